# Optimizing an MI355X kernel written in HIP

```python
import jax, jax.numpy as jnp
from jax import lax
import numpy as np

D_MODEL = 1024
BATCH = 32
SEQ = 2048
DEPTH = 2

CTX_LEN = 256
GRID_W = 64
NORM_EPS = 1e-6
POOL_WIDTH = 1024
POOL_WINDOWS = (2, 4, 8, 16)
POOL_GROUP = POOL_WIDTH // len(POOL_WINDOWS)
GLA_HEADS = 4
GLA_DK = 128
GLA_DV = 256
GLA_GATE_RANK = 16
GLA_TAU = 16.0
GLA_CHUNK = 64
MLA_HEADS = 8
MLA_Q_RANK = 384
MLA_KV_RANK = 256
MLA_NOPE = 128
MLA_ROPE = 64
MLA_V = 128
ROPE_BASE = 10000.0
Q_BLOCK = 128
N_BRANCH = 3
BRANCH_WIDTH = 1024
PEER_HEADS = 8
PEER_N_KEYS = 128
PEER_N_EXPERTS = PEER_N_KEYS * PEER_N_KEYS
PEER_TOPK = 16
PEER_QDIM = 256
PEER_HALF = PEER_QDIM // 2
PEER_BLOCK = 128
IN_SPLITS = (POOL_WIDTH, GLA_HEADS * GLA_DK, GLA_HEADS * GLA_DK, GLA_HEADS * GLA_DV, GLA_HEADS * GLA_DV,
             GLA_GATE_RANK, GLA_GATE_RANK, MLA_Q_RANK, MLA_KV_RANK, MLA_ROPE, N_BRANCH * D_MODEL)
IN_COLS = sum(IN_SPLITS)

kernel_name = "hybrid_pool_gla_mla_peer_diffusion_block"

F32 = jnp.float32


def rmsnorm(x, g):
    xf = x.astype(F32)
    y = xf * lax.rsqrt(jnp.mean(xf * xf, axis=-1, keepdims=True) + NORM_EPS)
    return (y * g.astype(F32)).astype(x.dtype)


def split_cols(z):
    idx, acc = [], 0
    for s in IN_SPLITS[:-1]:
        acc += s
        idx.append(acc)
    return jnp.split(z, idx, axis=-1)


def flip(a):
    return jnp.flip(a, axis=1)


def axial_angles(T):
    n_rows = T // GRID_W
    row = jnp.repeat(jnp.arange(n_rows), GRID_W).astype(F32)
    col = jnp.tile(jnp.arange(GRID_W), n_rows).astype(F32)
    half = MLA_ROPE // 2
    inv = ROPE_BASE ** (-jnp.arange(0, half, 2, dtype=F32) / half)
    return row[:, None] * inv, col[:, None] * inv


def rotate(x, ang):
    m = x.shape[-1] // 2
    x1, x2 = x[..., :m], x[..., m:]
    cos, sin = jnp.cos(ang).astype(x.dtype), jnp.sin(ang).astype(x.dtype)
    return jnp.concatenate([x1 * cos - x2 * sin, x1 * sin + x2 * cos], axis=-1)


def axial_rope(x, ang_row, ang_col):
    h = x.shape[-1] // 2
    return jnp.concatenate([rotate(x[..., :h], ang_row), rotate(x[..., h:], ang_col)], axis=-1)


def multiscale_pool(u, w, scale):
    T = u.shape[1]
    uf = u.astype(F32)
    cs = jnp.concatenate([jnp.zeros_like(uf[:, :1]), jnp.cumsum(uf, axis=1)], axis=1)
    t = jnp.arange(T)
    outs = []
    for gi, win in enumerate(POOL_WINDOWS):
        lo = jnp.clip(t - win // 2, 0, T)
        hi = jnp.clip(t + win - win // 2, 0, T)
        sl = slice(gi * POOL_GROUP, (gi + 1) * POOL_GROUP)
        csg = cs[..., sl]
        mean = (csg[:, hi] - csg[:, lo]) / (hi - lo).astype(F32)[:, None]
        diff = (mean - uf[..., sl]).astype(u.dtype)
        outs.append(diff @ w[gi])
    return jnp.concatenate(outs, axis=-1) * scale


def gla_chunk_scan(q, k, v, g, s0):
    Bn, T, H, _ = q.shape
    dv = v.shape[-1]
    n = T // GLA_CHUNK

    def to_chunks(a):
        return a.astype(F32).reshape(Bn, n, GLA_CHUNK, H, a.shape[-1]).transpose(1, 0, 3, 2, 4)

    mask = jnp.tril(jnp.ones((GLA_CHUNK, GLA_CHUNK), dtype=bool))

    def step(S, inp):
        qc, kc, vc, gc = inp
        b = jnp.cumsum(gc, axis=2)
        b_last = b[:, :, -1:, :]
        qe = qc * jnp.exp(b)
        ke = kc * jnp.exp(-b)
        kd = kc * jnp.exp(b_last - b)
        att = jnp.where(mask, jnp.einsum('bhtd,bhsd->bhts', qe, ke), 0.0)
        o = jnp.einsum('bhts,bhsv->bhtv', att, vc) + jnp.einsum('bhtd,bhdv->bhtv', qe, S)
        S = jnp.exp(b_last[:, :, 0, :])[..., None] * S + jnp.einsum('bhsd,bhsv->bhdv', kd, vc)
        return S, o

    S, o = lax.scan(step, s0, (to_chunks(q), to_chunks(k), to_chunks(v), to_chunks(g)))
    o = o.transpose(1, 0, 3, 2, 4).reshape(Bn, T, H, dv)
    return o.astype(q.dtype), S


def gla_inputs(q, k, v, lr_f, lr_b, gate_w, gate_b):
    shp = q.shape[:2]
    q = q.reshape(shp + (GLA_HEADS, GLA_DK)) * GLA_DK ** -0.5
    k = k.reshape(shp + (GLA_HEADS, GLA_DK))
    v = v.reshape(shp + (GLA_HEADS, GLA_DV))

    def log_gate(lr, d):
        z = (lr @ gate_w[d] + gate_b[d]).astype(F32)
        return (jax.nn.log_sigmoid(z) / GLA_TAU).reshape(shp + (GLA_HEADS, GLA_DK))

    return q, k, v, log_gate(lr_f, 0), log_gate(lr_b, 1)


def gla_finish(o, r, g_norm):
    shp = o.shape[:2]
    return rmsnorm(o, g_norm).reshape(shp + (GLA_HEADS * GLA_DV,)) * jax.nn.silu(r)


def mla_inputs(q_dn, kv_dn, k_rope, q_g, kv_g, w_uq, w_ukv, angles):
    shp = q_dn.shape[:2]
    q = (rmsnorm(q_dn, q_g) @ w_uq).reshape(shp + (MLA_HEADS, MLA_NOPE + MLA_ROPE))
    kv = (rmsnorm(kv_dn, kv_g) @ w_ukv).reshape(shp + (MLA_HEADS, MLA_NOPE + MLA_V))
    qn, qr = q[..., :MLA_NOPE], q[..., MLA_NOPE:]
    kn, vv = kv[..., :MLA_NOPE], kv[..., MLA_NOPE:]
    if angles is not None:
        ar, ac = angles
        qr = axial_rope(qr, ar[:, None, :], ac[:, None, :])
        k_rope = axial_rope(k_rope, ar, ac)
    return qn, qr, kn, k_rope, vv


def block_attention(qn, qr, kn, kr, v):
    Bn, T, H, dn = qn.shape
    nb = T // Q_BLOCK
    scale = (MLA_NOPE + MLA_ROPE) ** -0.5
    qn_b = qn.reshape(Bn, nb, Q_BLOCK, H, dn).swapaxes(0, 1)
    qr_b = qr.reshape(Bn, nb, Q_BLOCK, H, qr.shape[-1]).swapaxes(0, 1)

    def one(args):
        qnb, qrb = args
        s = jnp.einsum('bqhd,bkhd->bhqk', qnb, kn) + jnp.einsum('bqhr,bkr->bhqk', qrb, kr)
        p = jax.nn.softmax(s.astype(F32) * scale, axis=-1).astype(v.dtype)
        return jnp.einsum('bhqk,bkhd->bqhd', p, v)

    o = lax.map(one, (qn_b, qr_b))
    return o.swapaxes(0, 1).reshape(Bn, T, H * v.shape[-1])


def merge(pool_o, gla_o, mla_o, gz, branch_w, w_out):
    shp = gz.shape[:2]
    gates = jax.nn.sigmoid(gz.astype(F32)).astype(gz.dtype).reshape(shp + (N_BRANCH, D_MODEL))
    m = (gates[..., 0, :] * (pool_o @ branch_w[0]) + gates[..., 1, :] * (gla_o @ branch_w[1])
         + gates[..., 2, :] * (mla_o @ branch_w[2]))
    return m @ w_out


def token_mixer(h, hc, w_in, pool_w, pool_scale, gate_w, gate_b, gla_g, q_g, kv_g, w_uq, w_ukv,
                branch_w, w_out, with_ctx):
    Bn, T, _ = h.shape
    angles = axial_angles(T)
    (p_in, q, k, v, r, lr_f, lr_b, q_dn, kv_dn, k_rope, gz) = split_cols(h @ w_in)
    (p_c, q_c, k_c, v_c, r_c, lr_fc, lr_bc, q_dnc, kv_dnc, k_ropec, gzc) = split_cols(hc @ w_in)

    gq, gk, gv, gf, gb = gla_inputs(q, k, v, lr_f, lr_b, gate_w, gate_b)
    cq, ck, cv, cf, cb = gla_inputs(q_c, k_c, v_c, lr_fc, lr_bc, gate_w, gate_b)
    s0 = jnp.zeros((Bn, GLA_HEADS, GLA_DK, GLA_DV), F32)
    oc_f, s_f = gla_chunk_scan(cq, ck, cv, cf, s0)
    oc_b, s_b = gla_chunk_scan(flip(cq), flip(ck), flip(cv), flip(cb), s0)
    o_f, _ = gla_chunk_scan(gq, gk, gv, gf, s_f)
    o_b, _ = gla_chunk_scan(flip(gq), flip(gk), flip(gv), flip(gb), s_b)
    gla_lat = gla_finish(o_f + flip(o_b), r, gla_g)

    qn, qr, kn, kr, vv = mla_inputs(q_dn, kv_dn, k_rope, q_g, kv_g, w_uq, w_ukv, angles)
    cqn, cqr, ckn, ckr, cvv = mla_inputs(q_dnc, kv_dnc, k_ropec, q_g, kv_g, w_uq, w_ukv, None)
    mla_lat = block_attention(qn, qr, jnp.concatenate([ckn, kn], axis=1),
                              jnp.concatenate([ckr, kr], axis=1), jnp.concatenate([cvv, vv], axis=1))

    pool_lat = multiscale_pool(p_in, pool_w, pool_scale)
    y = merge(pool_lat, gla_lat, mla_lat, gz, branch_w, w_out)
    if not with_ctx:
        return y, None
    gla_ctx = gla_finish(oc_f + flip(oc_b), r_c, gla_g)
    mla_ctx = block_attention(cqn, cqr, ckn, ckr, cvv)
    pool_ctx = multiscale_pool(p_c, pool_w, pool_scale)
    yc = merge(pool_ctx, gla_ctx, mla_ctx, gzc, branch_w, w_out)
    return y, yc


def peer(h, wq, keys, u, v):
    shp = h.shape
    xb = h.reshape(-1, PEER_BLOCK, D_MODEL)

    def one(xs):
        q = (xs @ wq).reshape(PEER_BLOCK, PEER_HEADS, 2, PEER_HALF)
        s1 = jnp.einsum('nhd,hkd->nhk', q[:, :, 0], keys[0]).astype(F32)
        s2 = jnp.einsum('nhd,hkd->nhk', q[:, :, 1], keys[1]).astype(F32)
        t1, i1 = lax.top_k(s1, PEER_TOPK)
        t2, i2 = lax.top_k(s2, PEER_TOPK)
        cand = (t1[..., :, None] + t2[..., None, :]).reshape(PEER_BLOCK, PEER_HEADS, PEER_TOPK * PEER_TOPK)
        cid = (i1[..., :, None] * PEER_N_KEYS + i2[..., None, :]).reshape(PEER_BLOCK, PEER_HEADS,
                                                                          PEER_TOPK * PEER_TOPK)
        top, j = lax.top_k(cand, PEER_TOPK)
        eid = jnp.take_along_axis(cid, j, axis=-1)
        g = jax.nn.softmax(top, axis=-1).astype(xs.dtype)
        a = jax.nn.gelu(jnp.einsum('nd,nhjd->nhj', xs, u[eid]), approximate=False)
        return jnp.einsum('nhj,nhjd->nd', g * a, v[eid])

    return lax.map(one, xb).reshape(shp)


def setup_inputs(seed: int = 0) -> dict:
    key = jax.random.key(seed)
    ks = jax.random.split(key, 32)
    L, D = DEPTH, D_MODEL

    def nrm(k, shape, s):
        return jax.random.normal(k, shape, F32) * s

    return {
        "x": nrm(ks[0], (BATCH, SEQ, D), 1.0),
        "c": nrm(ks[1], (BATCH, D), 1.0),
        "ctx": nrm(ks[2], (BATCH, CTX_LEN, D), 1.0),
        "c_ctx": nrm(ks[3], (D,), 1.0),
        "ada_w": nrm(ks[4], (L, D, 6 * D), 0.5 * D ** -0.5),
        "ada_b": nrm(ks[5], (L, 6 * D), 0.02),
        "norm1_g": 1.0 + nrm(ks[6], (L, D), 0.02),
        "norm2_g": 1.0 + nrm(ks[7], (L, D), 0.02),
        "w_in": nrm(ks[8], (L, D, IN_COLS), D ** -0.5),
        "pool_w": nrm(ks[9], (L, len(POOL_WINDOWS), POOL_GROUP, POOL_GROUP), POOL_GROUP ** -0.5),
        "pool_scale": 1.0 + nrm(ks[10], (L, POOL_WIDTH), 0.1),
        "gla_gate_w": nrm(ks[11], (L, 2, GLA_GATE_RANK, GLA_HEADS * GLA_DK), GLA_GATE_RANK ** -0.5),
        "gla_gate_b": nrm(ks[12], (L, 2, GLA_HEADS * GLA_DK), 0.1),
        "gla_norm_g": 1.0 + nrm(ks[13], (L, GLA_DV), 0.02),
        "mla_q_norm_g": 1.0 + nrm(ks[14], (L, MLA_Q_RANK), 0.02),
        "mla_kv_norm_g": 1.0 + nrm(ks[15], (L, MLA_KV_RANK), 0.02),
        "mla_w_uq": nrm(ks[16], (L, MLA_Q_RANK, MLA_HEADS * (MLA_NOPE + MLA_ROPE)), MLA_Q_RANK ** -0.5),
        "mla_w_ukv": nrm(ks[17], (L, MLA_KV_RANK, MLA_HEADS * (MLA_NOPE + MLA_V)), MLA_KV_RANK ** -0.5),
        "branch_w": nrm(ks[18], (L, N_BRANCH, BRANCH_WIDTH, D), BRANCH_WIDTH ** -0.5),
        "w_out": nrm(ks[19], (L, D, D), D ** -0.5),
        "peer_wq": nrm(ks[20], (L, D, PEER_HEADS * PEER_QDIM), D ** -0.5),
        "peer_keys": nrm(ks[21], (L, 2, PEER_HEADS, PEER_N_KEYS, PEER_HALF), PEER_HALF ** -0.5),
        "peer_u": nrm(ks[22], (L, PEER_N_EXPERTS, D), D ** -0.5),
        "peer_v": nrm(ks[23], (L, PEER_N_EXPERTS, D), 1.0),
        "final_norm_g": 1.0 + nrm(ks[24], (D,), 0.02),
    }


def reference(x, c, ctx, c_ctx, ada_w, ada_b, norm1_g, norm2_g, w_in, pool_w, pool_scale, gla_gate_w,
              gla_gate_b, gla_norm_g, mla_q_norm_g, mla_kv_norm_g, mla_w_uq, mla_w_ukv, branch_w, w_out,
              peer_wq, peer_keys, peer_u, peer_v, final_norm_g):
    x_lat, x_ctx = x, ctx
    for i in range(DEPTH):
        with_ctx = i < DEPTH - 1
        mod = jax.nn.silu(c) @ ada_w[i] + ada_b[i]
        modc = jax.nn.silu(c_ctx) @ ada_w[i] + ada_b[i]
        sh1, sc1, g1, sh2, sc2, g2 = jnp.split(mod[:, None, :], 6, axis=-1)
        csh1, csc1, cg1, csh2, csc2, cg2 = jnp.split(modc, 6)
        h = rmsnorm(x_lat, norm1_g[i]) * (1.0 + sc1) + sh1
        hc = rmsnorm(x_ctx, norm1_g[i]) * (1.0 + csc1) + csh1
        y, yc = token_mixer(h, hc, w_in[i], pool_w[i], pool_scale[i], gla_gate_w[i], gla_gate_b[i],
                            gla_norm_g[i], mla_q_norm_g[i], mla_kv_norm_g[i], mla_w_uq[i], mla_w_ukv[i],
                            branch_w[i], w_out[i], with_ctx)
        x_lat = x_lat + g1 * y
        h2 = rmsnorm(x_lat, norm2_g[i]) * (1.0 + sc2) + sh2
        x_lat = x_lat + g2 * peer(h2, peer_wq[i], peer_keys[i], peer_u[i], peer_v[i])
        if with_ctx:
            x_ctx = x_ctx + cg1 * yc
            hc2 = rmsnorm(x_ctx, norm2_g[i]) * (1.0 + csc2) + csh2
            x_ctx = x_ctx + cg2 * peer(hc2, peer_wq[i], peer_keys[i], peer_u[i], peer_v[i])
    return rmsnorm(x_lat, final_norm_g)
```

```cpp
#include <hip/hip_runtime.h>
#include <stdint.h>
#include <stdio.h>

#ifndef REP_PHASE
#define REP_PHASE -1
#endif
#ifndef MK_SINGLE
#define MK_SINGLE 1
#endif

#define DI __device__ __forceinline__
#define LAS __attribute__((address_space(3)))

typedef unsigned short bf16_t;
typedef short bf16x8 __attribute__((ext_vector_type(8)));
typedef short s16x4 __attribute__((ext_vector_type(4)));
typedef float f32x4 __attribute__((ext_vector_type(4)));
typedef float f32x16 __attribute__((ext_vector_type(16)));
typedef unsigned u32x4 __attribute__((ext_vector_type(4)));
typedef unsigned u32x2 __attribute__((ext_vector_type(2)));
typedef __bf16 bf16x2_t __attribute__((ext_vector_type(2)));
typedef _Float16 h16x8 __attribute__((ext_vector_type(8)));

constexpr int D = 1024, NB = 32, TL = 2048, TC = 256, NLAYER = 2;
constexpr int ZLD = 7936;
constexpr int ZC_P = 0, ZC_Q = 1024, ZC_K = 1536, ZC_V = 2048, ZC_R = 3072, ZC_GZ = 4096, ZC_QDN = 7168, ZC_KVDN = 7552,
              ZC_KROPE = 7808, ZC_LRF = 7872, ZC_LRB = 7888;
constexpr int NEXP = 16384;
constexpr int NWG = 256, NTHR = 512;
constexpr int LDS_BYTES = 147456;

constexpr size_t WO_IN = 0, WO_POOL = WO_IN + (size_t)ZLD * 1024, WO_UQ = WO_POOL + 4 * 256 * 256, WO_KN = WO_UQ + 1536 * 384,
                 WO_V = WO_KN + 1024 * 256, WO_BR = WO_V + 1024 * 256, WO_OUT = WO_BR + 3 * 1024 * 1024, WO_Q = WO_OUT + 1024 * 1024,
                 WO_KEYS = WO_Q + 2048 * 1024, WO_PU = WO_KEYS + 8 * 256 * 256, WO_PV = WO_PU + (size_t)NEXP * 512,
                 W_LAYER = WO_PV + (size_t)NEXP * 512;

constexpr size_t MiB = 1048576;
constexpr size_t WS_CTL = 0;
constexpr size_t CTL_BYTES = 65536;
constexpr size_t WS_MOD = WS_CTL + CTL_BYTES;
constexpr size_t WS_ROPE = WS_MOD + 1792 * 1024;
constexpr size_t WS_W = WS_MOD + 2 * MiB;
constexpr size_t WS_H = WS_W + ((2 * W_LAYER * 2 + 255) / 256) * 256;
constexpr size_t WS_Z = WS_H + 32 * MiB;
constexpr size_t WS_QB = WS_Z + 248 * MiB;
constexpr size_t WS_KN = WS_QB + 48 * MiB;
constexpr size_t WS_VT = WS_KN + 32 * MiB;
constexpr size_t WS_KR = WS_VT + 32 * MiB;
constexpr size_t WS_CKN = WS_KR + 2 * MiB;
constexpr size_t WS_CVT = WS_CKN + 16 * MiB;
constexpr size_t WS_CKR = WS_CVT + 16 * MiB;
constexpr size_t WS_CST = WS_CKR + 1 * MiB;
constexpr size_t WS_RS = WS_CST + 32 * MiB;
constexpr size_t WS_OF = WS_RS + 1 * MiB;
constexpr size_t WS_OB = WS_OF + 32 * MiB;
constexpr size_t WS_MLA = WS_OB + 32 * MiB;
constexpr size_t WS_PD = WS_MLA + 32 * MiB;
constexpr size_t WS_PO = WS_PD + 32 * MiB;
constexpr size_t WS_ROUTE = WS_PO + 32 * MiB;
constexpr size_t WS_XCTX = WS_ROUTE + 16 * MiB;
constexpr size_t WS_XL = WS_XCTX + 16 * MiB;
constexpr size_t WS_END = WS_XL + 128 * MiB;

DI float bf2f(bf16_t b) { return __uint_as_float((unsigned)b << 16); }
DI bf16_t f2bf(float f) { return __builtin_bit_cast(bf16_t, (__bf16)f); }
DI unsigned pk2(float lo, float hi) { bf16x2_t v; v[0] = (__bf16)lo; v[1] = (__bf16)hi; return __builtin_bit_cast(unsigned, v); }
DI float lo2f(unsigned w) { return __uint_as_float(w << 16); }
DI float hi2f(unsigned w) { return __uint_as_float(w & 0xffff0000u); }
DI float shx(float v, int m, int lane) { return __builtin_bit_cast(float, __builtin_amdgcn_ds_bpermute((lane ^ m) << 2, __builtin_bit_cast(int, v))); }
DI float shl(float v, int src) { return __builtin_bit_cast(float, __builtin_amdgcn_ds_bpermute(src << 2, __builtin_bit_cast(int, v))); }
DI float wave_sum(float v, int lane) {
#pragma unroll
    for (int o = 32; o >= 1; o >>= 1) v += shx(v, o, lane);
    return v;
}
DI int ltid() { int t = threadIdx.x; asm volatile("" : "+v"(t)); return t; }
DI int lnd(int x) { asm volatile("" : "+s"(x)); return x; }
DI int lbid() { return lnd((int)blockIdx.x); }
DI int lgdim() { return lnd((int)gridDim.x); }
DI float sigmoidf_(float x) { return 1.0f / (1.0f + __expf(-x)); }

#define XB_TMO      128
#define XB_XCNT(j)  (256  + 64 * (j))
#define XB_XSUB(j)  (1280 + 64 * (j))
#define XB_XGEN(j)  (2304 + 64 * (j))
#define XB_TOP      3328
#define XB_TOPGEN   3392
#define XCD_BAR_WORDS 3456
#define XB_SPIN_CAP (1u << 23)
#define CTL_WORKQ   4096

DI unsigned xb_ld(unsigned* p)              { return __hip_atomic_load(p, __ATOMIC_RELAXED, __HIP_MEMORY_SCOPE_AGENT); }
DI unsigned xb_add(unsigned* p, unsigned v) { return __hip_atomic_fetch_add(p, v, __ATOMIC_RELAXED, __HIP_MEMORY_SCOPE_AGENT); }
DI unsigned xb_xcc_id() { return (unsigned)__builtin_amdgcn_s_getreg((3 << 11) | 20) & 0xFu; }
#define XB_SPIN(cond, bar) do { unsigned _sp = 0; while (cond) { __builtin_amdgcn_s_sleep(1); \
    if ((++_sp & 255u) == 0u) { if (xb_ld(&(bar)[XB_TMO])) break; if (_sp > XB_SPIN_CAP) { atomicAdd(&(bar)[XB_TMO], 1u); break; } } } } while (0)

struct XcdBarrier { unsigned* bar; unsigned x; volatile LAS unsigned* st; };

DI XcdBarrier xcd_barrier_post(unsigned* bar, volatile LAS unsigned* st) {
    XcdBarrier b; b.bar = bar; b.x = xb_xcc_id(); b.st = st;
    if (threadIdx.x == 0) (void)xb_add(&bar[XB_XCNT(b.x)], 1u);
    return b;
}
DI void xcd_barrier_complete(unsigned* bar, unsigned x, unsigned& nloc, unsigned& nx) {
    const unsigned G = gridDim.x * gridDim.y * gridDim.z;
    unsigned sum, cnt, mine, sp = 0u;
    for (;;) {
        sum = 0u; cnt = 0u; mine = 0u;
#pragma unroll
        for (unsigned j = 0; j < 16; ++j) { const unsigned c = xb_ld(&bar[XB_XCNT(j)]); sum += c; cnt += (c > 0u) ? 1u : 0u; mine = (j == x) ? c : mine; }
        if (sum == G) break;
        __builtin_amdgcn_s_sleep(1);
        if ((++sp & 255u) == 0u) { if (xb_ld(&bar[XB_TMO])) break; if (sp > XB_SPIN_CAP) { atomicAdd(&bar[XB_TMO], 1u); break; } }
    }
    nloc = mine > 0u ? mine : 1u; nx = cnt > 0u ? cnt : 1u;
}
DI void xcd_barrier(const XcdBarrier& b) {
    asm volatile("s_waitcnt vmcnt(0)" ::: "memory");
    __syncthreads();
    if (threadIdx.x == 0) {
        __attribute__((address_space(1))) unsigned* gbar = (__attribute__((address_space(1))) unsigned*)b.bar; asm volatile("" : "+s"(gbar)); unsigned* bar = (unsigned*)gbar;
        unsigned bx = b.x; asm volatile("" : "+s"(bx));
        __builtin_amdgcn_s_waitcnt(0);
        unsigned nloc = b.st[0], nx = b.st[1];
        if (nloc == 0u) { xcd_barrier_complete(bar, bx, nloc, nx); b.st[0] = nloc; b.st[1] = nx; }
        const unsigned old = xb_add(&bar[XB_XSUB(bx)], 1u);
        const unsigned gen = old / nloc;
        if (old + 1u == (gen + 1u) * nloc) {
            __builtin_amdgcn_fence(__ATOMIC_RELEASE, "agent");
            asm volatile("s_waitcnt vmcnt(0)" ::: "memory");
            const unsigned og = xb_add(&bar[XB_TOP], 1u);
            const unsigned tg = og / nx;
            if (og + 1u == (tg + 1u) * nx) xb_add(&bar[XB_TOPGEN], 1u);
            else XB_SPIN(xb_ld(&bar[XB_TOPGEN]) == tg, bar);
            __builtin_amdgcn_fence(__ATOMIC_ACQUIRE, "agent");
            xb_add(&bar[XB_XGEN(bx)], 1u);
            asm volatile("s_waitcnt vmcnt(0)" ::: "memory");
        } else {
            XB_SPIN(xb_ld(&bar[XB_XGEN(bx)]) == gen, bar);
            __builtin_amdgcn_fence(__ATOMIC_ACQUIRE, "agent");
            asm volatile("s_waitcnt vmcnt(0)" ::: "memory");
        }
    }
    __syncthreads();
}

namespace pg8 {
constexpr int BM = 256, BK = 64, HALF = 128, HTB = HALF * BK * 2, STAGE_BYTES = 8 * HTB, NXCD = 8, WGM = 8;
DI int lds_byte(int r, int c) { const int st = (r >> 4) * 2 + (c >> 5), rr = r & 15, cc = c & 31, ob = rr * 64 + cc * 2; return st * 1024 + (ob ^ (((ob >> 9) & 1) << 5)); }
DI void stage_rc(int b, int& R, int& C) { const int st = b / 1024, sb = b % 1024, swz = sb ^ (((sb >> 9) & 1) << 5); R = (st >> 1) * 16 + swz / 64; C = (st & 1) * 32 + (swz % 64) / 2; }
DI int perm32(int rho) { const int n = rho >> 4, i = rho & 15; return 8 * (i >> 2) + 4 * n + (i & 3); }

struct Unit { const char* A; const char* B; int pm, pn, z; };

DI void tile_of(int L, int nM, int nN, int& pm, int& pn) {
    const int nwg = nM * nN; int wgid = L;
    { const int q = nwg / NXCD, r = nwg % NXCD, xcd = wgid % NXCD, off = wgid / NXCD; wgid = (xcd < r ? xcd * (q + 1) : r * (q + 1) + (xcd - r) * q) + off; }
    const int nig = WGM * nN, gid = wgid / nig, fm = gid * WGM, gsz = (nM - fm) < WGM ? (nM - fm) : WGM;
    pm = fm + ((wgid % nig) % gsz); pn = (wgid % nig) / gsz;
}

template <class F> DI void epi8(const f32x4 (&acc)[2][2][4][2], int wr, int wc, int fr, int fq, F f) {
#pragma unroll
    for (int ai = 0; ai < 2; ++ai)
#pragma unroll
        for (int m = 0; m < 4; ++m) {
            const int row = ai * HALF + wr * 64 + m * 16 + fr;
#pragma unroll
            for (int bj = 0; bj < 2; ++bj) f(row, bj * HALF + wc * 32 + 8 * fq, acc[ai][bj][m][0], acc[ai][bj][m][1]);
        }
}

template <class Epi, class Sched>
DI void gemm_phase(LAS unsigned char* lds, const int lda, const int ldb, const int K, const Sched& S, const Epi& E) {
    int tid = threadIdx.x; asm volatile("" : "+v"(tid));
    const int wid = __builtin_amdgcn_readfirstlane(tid >> 6), lane = tid & 63, wr = wid >> 2, wc = wid & 3, fr = lane & 15, fq = lane >> 4;
    const int nt = K / BK;
    unsigned voffA[2], voffB[2];
#pragma unroll
    for (int i = 0; i < 2; ++i) { int R, C; stage_rc(tid * 16 + i * 8192, R, C); const int Rb = (R & ~31) + perm32(R & 31);
        voffA[i] = (unsigned)(R * lda + C) * 2u; voffB[i] = (unsigned)(Rb * ldb + C) * 2u; }
    const size_t kstep = (size_t)(BK * 2);
    const size_t hstepA = (size_t)HALF * lda * 2, hstepB = (size_t)HALF * ldb * 2;
    const unsigned ldsw = (unsigned)wid * 1024u;
    const int aoff = lds_byte(wr * 64 + fr, fq * 8), boff = lds_byte(wc * 32 + fr, fq * 8);
#define PG8_SA(b, h) (((b) * 2 + (h)) * HTB)
#define PG8_SB(b, h) ((4 + (b) * 2 + (h)) * HTB)
#define PG8_STAGE(bufoff, gbase, voff) do { _Pragma("unroll") for (int _i = 0; _i < 2; ++_i) \
        __builtin_amdgcn_global_load_lds((const unsigned*)((const char*)(gbase) + (voff)[_i]), (LAS unsigned*)(lds + (bufoff) + ldsw + _i * 8192), 16, 0, 0); } while (0)
#define PG8_LDA(dst, b, h) do { _Pragma("unroll") for (int m = 0; m < 4; ++m) _Pragma("unroll") for (int k = 0; k < 2; ++k) dst[m][k] = *(const LAS bf16x8*)(lds + PG8_SA(b, h) + aoff + m * 2048 + k * 1024); } while (0)
#define PG8_LDB(dst, b, h) do { _Pragma("unroll") for (int n = 0; n < 2; ++n) _Pragma("unroll") for (int k = 0; k < 2; ++k) dst[n][k] = *(const LAS bf16x8*)(lds + PG8_SB(b, h) + boff + n * 2048 + k * 1024); } while (0)
#define PG8_MMA(ai, bj, At, Bt) do { __builtin_amdgcn_s_setprio(1); _Pragma("unroll") for (int m = 0; m < 4; ++m) _Pragma("unroll") for (int n = 0; n < 2; ++n) _Pragma("unroll") for (int k = 0; k < 2; ++k) \
        acc[ai][bj][m][n] = __builtin_amdgcn_mfma_f32_16x16x32_bf16(Bt[n][k], At[m][k], acc[ai][bj][m][n], 0, 0, 0); __builtin_amdgcn_s_setprio(0); } while (0)
#define PG8_WAIT_V(n) asm volatile("s_waitcnt vmcnt(" #n ")" ::: "memory")
#define PG8_WAIT_L(n) asm volatile("s_waitcnt lgkmcnt(" #n ")" ::: "memory")
#define PG8_BAR __builtin_amdgcn_s_barrier()
#define PG8_SCHED __builtin_amdgcn_sched_barrier(0)
    Unit cur, nxt; int ui = 0;
    if (!S.next(0, cur)) return;
    f32x4 acc[2][2][4][2];
#pragma unroll
    for (int a = 0; a < 2; ++a)
#pragma unroll
        for (int b = 0; b < 2; ++b)
#pragma unroll
            for (int m = 0; m < 4; ++m)
#pragma unroll
                for (int n = 0; n < 2; ++n) acc[a][b][m][n] = (f32x4){0.f, 0.f, 0.f, 0.f};
    bf16x8 At[4][2], B0[2][2], B1[2][2];
    const char* cA = cur.A; const char* cB = cur.B;
    PG8_STAGE(PG8_SB(0, 0), cB, voffB); PG8_STAGE(PG8_SA(0, 0), cA, voffA); PG8_STAGE(PG8_SB(0, 1), cB + hstepB, voffB); PG8_STAGE(PG8_SA(0, 1), cA + hstepA, voffA);
    if (wr == 1) PG8_BAR;
    PG8_WAIT_V(4); PG8_BAR;
    PG8_STAGE(PG8_SB(1, 0), cB + kstep, voffB); PG8_STAGE(PG8_SA(1, 0), cA + kstep, voffA); PG8_STAGE(PG8_SB(1, 1), cB + hstepB + kstep, voffB);
    PG8_WAIT_V(6); PG8_BAR;
    for (;;) {
        const bool has_next = S.next(ui + 1, nxt);
        const char* nA = has_next ? nxt.A : cA; const char* nB = has_next ? nxt.B : cB;
#pragma nounroll
        for (int t = 0; t < nt; t += 2) {
            const bool last = (t == nt - 2);
            const char* a1 = cA + (size_t)(t + 1) * kstep;
            const char* a2 = last ? nA : cA + (size_t)(t + 2) * kstep; const char* b2 = last ? nB : cB + (size_t)(t + 2) * kstep;
            const char* a3 = a2 + kstep; const char* b3 = b2 + kstep;
            PG8_LDB(B0, 0, 0); PG8_SCHED; PG8_LDA(At, 0, 0); PG8_STAGE(PG8_SA(1, 1), a1 + hstepA, voffA);
            PG8_WAIT_L(8); PG8_BAR; PG8_WAIT_L(0); PG8_MMA(0, 0, At, B0); PG8_BAR; PG8_SCHED;
            PG8_LDB(B1, 0, 1); PG8_STAGE(PG8_SB(0, 0), b2, voffB);
            PG8_BAR; PG8_WAIT_L(0); PG8_MMA(0, 1, At, B1); PG8_BAR;
            PG8_LDA(At, 0, 1); PG8_STAGE(PG8_SA(0, 0), a2, voffA);
            PG8_BAR; PG8_WAIT_L(0); PG8_MMA(1, 0, At, B0); PG8_BAR; PG8_SCHED;
            PG8_STAGE(PG8_SB(0, 1), b2 + hstepB, voffB);
            PG8_WAIT_V(6); PG8_BAR; PG8_MMA(1, 1, At, B1); PG8_BAR;
            PG8_LDB(B0, 1, 0); PG8_SCHED; PG8_LDA(At, 1, 0); PG8_STAGE(PG8_SA(0, 1), a2 + hstepA, voffA);
            PG8_WAIT_L(8); PG8_BAR; PG8_WAIT_L(0); PG8_MMA(0, 0, At, B0); PG8_BAR; PG8_SCHED;
            PG8_LDB(B1, 1, 1); PG8_STAGE(PG8_SB(1, 0), b3, voffB);
            PG8_BAR; PG8_WAIT_L(0); PG8_MMA(0, 1, At, B1); PG8_BAR;
            PG8_LDA(At, 1, 1); PG8_STAGE(PG8_SA(1, 0), a3, voffA);
            PG8_BAR; PG8_WAIT_L(0); PG8_MMA(1, 0, At, B0); PG8_BAR; PG8_SCHED;
            PG8_STAGE(PG8_SB(1, 1), b3 + hstepB, voffB);
            PG8_WAIT_V(6); PG8_BAR; PG8_MMA(1, 1, At, B1); PG8_BAR;
        }
        E(acc, cur, wr, wc, fr, fq);
        if (!has_next) break;
#pragma unroll
        for (int a = 0; a < 2; ++a)
#pragma unroll
            for (int b = 0; b < 2; ++b)
#pragma unroll
                for (int m = 0; m < 4; ++m)
#pragma unroll
                    for (int n = 0; n < 2; ++n) acc[a][b][m][n] = (f32x4){0.f, 0.f, 0.f, 0.f};
        cur = nxt; cA = nA; cB = nB; ++ui;
    }
    PG8_WAIT_V(0);
    if (wr == 0) PG8_BAR;
    PG8_BAR;
#undef PG8_SA
#undef PG8_SB
#undef PG8_STAGE
#undef PG8_LDA
#undef PG8_LDB
#undef PG8_MMA
#undef PG8_WAIT_V
#undef PG8_WAIT_L
#undef PG8_BAR
#undef PG8_SCHED
}
}
using pg8::Unit;

struct Params {
    const float *x, *c, *ctx, *c_ctx, *ada_w, *ada_b, *norm1_g, *norm2_g, *w_in, *pool_w, *pool_scale, *gla_gate_w, *gla_gate_b, *gla_norm_g,
                *mla_q_norm_g, *mla_kv_norm_g, *mla_w_uq, *mla_w_ukv, *branch_w, *w_out, *peer_wq, *peer_keys, *peer_u, *peer_v, *final_norm_g;
    float* out; unsigned char* ws;
};
struct Chunk { int is_ctx, rows, b0, np; const float* x32; bf16_t* xb; };

DI Chunk make_chunk(const Params& P, int layer, int ci) {
    Chunk c; c.is_ctx = (ci == 0); c.rows = c.is_ctx ? NB * TC : 8 * TL; c.b0 = c.is_ctx ? 0 : 8 * (ci - 1); c.np = c.rows / 256;
    c.xb = c.is_ctx ? (bf16_t*)(P.ws + WS_XCTX) : (bf16_t*)(P.ws + WS_XL) + (size_t)c.b0 * TL * D;
    c.x32 = (layer == 0) ? (c.is_ctx ? P.ctx : P.x + (size_t)c.b0 * TL * D) : nullptr;
    return c;
}
DI const bf16_t* wlayer(const Params& P, int l) { return (const bf16_t*)(P.ws + WS_W) + (size_t)l * W_LAYER; }
DI const float* modlayer(const Params& P, int l) { return (const float*)(P.ws + WS_MOD) + (size_t)l * 33 * 6144; }

template <class SrcF> DI void tconv_tiles(LAS float* tile, bf16_t* dst, int K, int N, SrcF src, int rot) {
    const int tid = ltid(), ntk = K / 64, ntn = N / 64, nwg = lgdim();
    const int wg = (int)(((unsigned)lbid() + (unsigned)rot) % (unsigned)nwg);
    for (int t = wg; t < ntk * ntn; t += nwg) {
        const int kt = t % ntk, nt_ = t / ntk;
#pragma unroll
        for (int rr = 0; rr < 8; ++rr) { const int i = (tid >> 6) + 8 * rr, j = tid & 63; tile[i * 65 + j] = src(kt * 64 + i, nt_ * 64 + j); }
        __syncthreads();
#pragma unroll
        for (int rr = 0; rr < 8; ++rr) { const int jj = (tid >> 6) + 8 * rr, ii = tid & 63; dst[(size_t)(nt_ * 64 + jj) * K + kt * 64 + ii] = f2bf(tile[ii * 65 + jj]); }
        __syncthreads();
    }
}
DI void conv_direct(const float* src, bf16_t* dst, size_t n) {
    const size_t stride = (size_t)lgdim() * NTHR;
    const int tid_ = ltid();
    for (size_t i = (size_t)lbid() * NTHR + tid_; i < n / 4; i += stride) {
        const float4 v = ((const float4*)src)[i]; u32x2 w; w.x = pk2(v.x, v.y); w.y = pk2(v.z, v.w); ((u32x2*)dst)[i] = w; }
}
DI void conv_fp8(const float* src, unsigned* dst, size_t n, float scale) {
    const size_t stride = (size_t)lgdim() * NTHR;
    const int tid_ = ltid();
    for (size_t i = (size_t)lbid() * NTHR + tid_; i < n / 4; i += stride) {
        const float4 v = ((const float4*)src)[i]; int w = 0;
        w = __builtin_amdgcn_cvt_pk_fp8_f32(v.x * scale, v.y * scale, w, false); w = __builtin_amdgcn_cvt_pk_fp8_f32(v.z * scale, v.w * scale, w, true);
        dst[i] = (unsigned)w; }
}
DI void phase_convert(const Params& P, LAS unsigned char* lds) {
    LAS float* tile = (LAS float*)lds;
    for (int l = 0; l < NLAYER; ++l) {
        bf16_t* W = (bf16_t*)(P.ws + WS_W) + (size_t)l * W_LAYER;
        { const float* w = P.w_in + (size_t)l * 1024 * 7904;
          tconv_tiles(tile, W + WO_IN, 1024, ZLD, [=](int k, int n) -> float {
              int sc; float s = 1.0f;
              if (n < 4096) { sc = n; if (n >= 1024 && n < 1536) s = 0.08838834764831845f; }
              else if (n < 7168) sc = n - 4096 + 4832;
              else if (n < 7552) sc = n - 7168 + 4128;
              else if (n < 7808) sc = n - 7552 + 4512;
              else if (n < 7872) sc = n - 7808 + 4768;
              else if (n < 7888) sc = n - 7872 + 4096;
              else if (n < 7904) sc = n - 7888 + 4112;
              else return 0.0f;
              return w[(size_t)k * 7904 + sc] * s; }, 0); }
        { const float* w = P.mla_w_uq + (size_t)l * 384 * 1536; const float* g = P.mla_q_norm_g + l * 384;
          tconv_tiles(tile, W + WO_UQ, 384, 1536, [=](int k, int n) -> float { return g[k] * w[k * 1536 + n]; }, 81); }
        { const float* w = P.mla_w_ukv + (size_t)l * 256 * 2048; const float* g = P.mla_kv_norm_g + l * 256;
          tconv_tiles(tile, W + WO_KN, 256, 1024, [=](int k, int n) -> float { return g[k] * w[k * 2048 + (n >> 7) * 256 + (n & 127)]; }, 120);
          tconv_tiles(tile, W + WO_V, 256, 1024, [=](int k, int n) -> float { return g[k] * w[k * 2048 + (n >> 7) * 256 + 128 + (n & 127)]; }, 184); }
        for (int i = 1; i < 3; ++i) { const float* w = P.branch_w + ((size_t)l * 3 + i) * 1048576;
          tconv_tiles(tile, W + WO_BR + (size_t)i * 1048576, 1024, 1024, [=](int k, int n) -> float { return w[k * 1024 + n]; }, 0); }
        {
            const float* pw = P.pool_w + (size_t)l * 4 * 65536; const float* ps = P.pool_scale + l * 1024; const float* bw = P.branch_w + (size_t)l * 3 * 1048576; bf16_t* dst = W + WO_BR;
            LAS float* AS = (LAS float*)lds; LAS float* BS = AS + 64 * 257;
            const int tid = ltid();
            for (int t = lbid(); t < 256; t += lgdim()) {
                const int g = t >> 6, nb = (t >> 2) & 15, kb = t & 3;
                __syncthreads();
                for (int i = tid; i < 64 * 256; i += NTHR) { const int r = i >> 8, j = i & 255; AS[r * 257 + j] = pw[(size_t)g * 65536 + (kb * 64 + r) * 256 + j] * ps[g * 256 + j]; }
                for (int i = tid; i < 256 * 64; i += NTHR) { const int j = i >> 6, n = i & 63; BS[j * 65 + n] = bw[(size_t)(g * 256 + j) * 1024 + nb * 64 + n]; }
                __syncthreads();
                const int kq = tid & 63, n0 = (tid >> 6) * 8;
                float acc[8];
#pragma unroll
                for (int j = 0; j < 8; ++j) acc[j] = 0.f;
                for (int j = 0; j < 256; ++j) { const float a = AS[kq * 257 + j];
#pragma unroll
                    for (int q = 0; q < 8; ++q) acc[q] += a * BS[j * 65 + n0 + q]; }
#pragma unroll
                for (int q = 0; q < 8; ++q) dst[(size_t)(nb * 64 + n0 + q) * 1024 + g * 256 + kb * 64 + kq] = f2bf(acc[q]);
            }
            __syncthreads();
        }
        { const float* w = P.w_out + (size_t)l * 1048576;
          tconv_tiles(tile, W + WO_OUT, 1024, 1024, [=](int k, int n) -> float { return w[k * 1024 + n]; }, 0); }
        {
            const float* wq = P.peer_wq + (size_t)l * 1024 * 2048; const float* kk = P.peer_keys + (size_t)l * 2 * 8 * 128 * 128; bf16_t* dst = W + WO_Q;
            LAS float* KY = (LAS float*)lds; LAS float* WQS = KY + 128 * 129;
            const int tid = ltid();
            for (int t = lbid(); t < 256; t += lgdim()) {
                const int hs = t >> 4, k0 = (t & 15) * 64, h = hs >> 1, half = hs & 1;
                __syncthreads();
                for (int i = tid; i < 128 * 128; i += NTHR) { const int key = i >> 7, d = i & 127; KY[key * 129 + d] = kk[((size_t)(half * 8 + h) * 128 + key) * 128 + d]; }
                for (int i = tid; i < 64 * 128; i += NTHR) { const int r = i >> 7, d = i & 127; WQS[r * 129 + d] = wq[(size_t)(k0 + r) * 2048 + h * 256 + half * 128 + d]; }
                __syncthreads();
                const int kq = tid & 63, key0 = (tid >> 6) * 16;
                float acc[16];
#pragma unroll
                for (int j = 0; j < 16; ++j) acc[j] = 0.f;
                for (int d = 0; d < 128; ++d) { const float a = WQS[kq * 129 + d];
#pragma unroll
                    for (int j = 0; j < 16; ++j) acc[j] += a * KY[(key0 + j) * 129 + d]; }
#pragma unroll
                for (int j = 0; j < 16; ++j) dst[(size_t)(h * 256 + half * 128 + key0 + j) * 1024 + k0 + kq] = f2bf(acc[j]);
            }
            __syncthreads();
        }
        conv_fp8(P.peer_u + (size_t)l * NEXP * 1024, (unsigned*)(W + WO_PU), (size_t)NEXP * 1024, 32.0f);
        conv_fp8(P.peer_v + (size_t)l * NEXP * 1024, (unsigned*)(W + WO_PV), (size_t)NEXP * 1024, 1.0f);
    }
    if (lbid() == 0) {
        float2* rt = (float2*)(P.ws + WS_ROPE);
        for (int i = ltid(); i < 64 * 16; i += NTHR) { const float inv = exp2f(-(float)(i & 15) * 0.8304820237218406f); float sn, cs; sincosf((float)(i >> 4) * inv, &sn, &cs); rt[i] = make_float2(cs, sn); }
    }
}
DI void phase_mod(const Params& P, LAS unsigned char* lds) {
    LAS float* SC = (LAS float*)lds;
    LAS float* ACC = SC + 33 * 1024;
    const int tid = ltid(), wid = tid >> 6;
    if (lbid() >= 192) return;
    for (int i = tid; i < 33 * 1024; i += NTHR) { const int b = i >> 10, k = i & 1023; const float v = b < 32 ? P.c[b * 1024 + k] : P.c_ctx[k]; SC[i] = v / (1.0f + __expf(-v)); }
    float* MOD = (float*)(P.ws + WS_MOD);
    for (int grp = lbid(); grp < 192; grp += lgdim()) {
        const int l = grp / 96, n0 = (grp % 96) * 64;
        for (int i = tid; i < 33 * 64; i += NTHR) ACC[i] = 0.f;
        __syncthreads();
        const int j = tid & 63, ks = tid >> 6;
        float acc[33];
#pragma unroll
        for (int b = 0; b < 33; ++b) acc[b] = 0.f;
        const float* w = P.ada_w + (size_t)l * 1024 * 6144 + n0 + j;
        for (int k = ks * 128; k < ks * 128 + 128; ++k) { const float wv = w[(size_t)k * 6144];
#pragma unroll
            for (int b = 0; b < 33; ++b) acc[b] += SC[b * 1024 + k] * wv; }
        for (int ww = 0; ww < 8; ++ww) {
            if (wid == ww) {
#pragma unroll
                for (int b = 0; b < 33; ++b) ACC[b * 64 + j] += acc[b]; }
            __syncthreads(); }
        for (int i = tid; i < 33 * 64; i += NTHR) { const int b = i >> 6, jj = i & 63; MOD[(size_t)(l * 33 + b) * 6144 + n0 + jj] = ACC[i] + P.ada_b[l * 6144 + n0 + jj]; }
        __syncthreads();
    }
}

template <bool F32SRC> DI void phase_norm(const void* xsv, int rows, const float* gain, const float* mod, int is_ctx, int b0, int sh_idx, bf16_t* H) {
    const int tid_ = ltid(); const int lane = tid_ & 63, wid = tid_ >> 6;
    for (int r = lbid() * 8 + wid; r < rows; r += lgdim() * 8) {
        const int bi = is_ctx ? 32 : b0 + (r >> 11);
        const float* sh = mod + (size_t)bi * 6144 + sh_idx * 1024; const float* sc = sh + 1024;
        float4 v[4]; float ss = 0.f;
#pragma unroll
        for (int j = 0; j < 4; ++j) {
            if (F32SRC) v[j] = ((const float4*)((const float*)xsv + (size_t)r * 1024))[lane + 64 * j];
            else { const u32x2 w = ((const u32x2*)((const bf16_t*)xsv + (size_t)r * 1024))[lane + 64 * j]; v[j] = make_float4(lo2f(w.x), hi2f(w.x), lo2f(w.y), hi2f(w.y)); }
            ss += v[j].x * v[j].x + v[j].y * v[j].y + v[j].z * v[j].z + v[j].w * v[j].w; }
        ss = wave_sum(ss, lane);
        const float rstd = rsqrtf(ss * (1.0f / 1024.0f) + 1e-6f);
#pragma unroll
        for (int j = 0; j < 4; ++j) { const int c = (lane + 64 * j) * 4;
            const float4 g = *(const float4*)(gain + c), s1 = *(const float4*)(sc + c), s0 = *(const float4*)(sh + c);
            u32x2 w; w.x = pk2(v[j].x * rstd * g.x * (1.f + s1.x) + s0.x, v[j].y * rstd * g.y * (1.f + s1.y) + s0.y);
            w.y = pk2(v[j].z * rstd * g.z * (1.f + s1.z) + s0.z, v[j].w * rstd * g.w * (1.f + s1.w) + s0.w);
            *(u32x2*)(H + (size_t)r * 1024 + c) = w; }
    }
}

DI void phase_prep(const bf16_t* Z, int rows, int is_ctx, float* RS, bf16_t* KR, bf16_t* PD, bool do_pool, const float2* rt) {
    const int tid_ = ltid(); const int lane = tid_ & 63, wid = tid_ >> 6;
    const int seqlen = is_ctx ? TC : TL;
    for (int r = lbid() * 8 + wid; r < rows; r += lgdim() * 8) {
        const bf16_t* zr = Z + (size_t)r * ZLD;
        float sq = 0.f, sk = 0.f;
        { const unsigned* p = (const unsigned*)(zr + ZC_QDN + lane * 6);
#pragma unroll
          for (int i = 0; i < 3; ++i) { const unsigned w = p[i]; const float a = lo2f(w), b = hi2f(w); sq += a * a + b * b; } }
        { const u32x2 w = *(const u32x2*)(zr + ZC_KVDN + lane * 4); const float a = lo2f(w.x), b = hi2f(w.x), c = lo2f(w.y), d = hi2f(w.y); sk = a * a + b * b + c * c + d * d; }
        sq = wave_sum(sq, lane); sk = wave_sum(sk, lane);
        if (lane == 0) { RS[r] = rsqrtf(sq * (1.0f / 384.0f) + 1e-6f); RS[16384 + r] = rsqrtf(sk * (1.0f / 256.0f) + 1e-6f); }
        { const float x = bf2f(zr[ZC_KROPE + lane]); const float xp = shx(x, 16, lane); float o = x;
          if (!is_ctx) { const int t = r & (TL - 1); const int pos = (lane < 32) ? (t >> 6) : (t & 63); const int i = lane & 15;
              const float2 cs = rt[pos * 16 + i]; const float c = cs.x, s = cs.y;
              o = ((lane & 31) < 16) ? (x * c - xp * s) : (xp * s + x * c); }
          KR[(size_t)r * 64 + lane] = f2bf(o); }
        if (do_pool) {
            const int t = r % seqlen, seq0 = r - t;
#pragma unroll
            for (int j = 0; j < 4; ++j) {
                const int hw = 1 << j; const int lo = (t - hw) < 0 ? 0 : (t - hw); const int hi = (t + hw) > seqlen ? seqlen : (t + hw);
                const int c = j * 256 + lane * 4; float s0 = 0.f, s1 = 0.f, s2 = 0.f, s3 = 0.f;
#pragma unroll
                for (int k = 0; k < 2 * hw; ++k) {
                    const int tt = t - hw + k; const bool ok = tt >= 0 && tt < seqlen; const int tc = ok ? tt : t;
                    const u32x2 w = *(const u32x2*)(Z + (size_t)(seq0 + tc) * ZLD + ZC_P + c); const float m = ok ? 1.f : 0.f;
                    s0 += m * lo2f(w.x); s1 += m * hi2f(w.x); s2 += m * lo2f(w.y); s3 += m * hi2f(w.y); }
                const u32x2 me = *(const u32x2*)(zr + ZC_P + c); const float inv = 1.0f / (float)(hi - lo);
                u32x2 o; o.x = pk2(s0 * inv - lo2f(me.x), s1 * inv - hi2f(me.x)); o.y = pk2(s2 * inv - lo2f(me.y), s3 * inv - hi2f(me.y));
                *(u32x2*)(PD + (size_t)r * 1024 + c) = o; }
        }
    }
}

template <class Fill> struct GridSched { int nM, nN, G, c; Fill fill;
    DI bool next(int i, Unit& u) const { const long L = (long)i * G + c; if (L >= (long)nM * nN) return false; int pm, pn; pg8::tile_of((int)L, nM, nN, pm, pn); u.pm = pm; u.pn = pn; u.z = 0; fill(u); return true; } };
template <class Fill> DI GridSched<Fill> make_sched(int nM, int nN, Fill f) { GridSched<Fill> s{nM, nN, lgdim(), lbid(), f}; return s; }
template <class Fill> struct TripleSched { int nM, nN, G, c; Fill fill;
    DI bool next(int i, Unit& u) const { const long L = (long)(i / 3) * G + c; if (L >= (long)nM * nN) return false; int pm, pn; pg8::tile_of((int)L, nM, nN, pm, pn); u.pm = pm; u.pn = pn; u.z = i % 3; fill(u); return true; } };

DI bf16x8 pack8(const f32x16& x, int sp) { u32x4 p; p.x = pk2(x[8 * sp], x[8 * sp + 1]); p.y = pk2(x[8 * sp + 2], x[8 * sp + 3]); p.z = pk2(x[8 * sp + 4], x[8 * sp + 5]); p.w = pk2(x[8 * sp + 6], x[8 * sp + 7]);
    return __builtin_bit_cast(bf16x8, p); }
DI bf16x8 read_perm(const LAS unsigned char* p) {
    const s16x4 lo = *(const LAS s16x4*)p, hi = *(const LAS s16x4*)(p + 16);
    bf16x8 v; v[0] = lo[0]; v[1] = lo[1]; v[2] = lo[2]; v[3] = lo[3]; v[4] = hi[0]; v[5] = hi[1]; v[6] = hi[2]; v[7] = hi[3]; return v; }
DI void store8_bf16(bf16_t* p, const f32x4& a, const f32x4& b) { u32x4 w; w.x = pk2(a[0], a[1]); w.y = pk2(a[2], a[3]); w.z = pk2(b[0], b[1]); w.w = pk2(b[2], b[3]); *(u32x4*)p = w; }

DI void attn_item(LAS unsigned char* lds, const float2* rt, const bf16_t* Qp, int h, bool rope, int tq0,
                  const bf16_t* kn0, const bf16_t* kr0, const bf16_t* vt0, int ldv0, int nt0,
                  const bf16_t* kn1, const bf16_t* kr1, const bf16_t* vt1, int ldv1, int nt1, bf16_t* Op) {
    int tid = threadIdx.x; asm volatile("" : "+v"(tid));
    const int wid = tid >> 6, lane = tid & 63, ql = lane & 31, hh = lane >> 5;
    const bool grpB = __builtin_amdgcn_readfirstlane(wid) >= 4;
    constexpr int KPITCH = 400, VPITCH = 136, VOFF = 64 * KPITCH, BUFB = VOFF + 128 * VPITCH;
    constexpr float SL = 0.10411755f;
    bf16x8 qf[12];
    { const bf16_t* qrow = Qp + (size_t)(wid * 32 + ql) * 1536 + h * 192;
#pragma unroll
      for (int ks = 0; ks < 12; ++ks) qf[ks] = *(const bf16x8*)(qrow + ks * 16 + hh * 8); }
    if (rope) {
        const int t = tq0 + wid * 32 + ql; const int rp = t >> 6, cp = t & 63;
#pragma unroll
        for (int j = 0; j < 8; ++j) {
            float2 cs = rt[rp * 16 + 8 * hh + j]; float c = cs.x, s = cs.y;
            { const float x1 = bf2f((bf16_t)qf[8][j]), x2 = bf2f((bf16_t)qf[9][j]); qf[8][j] = (short)f2bf(x1 * c - x2 * s); qf[9][j] = (short)f2bf(x1 * s + x2 * c); }
            cs = rt[cp * 16 + 8 * hh + j]; c = cs.x; s = cs.y;
            { const float x1 = bf2f((bf16_t)qf[10][j]), x2 = bf2f((bf16_t)qf[11][j]); qf[10][j] = (short)f2bf(x1 * c - x2 * s); qf[11][j] = (short)f2bf(x1 * s + x2 * c); }
        }
    }
    f32x16 oacc[4];
#pragma unroll
    for (int db = 0; db < 4; ++db)
#pragma unroll
        for (int r = 0; r < 16; ++r) oacc[db][r] = 0.f;
    float m_run = -1e30f, l_run = 0.f;
    const int ntile = nt0 + nt1;
    u32x4 kst[3], vst[2];
    auto issueK = [&](int j) {
        const bool s1 = j >= nt0; const int key0 = (s1 ? j - nt0 : j) * 64;
        const bf16_t* kn = s1 ? kn1 : kn0; const bf16_t* kr = s1 ? kr1 : kr0;
#pragma unroll
        for (int i = 0; i < 2; ++i) { const int id = tid + 512 * i, key = id >> 4, c = id & 15;
            kst[i] = *(const u32x4*)(kn + (size_t)(key0 + key) * 1024 + h * 128 + c * 8); }
        { const int key = tid >> 3, c = tid & 7;
            kst[2] = *(const u32x4*)(kr + (size_t)(key0 + key) * 64 + c * 8); } };
    auto issueV = [&](int j) {
        const bool s1 = j >= nt0; const int key0 = (s1 ? j - nt0 : j) * 64;
        const bf16_t* vt = s1 ? vt1 : vt0; const int ldv = s1 ? ldv1 : ldv0;
#pragma unroll
        for (int i = 0; i < 2; ++i) { const int id = tid + 512 * i, d = id >> 3, c = id & 7;
            vst[i] = *(const u32x4*)(vt + (size_t)(h * 128 + d) * ldv + key0 + c * 8); } };
    auto commitK = [&](int buf) {
        LAS unsigned char* base = lds + buf * BUFB;
#pragma unroll
        for (int i = 0; i < 2; ++i) { const int id = tid + 512 * i, key = id >> 4, c = id & 15; *(LAS u32x4*)(base + key * KPITCH + c * 16) = kst[i]; }
        { const int key = tid >> 3, c = tid & 7; *(LAS u32x4*)(base + key * KPITCH + (16 + c) * 16) = kst[2]; } };
    auto commitV = [&](int buf) {
        LAS unsigned char* base = lds + buf * BUFB + VOFF;
#pragma unroll
        for (int i = 0; i < 2; ++i) { const int id = tid + 512 * i, d = id >> 3, c = id & 7; LAS u32x2* p = (LAS u32x2*)(base + d * VPITCH + c * 16);
            u32x2 a; a.x = vst[i].x; a.y = vst[i].y; u32x2 b; b.x = vst[i].z; b.y = vst[i].w; p[0] = a; p[1] = b; } };
    auto wgbar = [&]() { asm volatile("s_waitcnt lgkmcnt(0)" ::: "memory"); __builtin_amdgcn_s_barrier(); asm volatile("" ::: "memory"); };
    f32x16 s0, s1;
    auto scores = [&](int j) {
        const LAS unsigned char* Kb = lds + (j & 1) * BUFB;
#pragma unroll
        for (int r = 0; r < 16; ++r) { s0[r] = 0.f; s1[r] = 0.f; }
        const LAS unsigned char* kp0 = Kb + ql * KPITCH + hh * 16; const LAS unsigned char* kp1 = Kb + (32 + ql) * KPITCH + hh * 16;
        bf16x8 k0c = *(const LAS bf16x8*)kp0, k1c = *(const LAS bf16x8*)kp1;
#pragma unroll
        for (int ks = 0; ks < 12; ++ks) {
            bf16x8 k0n = k0c, k1n = k1c;
            if (ks < 11) { k0n = *(const LAS bf16x8*)(kp0 + (ks + 1) * 32); k1n = *(const LAS bf16x8*)(kp1 + (ks + 1) * 32); }
            __builtin_amdgcn_sched_barrier(0);
            s0 = __builtin_amdgcn_mfma_f32_32x32x16_bf16(k0c, qf[ks], s0, 0, 0, 0);
            s1 = __builtin_amdgcn_mfma_f32_32x32x16_bf16(k1c, qf[ks], s1, 0, 0, 0);
            __builtin_amdgcn_sched_barrier(0);
            k0c = k0n; k1c = k1n;
        }
        float mx = s0[0];
#pragma unroll
        for (int r = 0; r < 16; ++r) { mx = fmaxf(mx, s0[r]); mx = fmaxf(mx, s1[r]); }
        mx = fmaxf(mx, shx(mx, 32, lane));
        const bool grow = (mx - m_run) * SL > 8.0f;
        if (__builtin_amdgcn_ballot_w64(grow) != 0ull) {
            const float m_new = grow ? mx : m_run; const float alpha = exp2f((m_run - m_new) * SL); m_run = m_new;
            l_run *= alpha;
#pragma unroll
            for (int db = 0; db < 4; ++db)
#pragma unroll
                for (int r = 0; r < 16; ++r) oacc[db][r] *= alpha;
        }
    };
    auto pv = [&](int j) {
        { float ps = 0.f; const float mb = m_run * SL;
#pragma unroll
          for (int r = 0; r < 16; ++r) { s0[r] = exp2f(s0[r] * SL - mb); s1[r] = exp2f(s1[r] * SL - mb); ps += s0[r] + s1[r]; }
          l_run += ps; }
        const LAS unsigned char* vbase = lds + (j & 1) * BUFB + VOFF + ql * VPITCH + hh * 8;
        bf16x8 vc = read_perm(vbase);
#pragma unroll
        for (int it = 0; it < 16; ++it) {
            const int kb = it >> 3, sp = (it >> 2) & 1, db = it & 3;
            bf16x8 vn = vc;
            if (it < 15) { const int kb2 = (it + 1) >> 3, sp2 = ((it + 1) >> 2) & 1, db2 = (it + 1) & 3; vn = read_perm(vbase + db2 * 32 * VPITCH + (32 * kb2 + 16 * sp2) * 2); }
            const bf16x8 pf = pack8(kb == 0 ? s0 : s1, sp);
            __builtin_amdgcn_sched_barrier(0);
            if (db == 0) oacc[0] = __builtin_amdgcn_mfma_f32_32x32x16_bf16(vc, pf, oacc[0], 0, 0, 0);
            if (db == 1) oacc[1] = __builtin_amdgcn_mfma_f32_32x32x16_bf16(vc, pf, oacc[1], 0, 0, 0);
            if (db == 2) oacc[2] = __builtin_amdgcn_mfma_f32_32x32x16_bf16(vc, pf, oacc[2], 0, 0, 0);
            if (db == 3) oacc[3] = __builtin_amdgcn_mfma_f32_32x32x16_bf16(vc, pf, oacc[3], 0, 0, 0);
            __builtin_amdgcn_sched_barrier(0);
            vc = vn;
        }
    };
    issueK(0); issueV(0); commitK(0); commitV(0); wgbar();
    if (!grpB) {
        for (int m = 0; m < ntile; ++m) {
            if (m >= 1) commitV(m & 1);
            if (m + 1 < ntile) issueK(m + 1);
            scores(m);
            wgbar();
            if (m + 1 < ntile) { commitK((m + 1) & 1); issueV(m + 1); }
            pv(m);
            wgbar();
        }
        wgbar();
    } else {
        if (1 < ntile) issueK(1);
        wgbar();
        for (int m = 0; m < ntile; ++m) {
            if (m + 1 < ntile) { commitK((m + 1) & 1); issueV(m + 1); }
            scores(m);
            wgbar();
            if (m + 1 < ntile) commitV((m + 1) & 1);
            if (m + 2 < ntile) issueK(m + 2);
            pv(m);
            wgbar();
        }
    }
    const float linv = 1.0f / (l_run + shx(l_run, 32, lane));
    bf16_t* orow = Op + (size_t)(wid * 32 + ql) * 1024 + h * 128;
#pragma unroll
    for (int db = 0; db < 4; ++db)
#pragma unroll
        for (int g = 0; g < 4; ++g) { u32x2 w; w.x = pk2(oacc[db][4 * g] * linv, oacc[db][4 * g + 1] * linv); w.y = pk2(oacc[db][4 * g + 2] * linv, oacc[db][4 * g + 3] * linv);
            *(u32x2*)(orow + db * 32 + g * 8 + hh * 4) = w; }
    __syncthreads();
}

DI void gla_item(LAS unsigned char* lds, const bf16_t* Zseq, int len, int h, int dir, const float* gw, const float* gb,
                 const float* Sin, float* Sout, bf16_t* Oseq) {
    constexpr int QP = 272, KDP = 144, VP = 144;
    LAS unsigned char* QE = lds; LAS unsigned char* KE = lds + 17408; LAS unsigned char* KDT = lds + 34816; LAS unsigned char* VT = lds + 53248;
    LAS float* LR = (LAS float*)(lds + 90112); LAS float* SEG = (LAS float*)(lds + 94208); LAS float* DEC = (LAS float*)(lds + 96256);
    int tid = threadIdx.x; asm volatile("" : "+v"(tid));
    const int wid = tid >> 6, lane = tid & 63, ql = lane & 31, hh = lane >> 5, d = tid & 127, part = tid >> 7;
    float gwr[16];
#pragma unroll
    for (int j = 0; j < 16; ++j) gwr[j] = gw[j * 512 + h * 128 + d];
    const float gbr = gb[h * 128 + d];
    f32x16 S[4];
#pragma unroll
    for (int db = 0; db < 4; ++db)
#pragma unroll
        for (int r = 0; r < 16; ++r) S[db][r] = Sin ? Sin[(size_t)(32 * db + (r & 3) + 8 * (r >> 2) + 4 * hh) * 256 + 32 * wid + ql] : 0.f;
    const int lrcol = dir ? ZC_LRB : ZC_LRF;
    for (int n0 = 0; n0 < len; n0 += 64) {
#pragma unroll
        for (int i = 0; i < 2; ++i) { const int e = tid + 512 * i, row = e >> 4, j = e & 15; const int t = dir ? len - 1 - (n0 + row) : n0 + row;
            LR[e] = bf2f(Zseq[(size_t)t * ZLD + lrcol + j]); }
#pragma unroll
        for (int i = 0; i < 4; ++i) { const int cidx = tid + 512 * i, row = cidx & 63, c8 = cidx >> 6; const int t = dir ? len - 1 - (n0 + row) : n0 + row;
            const u32x4 v = *(const u32x4*)(Zseq + (size_t)t * ZLD + ZC_V + h * 256 + c8 * 8);
            LAS bf16_t* vp = (LAS bf16_t*)(VT + (c8 * 8) * VP + row * 2);
            const unsigned v0 = v.x, v1 = v.y, v2 = v.z, v3 = v.w;
            vp[0 * (VP / 2)] = (bf16_t)v0; vp[1 * (VP / 2)] = (bf16_t)(v0 >> 16); vp[2 * (VP / 2)] = (bf16_t)v1; vp[3 * (VP / 2)] = (bf16_t)(v1 >> 16);
            vp[4 * (VP / 2)] = (bf16_t)v2; vp[5 * (VP / 2)] = (bf16_t)(v2 >> 16); vp[6 * (VP / 2)] = (bf16_t)v3; vp[7 * (VP / 2)] = (bf16_t)(v3 >> 16); }
        bf16_t qraw[16], kraw[16];
#pragma unroll
        for (int ii = 0; ii < 16; ++ii) { const int row = part * 16 + ii; const int t = dir ? len - 1 - (n0 + row) : n0 + row;
            qraw[ii] = Zseq[(size_t)t * ZLD + ZC_Q + h * 128 + d]; kraw[ii] = Zseq[(size_t)t * ZLD + ZC_K + h * 128 + d]; }
        __syncthreads();
        float bl[16]; float run = 0.f;
#pragma unroll
        for (int ii = 0; ii < 16; ++ii) { float z = gbr;
#pragma unroll
            for (int j = 0; j < 16; ++j) z += LR[(part * 16 + ii) * 16 + j] * gwr[j];
            run += (fminf(z, 0.f) - __logf(1.0f + __expf(-fabsf(z)))) * 0.0625f; bl[ii] = run; }
        SEG[part * 128 + d] = run;
        __syncthreads();
        float off = 0.f, blast = 0.f;
#pragma unroll
        for (int pp = 0; pp < 4; ++pp) { const float sg = SEG[pp * 128 + d]; off += (pp < part) ? sg : 0.f; blast += sg; }
        if (part == 0) DEC[d] = __expf(blast);
        unsigned kdp[8];
#pragma unroll
        for (int ii = 0; ii < 16; ++ii) { const int row = part * 16 + ii; const float b = off + bl[ii];
            const float qv = bf2f(qraw[ii]), kv = bf2f(kraw[ii]);
            *(LAS bf16_t*)(QE + row * QP + d * 2) = f2bf(qv * __expf(b));
            *(LAS bf16_t*)(KE + row * QP + d * 2) = f2bf(kv * __expf(-b));
            const unsigned kd = f2bf(kv * __expf(blast - b));
            if (ii & 1) kdp[ii >> 1] |= kd << 16; else kdp[ii >> 1] = kd; }
        { u32x4 a; a.x = kdp[0]; a.y = kdp[1]; a.z = kdp[2]; a.w = kdp[3]; u32x4 b; b.x = kdp[4]; b.y = kdp[5]; b.z = kdp[6]; b.w = kdp[7];
          *(LAS u32x4*)(KDT + d * KDP + part * 32) = a; *(LAS u32x4*)(KDT + d * KDP + part * 32 + 16) = b; }
        __syncthreads();
        f32x16 att00, att01, att11, o0, o1;
#pragma unroll
        for (int r = 0; r < 16; ++r) { att00[r] = 0.f; att01[r] = 0.f; att11[r] = 0.f; o0[r] = 0.f; o1[r] = 0.f; }
#pragma unroll
        for (int ks = 0; ks < 8; ++ks) {
            const int co = (ks * 16 + hh * 8) * 2;
            const bf16x8 kf0 = *(const LAS bf16x8*)(KE + ql * QP + co), kf1 = *(const LAS bf16x8*)(KE + (32 + ql) * QP + co);
            const bf16x8 qf0 = *(const LAS bf16x8*)(QE + ql * QP + co), qf1 = *(const LAS bf16x8*)(QE + (32 + ql) * QP + co);
            att00 = __builtin_amdgcn_mfma_f32_32x32x16_bf16(kf0, qf0, att00, 0, 0, 0);
            att01 = __builtin_amdgcn_mfma_f32_32x32x16_bf16(kf0, qf1, att01, 0, 0, 0);
            att11 = __builtin_amdgcn_mfma_f32_32x32x16_bf16(kf1, qf1, att11, 0, 0, 0);
            if (ks & 1) __builtin_amdgcn_sched_barrier(0);
        }
#pragma unroll
        for (int r = 0; r < 16; ++r) { const int srow = (r & 3) + 8 * (r >> 2) + 4 * hh; if (srow > ql) { att00[r] = 0.f; att11[r] = 0.f; } }
        const LAS unsigned char* vrow = VT + (32 * wid + ql) * VP + hh * 8;
#pragma unroll
        for (int sp = 0; sp < 2; ++sp) {
            const bf16x8 va = read_perm(vrow + (16 * sp) * 2), vb = read_perm(vrow + (32 + 16 * sp) * 2);
            o0 = __builtin_amdgcn_mfma_f32_32x32x16_bf16(va, pack8(att00, sp), o0, 0, 0, 0);
            o1 = __builtin_amdgcn_mfma_f32_32x32x16_bf16(va, pack8(att01, sp), o1, 0, 0, 0);
            o1 = __builtin_amdgcn_mfma_f32_32x32x16_bf16(vb, pack8(att11, sp), o1, 0, 0, 0);
        }
#pragma unroll
        for (int db = 0; db < 4; ++db)
#pragma unroll
            for (int sp = 0; sp < 2; ++sp) {
                const bf16x8 sa = pack8(S[db], sp);
                const int co = (32 * db + 16 * sp + 4 * hh) * 2;
                const bf16x8 qb0 = read_perm(QE + ql * QP + co), qb1 = read_perm(QE + (32 + ql) * QP + co);
                o0 = __builtin_amdgcn_mfma_f32_32x32x16_bf16(sa, qb0, o0, 0, 0, 0);
                o1 = __builtin_amdgcn_mfma_f32_32x32x16_bf16(sa, qb1, o1, 0, 0, 0);
                if (sp) __builtin_amdgcn_sched_barrier(0);
            }
#pragma unroll
        for (int db = 0; db < 4; ++db) {
#pragma unroll
            for (int g4 = 0; g4 < 4; ++g4) { const f32x4 dc = *(const LAS f32x4*)(DEC + 32 * db + 8 * g4 + 4 * hh);
#pragma unroll
                for (int i = 0; i < 4; ++i) S[db][4 * g4 + i] *= dc[i]; }
#pragma unroll
            for (int ks = 0; ks < 4; ++ks) {
                const bf16x8 af = *(const LAS bf16x8*)(KDT + (32 * db + ql) * KDP + (16 * ks + 8 * hh) * 2);
                const bf16x8 bv = *(const LAS bf16x8*)(VT + (32 * wid + ql) * VP + (16 * ks + 8 * hh) * 2);
                S[db] = __builtin_amdgcn_mfma_f32_32x32x16_bf16(af, bv, S[db], 0, 0, 0);
            }
            __builtin_amdgcn_sched_barrier(0);
        }
#pragma unroll
        for (int tb = 0; tb < 2; ++tb) { const int row = 32 * tb + ql; const int t = dir ? len - 1 - (n0 + row) : n0 + row;
            bf16_t* op = Oseq + (size_t)t * 1024 + h * 256 + 32 * wid + 4 * hh;
#pragma unroll
            for (int g4 = 0; g4 < 4; ++g4) { u32x2 w2;
                if (tb == 0) { w2.x = pk2(o0[4 * g4], o0[4 * g4 + 1]); w2.y = pk2(o0[4 * g4 + 2], o0[4 * g4 + 3]); }
                else { w2.x = pk2(o1[4 * g4], o1[4 * g4 + 1]); w2.y = pk2(o1[4 * g4 + 2], o1[4 * g4 + 3]); }
                *(u32x2*)(op + 8 * g4) = w2; } }
        __syncthreads();
    }
    if (Sout) {
#pragma unroll
        for (int db = 0; db < 4; ++db)
#pragma unroll
            for (int r = 0; r < 16; ++r) Sout[(size_t)(32 * db + (r & 3) + 8 * (r >> 2) + 4 * hh) * 256 + 32 * wid + ql] = S[db][r]; }
}

DI void phase_glafin(const bf16_t* OF, const bf16_t* OB, const bf16_t* Z, const float* gg, int rows, bf16_t* GF) {
    const int tid_ = ltid(); const int lane = tid_ & 63, wid = tid_ >> 6;
    const float4 g4 = *(const float4*)(gg + lane * 4);
    for (int r = lbid() * 8 + wid; r < rows; r += lgdim() * 8) {
#pragma unroll
        for (int h = 0; h < 4; ++h) {
            const int c = h * 256 + lane * 4;
            const u32x2 a = *(const u32x2*)(OF + (size_t)r * 1024 + c), b = *(const u32x2*)(OB + (size_t)r * 1024 + c), rr = *(const u32x2*)(Z + (size_t)r * ZLD + ZC_R + c);
            const float s0 = lo2f(a.x) + lo2f(b.x), s1 = hi2f(a.x) + hi2f(b.x), s2 = lo2f(a.y) + lo2f(b.y), s3 = hi2f(a.y) + hi2f(b.y);
            const float ss = wave_sum(s0 * s0 + s1 * s1 + s2 * s2 + s3 * s3, lane);
            const float rstd = rsqrtf(ss * (1.0f / 256.0f) + 1e-6f);
            const float r0 = lo2f(rr.x), r1 = hi2f(rr.x), r2 = lo2f(rr.y), r3 = hi2f(rr.y);
            u32x2 o; o.x = pk2(s0 * rstd * g4.x * (r0 * sigmoidf_(r0)), s1 * rstd * g4.y * (r1 * sigmoidf_(r1)));
            o.y = pk2(s2 * rstd * g4.z * (r2 * sigmoidf_(r2)), s3 * rstd * g4.w * (r3 * sigmoidf_(r3)));
            *(u32x2*)(GF + (size_t)r * 1024 + c) = o;
        }
    }
}

DI unsigned fkey(float f) { const unsigned u = __float_as_uint(f); return u ^ ((unsigned)((int)u >> 31) | 0x80000000u); }
DI float unfkey(unsigned k) { return __uint_as_float((k & 0x80000000u) ? (k ^ 0x80000000u) : ~k); }
DI void key_insert(unsigned (&t)[16], unsigned k) {
#pragma unroll
    for (int j = 0; j < 16; ++j) { const unsigned hi = t[j] > k ? t[j] : k; const unsigned lo = t[j] > k ? k : t[j]; t[j] = hi; k = lo; }
}
DI void phase_select(const _Float16* SC, int rows, uint2* ROUTE, unsigned short* EID, LAS unsigned char* lds) {
    const int tid_ = ltid(); const int lane = tid_ & 63, wid = tid_ >> 6;
    LAS float* T = (LAS float*)lds + wid * (64 * 65);
    for (int pbase = (lbid() * 8 + wid) * 64; pbase < rows * 8; pbase += lgdim() * 8 * 64) {
        const int p = pbase + lane;
        unsigned k1[16], k2[16];
#pragma unroll
        for (int j = 0; j < 16; ++j) { k1[j] = 0u; k2[j] = 0u; }
#pragma unroll
        for (int pass = 0; pass < 4; ++pass) {
#pragma unroll
            for (int k = 0; k < 8; ++k) { const int pp = 8 * k + (lane >> 3);
                const h16x8 v = *(const h16x8*)(SC + (size_t)(pbase + pp) * 256 + pass * 64 + (lane & 7) * 8);
                LAS float* tp = T + (8 * (lane & 7)) * 65 + pp;
#pragma unroll
                for (int c = 0; c < 8; ++c) tp[c * 65] = (float)v[c]; }
            for (int f = 0; f < 64; ++f) { const float v = T[f * 65 + lane]; const unsigned key = (fkey(v) & ~127u) | (unsigned)(127 - ((pass & 1) * 64 + f));
                if (pass < 2) key_insert(k1, key); else key_insert(k2, key); }
        }
        float t1[16], t2[16]; unsigned i1p[4] = {0u, 0u, 0u, 0u}, i2p[4] = {0u, 0u, 0u, 0u};
#pragma unroll
        for (int j = 0; j < 16; ++j) { t1[j] = unfkey(k1[j] & ~127u); t2[j] = unfkey(k2[j] & ~127u);
            i1p[j >> 2] |= (127u - (k1[j] & 127u)) << (8 * (j & 3)); i2p[j >> 2] |= (127u - (k2[j] & 127u)) << (8 * (j & 3)); }
        unsigned kc[16];
#pragma unroll
        for (int j = 0; j < 16; ++j) kc[j] = 0u;
#pragma unroll
        for (int a = 0; a < 16; ++a)
#pragma unroll
            for (int b = 0; b < 16; ++b)
                if ((a + 1) * (b + 1) <= 16) key_insert(kc, (fkey(t1[a] + t2[b]) & ~255u) | (unsigned)(a * 16 + b));
        float e[16]; unsigned ei[16]; float mx = -3.0e38f;
#pragma unroll
        for (int j = 0; j < 16; ++j) { const unsigned a = (kc[j] >> 4) & 15u, b = kc[j] & 15u;
            const unsigned wa = (a >> 2) == 0u ? i1p[0] : (a >> 2) == 1u ? i1p[1] : (a >> 2) == 2u ? i1p[2] : i1p[3];
            const unsigned wb = (b >> 2) == 0u ? i2p[0] : (b >> 2) == 1u ? i2p[1] : (b >> 2) == 2u ? i2p[2] : i2p[3];
            ei[j] = (((wa >> (8 * (a & 3u))) & 127u) << 7) | ((wb >> (8 * (b & 3u))) & 127u);
            e[j] = unfkey(kc[j] & ~255u); mx = fmaxf(mx, e[j]); }
        float sum = 0.f;
#pragma unroll
        for (int j = 0; j < 16; ++j) { e[j] = __expf(e[j] - mx); sum += e[j]; }
        const float inv = 1.0f / sum;
        uint2* dst = ROUTE + (size_t)p * 16; unsigned short* de = EID + (size_t)p * 16;
#pragma unroll
        for (int j = 0; j < 16; ++j) { dst[j] = make_uint2(ei[j], __float_as_uint(e[j] * inv)); de[j] = (unsigned short)ei[j]; }
    }
}

DI float dot2u(unsigned a, unsigned b, float acc) { return __builtin_amdgcn_fdot2_f32_bf16(__builtin_bit_cast(bf16x2_t, a), __builtin_bit_cast(bf16x2_t, b), acc, false); }
DI float dot8(const u32x4& a, const u32x4& b, float acc) {
    const unsigned a0 = a.x, a1 = a.y, a2 = a.z, a3 = a.w, b0 = b.x, b1 = b.y, b2 = b.z, b3 = b.w;
    acc = dot2u(a0, b0, acc); acc = dot2u(a1, b1, acc); acc = dot2u(a2, b2, acc); acc = dot2u(a3, b3, acc);
    return acc;
}
template <int CTRL> DI float dppf(float v) { return __builtin_bit_cast(float, __builtin_amdgcn_update_dpp(0, __builtin_bit_cast(int, v), CTRL, 0xF, 0xF, true)); }
typedef float f32x2_t __attribute__((ext_vector_type(2)));
DI void phase_peer_u(const bf16_t* H2, const unsigned short* EID, const unsigned char* PU, int rows, float* PART) {
    const int tid_ = ltid(); const int lane = tid_ & 63, wid = tid_ >> 6, g = lane >> 3, pc = lane & 7;
    const int x = lbid() & 7, gw = (lbid() >> 3) * 8 + wid, nw = (lgdim() >> 3) * 8;
    const unsigned lbase = (unsigned)(x * 128 + pc * 16);
    auto meta = [&](int r, unsigned (&e)[8], u32x4& h0, u32x4& h1) {
        const int rr = r < rows ? r : rows - 1;
        const u32x4* hp = (const u32x4*)(H2 + (unsigned)(rr * 1024 + x * 128 + pc * 16)); h0 = hp[0]; h1 = hp[1];
        const u32x4* ep = (const u32x4*)(EID + (unsigned)(rr * 128 + g * 16)); const u32x4 t0 = ep[0], t1 = ep[1];
        e[0] = t0.x; e[1] = t0.y; e[2] = t0.z; e[3] = t0.w; e[4] = t1.x; e[5] = t1.y; e[6] = t1.z; e[7] = t1.w; };
    auto finish = [&](int r, const u32x4 (&uv)[16], const u32x4& h0, const u32x4& h1) {
        float hf[16];
        { const unsigned a0 = h0.x, a1 = h0.y, a2 = h0.z, a3 = h0.w, b0 = h1.x, b1 = h1.y, b2 = h1.z, b3 = h1.w;
          hf[0] = lo2f(a0); hf[1] = hi2f(a0); hf[2] = lo2f(a1); hf[3] = hi2f(a1); hf[4] = lo2f(a2); hf[5] = hi2f(a2); hf[6] = lo2f(a3); hf[7] = hi2f(a3);
          hf[8] = lo2f(b0); hf[9] = hi2f(b0); hf[10] = lo2f(b1); hf[11] = hi2f(b1); hf[12] = lo2f(b2); hf[13] = hi2f(b2); hf[14] = lo2f(b3); hf[15] = hi2f(b3); }
        float v0 = 0.f, v1 = 0.f;
#pragma unroll
        for (int j = 0; j < 16; ++j) {
            const unsigned w0 = uv[j].x, w1 = uv[j].y, w2 = uv[j].z, w3 = uv[j].w;
            float a = 0.f;
            { const f32x2_t l = __builtin_amdgcn_cvt_pk_f32_fp8((int)w0, false), hh2 = __builtin_amdgcn_cvt_pk_f32_fp8((int)w0, true); a += l[0] * hf[0] + l[1] * hf[1] + hh2[0] * hf[2] + hh2[1] * hf[3]; }
            { const f32x2_t l = __builtin_amdgcn_cvt_pk_f32_fp8((int)w1, false), hh2 = __builtin_amdgcn_cvt_pk_f32_fp8((int)w1, true); a += l[0] * hf[4] + l[1] * hf[5] + hh2[0] * hf[6] + hh2[1] * hf[7]; }
            { const f32x2_t l = __builtin_amdgcn_cvt_pk_f32_fp8((int)w2, false), hh2 = __builtin_amdgcn_cvt_pk_f32_fp8((int)w2, true); a += l[0] * hf[8] + l[1] * hf[9] + hh2[0] * hf[10] + hh2[1] * hf[11]; }
            { const f32x2_t l = __builtin_amdgcn_cvt_pk_f32_fp8((int)w3, false), hh2 = __builtin_amdgcn_cvt_pk_f32_fp8((int)w3, true); a += l[0] * hf[12] + l[1] * hf[13] + hh2[0] * hf[14] + hh2[1] * hf[15]; }
            a += dppf<0xB1>(a); a += dppf<0x4E>(a); a += dppf<0x141>(a);
            v0 = (j < 8 && pc == (j & 7)) ? a : v0; v1 = (j >= 8 && pc == (j & 7)) ? a : v1;
        }
        if (r < rows) { float* pp = PART + (unsigned)((r * 8 + x) * 128 + g * 16 + pc); pp[0] = v0 * 0.03125f; pp[8] = v1 * 0.03125f; } };
    unsigned eA[8], eB[8]; u32x4 hA0, hA1, hB0, hB1;
    meta(gw, eA, hA0, hA1); meta(gw + nw, eB, hB0, hB1);
    for (int r = gw; r < rows; r += 2 * nw) {
        u32x4 uA[16], uB[16];
#pragma unroll
        for (int j = 0; j < 16; ++j) uA[j] = *(const u32x4*)(PU + ((((j & 1) ? (eA[j >> 1] >> 16) : (eA[j >> 1] & 0xffffu)) << 10) + lbase));
#pragma unroll
        for (int j = 0; j < 16; ++j) uB[j] = *(const u32x4*)(PU + ((((j & 1) ? (eB[j >> 1] >> 16) : (eB[j >> 1] & 0xffffu)) << 10) + lbase));
        const u32x4 cA0 = hA0, cA1 = hA1, cB0 = hB0, cB1 = hB1;
        meta(r + 2 * nw, eA, hA0, hA1); meta(r + 3 * nw, eB, hB0, hB1);
        finish(r, uA, cA0, cA1); finish(r + nw, uB, cB0, cB1);
    }
}
DI void phase_peer_w(const float* PART, const uint2* ROUTE, int rows, bf16_t* WG) {
    const int tid_ = ltid(); const int lane = tid_ & 63, wid = tid_ >> 6;
    for (int r = lbid() * 8 + wid; r < rows; r += lgdim() * 8) {
        float a0 = 0.f, a1 = 0.f;
#pragma unroll
        for (int x = 0; x < 8; ++x) { const float* pp = PART + ((size_t)r * 8 + x) * 128; a0 += pp[lane]; a1 += pp[64 + lane]; }
        const float g0 = __uint_as_float(ROUTE[(size_t)r * 128 + lane].y), g1 = __uint_as_float(ROUTE[(size_t)r * 128 + 64 + lane].y);
        WG[(size_t)r * 128 + lane] = f2bf(g0 * 0.5f * a0 * (1.0f + erff(a0 * 0.70710678118654752f)));
        WG[(size_t)r * 128 + 64 + lane] = f2bf(g1 * 0.5f * a1 * (1.0f + erff(a1 * 0.70710678118654752f)));
    }
}
DI void phase_peer_v(const bf16_t* WG, const unsigned short* EID, const unsigned char* PV, const float* mod, int is_ctx, int b0, int rows, bf16_t* X, bool dry) {
    const int tid_ = ltid(); const int lane = tid_ & 63, wid = tid_ >> 6, g = lane >> 3, pc = lane & 7;
    const int x = lbid() & 7, gw = (lbid() >> 3) * 8 + wid, nw = (lgdim() >> 3) * 8;
    const unsigned lbase = (unsigned)(x * 128 + pc * 16);
    const int mydim = x * 128 + pc * 16 + 8 * ((lane >> 5) & 1) + 4 * ((lane >> 4) & 1) + 2 * ((lane >> 3) & 1);
    auto meta = [&](int r, unsigned (&e)[8]) {
        const int rr = r < rows ? r : rows - 1;
        const u32x4* ep = (const u32x4*)(EID + (unsigned)(rr * 128 + g * 16)); const u32x4 t0 = ep[0], t1 = ep[1];
        e[0] = t0.x; e[1] = t0.y; e[2] = t0.z; e[3] = t0.w; e[4] = t1.x; e[5] = t1.y; e[6] = t1.z; e[7] = t1.w; };
    auto wload = [&](int r, unsigned (&w)[8]) {
        const int rr = r < rows ? r : rows - 1;
        const u32x4* wp = (const u32x4*)(WG + (unsigned)(rr * 128 + g * 16)); const u32x4 t0 = wp[0], t1 = wp[1];
        w[0] = t0.x; w[1] = t0.y; w[2] = t0.z; w[3] = t0.w; w[4] = t1.x; w[5] = t1.y; w[6] = t1.z; w[7] = t1.w; };
    auto finish = [&](int r, const u32x4 (&vv)[16], const unsigned (&w)[8]) {
        float o[16];
#pragma unroll
        for (int i = 0; i < 16; ++i) o[i] = 0.f;
#pragma unroll
        for (int j = 0; j < 16; ++j) { const unsigned w0 = vv[j].x, w1 = vv[j].y, w2 = vv[j].z, w3 = vv[j].w; const float wj = (j & 1) ? hi2f(w[j >> 1]) : lo2f(w[j >> 1]);
            { const f32x2_t l = __builtin_amdgcn_cvt_pk_f32_fp8((int)w0, false), h2 = __builtin_amdgcn_cvt_pk_f32_fp8((int)w0, true); o[0] += wj * l[0]; o[1] += wj * l[1]; o[2] += wj * h2[0]; o[3] += wj * h2[1]; }
            { const f32x2_t l = __builtin_amdgcn_cvt_pk_f32_fp8((int)w1, false), h2 = __builtin_amdgcn_cvt_pk_f32_fp8((int)w1, true); o[4] += wj * l[0]; o[5] += wj * l[1]; o[6] += wj * h2[0]; o[7] += wj * h2[1]; }
            { const f32x2_t l = __builtin_amdgcn_cvt_pk_f32_fp8((int)w2, false), h2 = __builtin_amdgcn_cvt_pk_f32_fp8((int)w2, true); o[8] += wj * l[0]; o[9] += wj * l[1]; o[10] += wj * h2[0]; o[11] += wj * h2[1]; }
            { const f32x2_t l = __builtin_amdgcn_cvt_pk_f32_fp8((int)w3, false), h2 = __builtin_amdgcn_cvt_pk_f32_fp8((int)w3, true); o[12] += wj * l[0]; o[13] += wj * l[1]; o[14] += wj * h2[0]; o[15] += wj * h2[1]; } }
        float k8[8], k4[4], k2[2];
#pragma unroll
        for (int i = 0; i < 8; ++i) { const bool up = (lane & 32) != 0; const float send = up ? o[i] : o[i + 8]; k8[i] = (up ? o[i + 8] : o[i]) + shx(send, 32, lane); }
#pragma unroll
        for (int i = 0; i < 4; ++i) { const bool up = (lane & 16) != 0; const float send = up ? k8[i] : k8[i + 4]; k4[i] = (up ? k8[i + 4] : k8[i]) + shx(send, 16, lane); }
#pragma unroll
        for (int i = 0; i < 2; ++i) { const bool up = (lane & 8) != 0; const float send = up ? k4[i] : k4[i + 2]; k2[i] = (up ? k4[i + 2] : k4[i]) + dppf<0x128>(send); }
        if (dry && k2[0] != 12345.678f) return;
        if (r < rows) {
            const int bi = is_ctx ? 32 : b0 + (r >> 11);
            const float2 m = *(const float2*)(mod + (unsigned)(bi * 6144 + 5 * 1024 + mydim));
            unsigned* xr = (unsigned*)(X + (unsigned)(r * 1024 + mydim)); const unsigned xw = *xr; *xr = pk2(lo2f(xw) + m.x * k2[0], hi2f(xw) + m.y * k2[1]);
        } };
    unsigned eA[8];
    meta(gw, eA);
    for (int r = gw; r < rows; r += nw) {
        u32x4 vA[16]; unsigned wA[8];
#pragma unroll
        for (int j = 0; j < 16; ++j) vA[j] = *(const u32x4*)(PV + ((((j & 1) ? (eA[j >> 1] >> 16) : (eA[j >> 1] & 0xffffu)) << 10) + lbase));
        wload(r, wA);
        meta(r + nw, eA);
        finish(r, vA, wA);
    }
}

DI void phase_final(const bf16_t* xb, float* out, const float* gain, int rows) {
    const int tid_ = ltid(); const int lane = tid_ & 63, wid = tid_ >> 6;
    for (int r = lbid() * 8 + wid; r < rows; r += lgdim() * 8) {
        float4 v[4]; float ss = 0.f;
#pragma unroll
        for (int j = 0; j < 4; ++j) { const u32x2 w = ((const u32x2*)(xb + (size_t)r * 1024))[lane + 64 * j]; v[j] = make_float4(lo2f(w.x), hi2f(w.x), lo2f(w.y), hi2f(w.y));
            ss += v[j].x * v[j].x + v[j].y * v[j].y + v[j].z * v[j].z + v[j].w * v[j].w; }
        ss = wave_sum(ss, lane);
        const float rstd = rsqrtf(ss * (1.0f / 1024.0f) + 1e-6f);
        float4* orow = (float4*)(out + (size_t)r * 1024);
#pragma unroll
        for (int j = 0; j < 4; ++j) { const float4 g = *(const float4*)(gain + (lane + 64 * j) * 4);
            float4 o; o.x = v[j].x * rstd * g.x; o.y = v[j].y * rstd * g.y; o.z = v[j].z * rstd * g.z; o.w = v[j].w * rstd * g.w; orow[lane + 64 * j] = o; }
    }
}

enum { PH_NORM1 = 0, PH_INPROJ, PH_PREP, PH_UPPROJ, PH_MIX, PH_GLAFIN, PH_BRANCH, PH_WOUT, PH_NORM2, PH_WQ, PH_SELECT, PH_PEERU, PH_PEERW, PH_PEERV, PH_COUNT };

struct RunArgs { int mode;
                 int layer, chunk, phase; };

struct Bufs { bf16_t *H, *Z, *QB, *KN, *VT, *KR, *OF, *OB, *MLA, *PD, *PO, *GF, *MMB, *PQ; float *RS, *MMF, *CST, *PART; _Float16* SC; bf16_t* WG; unsigned short* EID; uint2* ROUTE; const bf16_t* W; const float* mod; unsigned* ctl; };
DI Bufs make_bufs(const Params& P, int is_ctx, int layer) {
    __attribute__((address_space(1))) unsigned char* gws = (__attribute__((address_space(1))) unsigned char*)P.ws; asm volatile("" : "+s"(gws));
    unsigned char* ws = (unsigned char*)gws; asm volatile("" : "+s"(layer));
    Bufs B;
    B.H = (bf16_t*)(ws + WS_H); B.Z = (bf16_t*)(ws + WS_Z); B.QB = (bf16_t*)(ws + WS_QB);
    B.KN = (bf16_t*)(ws + (is_ctx ? WS_CKN : WS_KN)); B.VT = (bf16_t*)(ws + (is_ctx ? WS_CVT : WS_VT)); B.KR = (bf16_t*)(ws + (is_ctx ? WS_CKR : WS_KR));
    B.RS = (float*)(ws + WS_RS); B.OF = (bf16_t*)(ws + WS_OF); B.OB = (bf16_t*)(ws + WS_OB); B.MLA = (bf16_t*)(ws + WS_MLA);
    B.PD = (bf16_t*)(ws + WS_PD); B.PO = (bf16_t*)(ws + WS_PO); B.GF = B.PO; B.MMF = (float*)(ws + WS_OF); B.MMB = (bf16_t*)(ws + WS_VT);
    B.PQ = B.QB; B.SC = (_Float16*)(ws + WS_Z); B.ROUTE = (uint2*)(ws + WS_ROUTE); B.PART = (float*)(ws + WS_Z + 128 * MiB); B.WG = (bf16_t*)(ws + WS_Z + 192 * MiB); B.EID = (unsigned short*)(ws + WS_Z + 200 * MiB); B.CST = (float*)(ws + WS_CST);
    B.W = (const bf16_t*)(ws + WS_W) + (size_t)layer * W_LAYER; B.mod = (const float*)(ws + WS_MOD) + (size_t)layer * 33 * 6144; B.ctl = (unsigned*)(ws + WS_CTL);
    return B;
}

DI Params kparams() {
    Params P;
#if defined(__HIP_DEVICE_COMPILE__)
    typedef const void* cvp; typedef const __attribute__((address_space(1))) void* gvp;
    const __attribute__((address_space(4))) gvp* q = (const __attribute__((address_space(4))) gvp*)__builtin_amdgcn_kernarg_segment_ptr();
    asm volatile("" : "+s"(q));
#pragma unroll
    for (int i = 0; i < (int)(sizeof(Params) / sizeof(void*)); ++i) ((cvp*)&P)[i] = (cvp)q[i];
#endif
    return P;
}

__global__ void __launch_bounds__(NTHR, 2) fwd_kernel(Params Pk, RunArgs R) {
    extern __shared__ __attribute__((aligned(16))) unsigned char smem[];
    LAS unsigned char* lds = (LAS unsigned char*)smem;
    LAS unsigned* ctlw = (LAS unsigned*)(lds + LDS_BYTES - 64);
    unsigned* ctl = (unsigned*)(Pk.ws + WS_CTL);
    if (threadIdx.x == 0) { ctlw[0] = 0u; ctlw[1] = 0u; ctlw[2] = 0u; ctlw[3] = 0u; }
    __syncthreads();
    XcdBarrier bar; bar.bar = ctl; bar.x = 0; bar.st = (volatile LAS unsigned*)ctlw;
    const bool single = (R.mode == 0);
    if (single) bar = xcd_barrier_post(ctl, (volatile LAS unsigned*)ctlw);
#define GRID_SYNC() do { if (single) xcd_barrier(bar); } while (0)

    if (R.mode == 0 || R.mode == 1) for (int rep_ = 0; rep_ < ((REP_PHASE) == 100 ? 2 : 1); ++rep_) { const Params P = kparams(); phase_convert(P, lds); phase_mod(P, lds); __syncthreads(); }
    GRID_SYNC();

    if (R.mode == 0 || R.mode == 2) {
    const int l_lo = single ? 0 : R.layer, l_hi = single ? NLAYER : R.layer + 1;
    const int c_lo = single ? 0 : R.chunk, c_hi = single ? 5 : R.chunk + 1;
    for (int layer = l_lo; layer < l_hi; ++layer)
    for (int ci = c_lo; ci < c_hi; ++ci) {
        const bool is_ctx = (ci == 0);
        const bool ctx_kv_only = is_ctx && layer == NLAYER - 1;
#define RUN(ph) (single || lnd(R.phase) == (ph))
#define REP(ph) for (int rep_ = 0; rep_ < (((REP_PHASE) == (ph) || (REP_PHASE) == 999) ? 2 : 1); ++rep_)
#define PHASE_LOCALS const Params P = kparams(); const Chunk ck = make_chunk(P, layer, ci); const Bufs B = make_bufs(P, ck.is_ctx, layer); const int rows = ck.rows, np = ck.np; (void)rows; (void)np;

        if ((REP_PHASE) == 200) { for (int xb = 0; xb < 10; ++xb) GRID_SYNC(); }
        if (RUN(PH_NORM1)) REP(PH_NORM1) { PHASE_LOCALS if (layer == 0) phase_norm<true>(ck.x32, rows, P.norm1_g + layer * 1024, B.mod, ck.is_ctx, ck.b0, 0, B.H); else phase_norm<false>(ck.xb, rows, P.norm1_g + layer * 1024, B.mod, ck.is_ctx, ck.b0, 0, B.H); }
        GRID_SYNC();
        if (RUN(PH_INPROJ)) REP(PH_INPROJ) { PHASE_LOCALS
            const bf16_t* H = B.H; const bf16_t* W = B.W; bf16_t* Z = B.Z;
            auto S = make_sched(np, ZLD / 256, [=](Unit& u) { u.A = (const char*)(H + (size_t)u.pm * 256 * 1024); u.B = (const char*)(W + WO_IN + (size_t)u.pn * 256 * 1024); });
            pg8::gemm_phase(lds, 1024, 1024, 1024, S, [=](const f32x4 (&acc)[2][2][4][2], const Unit& u, int wr, int wc, int fr, int fq) {
                const bool is_gate = (u.pn >= ZC_GZ / 256) && (u.pn < (ZC_GZ + 3072) / 256);
                pg8::epi8(acc, wr, wc, fr, fq, [&](int row, int col, const f32x4& a, const f32x4& b) {
                    f32x4 a2 = a, b2 = b;
                    if (is_gate) {
#pragma unroll
                        for (int j = 0; j < 4; ++j) { a2[j] = sigmoidf_(a[j]); b2[j] = sigmoidf_(b[j]); } }
                    store8_bf16(Z + (size_t)(u.pm * 256 + row) * ZLD + u.pn * 256 + col, a2, b2); }); });
        }
        GRID_SYNC();
        if (RUN(PH_PREP)) REP(PH_PREP) { PHASE_LOCALS phase_prep(B.Z, rows, ck.is_ctx, B.RS, B.KR, B.PD, !ctx_kv_only, (const float2*)(P.ws + WS_ROPE)); }
        GRID_SYNC();
        if (RUN(PH_UPPROJ)) REP(PH_UPPROJ) {
            if (!ctx_kv_only) { PHASE_LOCALS
                const bf16_t* Z = B.Z; const bf16_t* W = B.W; bf16_t* QB = B.QB; const float* RS = B.RS;
                auto S = make_sched(np, 6, [=](Unit& u) { u.A = (const char*)(Z + (size_t)u.pm * 256 * ZLD + ZC_QDN); u.B = (const char*)(W + WO_UQ + (size_t)u.pn * 256 * 384); });
                pg8::gemm_phase(lds, ZLD, 384, 384, S, [=](const f32x4 (&acc)[2][2][4][2], const Unit& u, int wr, int wc, int fr, int fq) {
                    pg8::epi8(acc, wr, wc, fr, fq, [&](int row, int col, const f32x4& a, const f32x4& b) { const int gr = u.pm * 256 + row; const float s = RS[gr];
                        store8_bf16(QB + (size_t)gr * 1536 + u.pn * 256 + col, a * s, b * s); }); });
            }
            { PHASE_LOCALS
                const bf16_t* Z = B.Z; const bf16_t* W = B.W; bf16_t* KN = B.KN; const float* RS = B.RS;
                auto S = make_sched(np, 4, [=](Unit& u) { u.A = (const char*)(Z + (size_t)u.pm * 256 * ZLD + ZC_KVDN); u.B = (const char*)(W + WO_KN + (size_t)u.pn * 256 * 256); });
                pg8::gemm_phase(lds, ZLD, 256, 256, S, [=](const f32x4 (&acc)[2][2][4][2], const Unit& u, int wr, int wc, int fr, int fq) {
                    pg8::epi8(acc, wr, wc, fr, fq, [&](int row, int col, const f32x4& a, const f32x4& b) { const int gr = u.pm * 256 + row; const float s = RS[16384 + gr];
                        store8_bf16(KN + (size_t)gr * 1024 + u.pn * 256 + col, a * s, b * s); }); });
            }
            { PHASE_LOCALS
                const bf16_t* Z = B.Z; const bf16_t* W = B.W; bf16_t* VT = B.VT; const float* RS = B.RS;
                auto S = make_sched(4, np, [=](Unit& u) { u.A = (const char*)(W + WO_V + (size_t)u.pm * 256 * 256); u.B = (const char*)(Z + (size_t)u.pn * 256 * ZLD + ZC_KVDN); });
                pg8::gemm_phase(lds, 256, ZLD, 256, S, [=](const f32x4 (&acc)[2][2][4][2], const Unit& u, int wr, int wc, int fr, int fq) {
                    pg8::epi8(acc, wr, wc, fr, fq, [&](int row, int col, const f32x4& a, const f32x4& b) { const int tk = u.pn * 256 + col;
                        const f32x4 r0 = *(const f32x4*)(RS + 16384 + tk), r1 = *(const f32x4*)(RS + 16384 + tk + 4);
                        store8_bf16(VT + (size_t)(u.pm * 256 + row) * rows + tk, a * r0, b * r1); }); });
            }
        }
        GRID_SYNC();
        if (RUN(PH_MIX)) for (int rep_ = 0; rep_ < (((REP_PHASE) == PH_MIX || (REP_PHASE) == 201 || (REP_PHASE) == 202 || (REP_PHASE) == 999) ? 2 : 1); ++rep_) { PHASE_LOCALS
            const int nbat = ck.is_ctx ? NB : 8;
            const int nG = (rep_ != 0 && (REP_PHASE) == 202) ? 0 : nbat * 8;
            const int nA = (rep_ != 0 && (REP_PHASE) == 201) ? 0 : (ck.is_ctx ? (layer == 0 ? NB * 8 : 0) : 8 * 8 * 8);
            unsigned* ctr = B.ctl + CTL_WORKQ + 64 * (layer * 5 + ci) + 64 * 16 * rep_;
            const int seqlen = ck.is_ctx ? TC : TL;
            for (;;) {
                if (ltid() == 0) ctlw[4] = xb_add(ctr, 1u);
                __syncthreads();
                const int item = (int)ctlw[4];
                __syncthreads();
                if (item >= nG + nA) break;
                if (item < nG) {
                    const int dir = item & 1, h = (item >> 1) & 3, bl = item >> 3;
                    const int b = ck.b0 + bl;
                    float* st = B.CST + (size_t)((b * 4 + h) * 2 + dir) * 128 * 256;
                    gla_item(lds, B.Z + (size_t)bl * seqlen * ZLD, seqlen, h, dir, P.gla_gate_w + ((size_t)layer * 2 + dir) * 16 * 512, P.gla_gate_b + ((size_t)layer * 2 + dir) * 512,
                             ck.is_ctx ? nullptr : st, ck.is_ctx ? st : nullptr, (dir ? B.OB : B.OF) + (size_t)bl * seqlen * 1024);
                } else {
                    const int a = item - nG;
                    int h, nt0, nt1, ldv0, tq0; bool rope; const bf16_t *Qp, *kn0, *kr0, *vt0, *kn1, *kr1, *vt1; bf16_t* Op;
                    if (ck.is_ctx) {
                        h = a & 7; const int bl = a >> 3; rope = false; tq0 = 0;
                        Qp = B.QB + (size_t)bl * TC * 1536; kn0 = B.KN + (size_t)bl * TC * 1024; kr0 = B.KR + (size_t)bl * TC * 64; vt0 = B.VT + (size_t)bl * TC; ldv0 = rows; nt0 = TC / 64;
                        kn1 = kn0; kr1 = kr0; vt1 = vt0; nt1 = 0; Op = B.MLA + (size_t)bl * TC * 1024;
                    } else {
                        const int qb = a & 7; h = (a >> 3) & 7; const int bl = a >> 6; const int b = ck.b0 + bl; rope = true; tq0 = qb * 256;
                        const bf16_t* CKN = (const bf16_t*)(P.ws + WS_CKN); const bf16_t* CKR = (const bf16_t*)(P.ws + WS_CKR); const bf16_t* CVT = (const bf16_t*)(P.ws + WS_CVT);
                        Qp = B.QB + (size_t)(bl * TL + qb * 256) * 1536; kn0 = CKN + (size_t)b * TC * 1024; kr0 = CKR + (size_t)b * TC * 64; vt0 = CVT + (size_t)b * TC; ldv0 = NB * TC; nt0 = TC / 64;
                        kn1 = B.KN + (size_t)bl * TL * 1024; kr1 = B.KR + (size_t)bl * TL * 64; vt1 = B.VT + (size_t)bl * TL; nt1 = TL / 64; Op = B.MLA + (size_t)(bl * TL + qb * 256) * 1024;
                    }
                    attn_item(lds, (const float2*)(P.ws + WS_ROPE), Qp, h, rope, tq0, kn0, kr0, vt0, ldv0, nt0, kn1, kr1, vt1, rows, nt1, Op);
                }
            }
        }
        GRID_SYNC();
        if (!ctx_kv_only) {
        if (RUN(PH_GLAFIN)) REP(PH_GLAFIN) { PHASE_LOCALS phase_glafin(B.OF, B.OB, B.Z, P.gla_norm_g + layer * 256, rows, B.GF); }
        GRID_SYNC();
        if (RUN(PH_BRANCH)) REP(PH_BRANCH) { PHASE_LOCALS
            const bf16_t* PO = B.PD; const bf16_t* GF = B.GF; const bf16_t* MLA = B.MLA; const bf16_t* W = B.W; const bf16_t* Z = B.Z; bf16_t* MMS = (bf16_t*)B.MMF; bf16_t* MMB = B.MMB;
            auto fill = [=](Unit& u) { const bf16_t* a = (u.z == 0) ? PO : (u.z == 1) ? GF : MLA;   u.A = (const char*)(a + (size_t)u.pm * 256 * 1024);
                                       u.B = (const char*)(W + WO_BR + (size_t)u.z * 1048576 + (size_t)u.pn * 256 * 1024); };
            TripleSched<decltype(fill)> S{np, 4, lgdim(), lbid(), fill};
            pg8::gemm_phase(lds, 1024, 1024, 1024, S, [=](const f32x4 (&acc)[2][2][4][2], const Unit& u, int wr, int wc, int fr, int fq) {
                pg8::epi8(acc, wr, wc, fr, fq, [&](int row, int col, const f32x4& a, const f32x4& b) {
                    const int gr = u.pm * 256 + row, c = u.pn * 256 + col;
                    const u32x4 gz = *(const u32x4*)(Z + (size_t)gr * ZLD + ZC_GZ + u.z * 1024 + c);
                    f32x4 va, vb;
                    va[0] = a[0] * lo2f(gz.x); va[1] = a[1] * hi2f(gz.x); va[2] = a[2] * lo2f(gz.y); va[3] = a[3] * hi2f(gz.y);
                    vb[0] = b[0] * lo2f(gz.z); vb[1] = b[1] * hi2f(gz.z); vb[2] = b[2] * lo2f(gz.w); vb[3] = b[3] * hi2f(gz.w);
                    bf16_t* mp = MMS + (size_t)gr * 1024 + c;
                    if (u.z != 0) { const u32x4 pm = *(const u32x4*)mp;
                        va[0] += lo2f(pm.x); va[1] += hi2f(pm.x); va[2] += lo2f(pm.y); va[3] += hi2f(pm.y); vb[0] += lo2f(pm.z); vb[1] += hi2f(pm.z); vb[2] += lo2f(pm.w); vb[3] += hi2f(pm.w); }
                    store8_bf16((u.z == 2 ? MMB : mp) + (u.z == 2 ? (size_t)gr * 1024 + c : 0), va, vb); }); });
        }
        GRID_SYNC();
        if (RUN(PH_WOUT)) for (int rep_ = 0; rep_ < (((REP_PHASE) == PH_WOUT || (REP_PHASE) == 999) && layer == 0 ? 2 : 1); ++rep_) { PHASE_LOCALS
            const bf16_t* MMB = B.MMB; const bf16_t* W = B.W; const float* mod = B.mod;
            auto S = make_sched(np, 4, [=](Unit& u) { u.A = (const char*)(MMB + (size_t)u.pm * 256 * 1024); u.B = (const char*)(W + WO_OUT + (size_t)u.pn * 256 * 1024); });
            const float* x32 = ck.x32; bf16_t* xb = ck.xb; const int isc = ck.is_ctx, b0 = ck.b0;
            pg8::gemm_phase(lds, 1024, 1024, 1024, S, [=](const f32x4 (&acc)[2][2][4][2], const Unit& u, int wr, int wc, int fr, int fq) {
                const int bi = isc ? 32 : b0 + (u.pm >> 3);
                const float* g1 = mod + (size_t)bi * 6144 + 2 * 1024;
                pg8::epi8(acc, wr, wc, fr, fq, [&](int row, int col, const f32x4& a, const f32x4& b) {
                    const int c = u.pn * 256 + col; const size_t o = (size_t)(u.pm * 256 + row) * 1024 + c;
                    const f32x4 ga = *(const f32x4*)(g1 + c), gb = *(const f32x4*)(g1 + c + 4);
                    f32x4 xa, xv;
                    if (x32) { xa = *(const f32x4*)(x32 + o); xv = *(const f32x4*)(x32 + o + 4); }
                    else { const u32x4 w = *(const u32x4*)(xb + o); xa[0] = lo2f(w.x); xa[1] = hi2f(w.x); xa[2] = lo2f(w.y); xa[3] = hi2f(w.y); xv[0] = lo2f(w.z); xv[1] = hi2f(w.z); xv[2] = lo2f(w.w); xv[3] = hi2f(w.w); }
                    store8_bf16(xb + o, xa + ga * a, xv + gb * b); }); });
        }
        GRID_SYNC();
        if (RUN(PH_NORM2)) REP(PH_NORM2) { PHASE_LOCALS phase_norm<false>(ck.xb, rows, P.norm2_g + layer * 1024, B.mod, ck.is_ctx, ck.b0, 3, B.H); }
        GRID_SYNC();
        if (RUN(PH_WQ)) REP(PH_WQ) { PHASE_LOCALS
            const bf16_t* H = B.H; const bf16_t* W = B.W; _Float16* SC = B.SC;
            auto S = make_sched(np, 8, [=](Unit& u) { u.A = (const char*)(H + (size_t)u.pm * 256 * 1024); u.B = (const char*)(W + WO_Q + (size_t)u.pn * 256 * 1024); });
            pg8::gemm_phase(lds, 1024, 1024, 1024, S, [=](const f32x4 (&acc)[2][2][4][2], const Unit& u, int wr, int wc, int fr, int fq) {
                pg8::epi8(acc, wr, wc, fr, fq, [&](int row, int col, const f32x4& a, const f32x4& b) {
                    h16x8 hv; hv[0] = (_Float16)a[0]; hv[1] = (_Float16)a[1]; hv[2] = (_Float16)a[2]; hv[3] = (_Float16)a[3]; hv[4] = (_Float16)b[0]; hv[5] = (_Float16)b[1]; hv[6] = (_Float16)b[2]; hv[7] = (_Float16)b[3];
                    *(h16x8*)(SC + (size_t)(u.pm * 256 + row) * 2048 + u.pn * 256 + col) = hv; }); });
        }
        GRID_SYNC();
        if (RUN(PH_SELECT)) REP(PH_SELECT) { PHASE_LOCALS phase_select(B.SC, rows, B.ROUTE, B.EID, lds); }
        GRID_SYNC();
        if (RUN(PH_PEERU)) REP(PH_PEERU) { PHASE_LOCALS phase_peer_u(B.H, B.EID, (const unsigned char*)(B.W + WO_PU), rows, B.PART); }
        GRID_SYNC();
        if (RUN(PH_PEERW)) REP(PH_PEERW) { PHASE_LOCALS phase_peer_w(B.PART, B.ROUTE, rows, B.WG); }
        GRID_SYNC();
        if (RUN(PH_PEERV)) REP(PH_PEERV) { PHASE_LOCALS phase_peer_v(B.WG, B.EID, (const unsigned char*)(B.W + WO_PV), B.mod, ck.is_ctx, ck.b0, rows, ck.xb, rep_ != 0); }
        GRID_SYNC();
        }
    }
    }
    if (R.mode == 0 || R.mode == 3) { const Params P = kparams(); phase_final((const bf16_t*)(P.ws + WS_XL), P.out, P.final_norm_g, NB * TL); }
#undef RUN
#undef GRID_SYNC
#undef PHASE_LOCALS
}

extern "C" void kernel_launch(void* const* d_in, const int* in_sizes, int n_in, void* d_out, int out_size, void* d_ws, size_t ws_size, hipStream_t stream) {
    static int grid = 0;
    if (grid == 0) {
        if (n_in != 25 || ws_size < WS_END) { fprintf(stderr, "kernel_launch: need 25 inputs and %zu bytes of workspace (got %d, %zu)\n", (size_t)WS_END, n_in, ws_size); grid = -1; return; }
        int dev = 0, cus = 0, per_cu = 0;
        if (hipGetDevice(&dev) != hipSuccess || hipDeviceGetAttribute(&cus, hipDeviceAttributeMultiprocessorCount, dev) != hipSuccess) { grid = -1; return; }
        if (hipFuncSetAttribute((const void*)fwd_kernel, hipFuncAttributeMaxDynamicSharedMemorySize, LDS_BYTES) != hipSuccess) { fprintf(stderr, "kernel_launch: hipFuncSetAttribute failed\n"); grid = -1; return; }
        if (hipOccupancyMaxActiveBlocksPerMultiprocessor(&per_cu, (const void*)fwd_kernel, NTHR, LDS_BYTES) != hipSuccess || per_cu < 1) { fprintf(stderr, "kernel_launch: occupancy query says %d\n", per_cu); grid = -1; return; }
        grid = cus;
    }
    if (grid <= 0) return;
    (void)hipMemsetAsync((char*)d_ws + WS_CTL, 0, CTL_BYTES, stream);
    Params P{};
    const float* const* in = (const float* const*)d_in;
    P.x = in[0]; P.c = in[1]; P.ctx = in[2]; P.c_ctx = in[3]; P.ada_w = in[4]; P.ada_b = in[5]; P.norm1_g = in[6]; P.norm2_g = in[7]; P.w_in = in[8]; P.pool_w = in[9];
    P.pool_scale = in[10]; P.gla_gate_w = in[11]; P.gla_gate_b = in[12]; P.gla_norm_g = in[13]; P.mla_q_norm_g = in[14]; P.mla_kv_norm_g = in[15]; P.mla_w_uq = in[16];
    P.mla_w_ukv = in[17]; P.branch_w = in[18]; P.w_out = in[19]; P.peer_wq = in[20]; P.peer_keys = in[21]; P.peer_u = in[22]; P.peer_v = in[23]; P.final_norm_g = in[24];
    P.out = (float*)d_out; P.ws = (unsigned char*)d_ws;
#if MK_SINGLE
    RunArgs R{0, 0, 0, 0};
    hipLaunchKernelGGL(fwd_kernel, dim3(grid), dim3(NTHR), LDS_BYTES, stream, P, R);
#else
    { RunArgs R{1, 0, 0, 0}; hipLaunchKernelGGL(fwd_kernel, dim3(grid), dim3(NTHR), LDS_BYTES, stream, P, R); }
    for (int layer = 0; layer < NLAYER; ++layer)
        for (int ci = 0; ci < 5; ++ci)
            for (int ph = 0; ph < PH_COUNT; ++ph) {
                if (ci == 0 && layer == NLAYER - 1 && ph >= PH_GLAFIN) continue;
                RunArgs R{2, layer, ci, ph}; hipLaunchKernelGGL(fwd_kernel, dim3(grid), dim3(NTHR), LDS_BYTES, stream, P, R); }
    { RunArgs R{3, 0, 0, 0}; hipLaunchKernelGGL(fwd_kernel, dim3(grid), dim3(NTHR), LDS_BYTES, stream, P, R); }
#endif
}
```

```cpp
#include <hip/hip_runtime.h>
#include <stdint.h>
#include <stdio.h>

#ifndef REP_PHASE
#define REP_PHASE -1
#endif
#ifndef MK_SINGLE
#define MK_SINGLE 1
#endif

#define DI __device__ __forceinline__
#define LAS __attribute__((address_space(3)))

typedef unsigned short bf16_t;
typedef short bf16x8 __attribute__((ext_vector_type(8)));
typedef short s16x4 __attribute__((ext_vector_type(4)));
typedef float f32x4 __attribute__((ext_vector_type(4)));
typedef float f32x16 __attribute__((ext_vector_type(16)));
typedef unsigned u32x4 __attribute__((ext_vector_type(4)));
typedef unsigned u32x2 __attribute__((ext_vector_type(2)));
typedef __bf16 bf16x2_t __attribute__((ext_vector_type(2)));
typedef _Float16 h16x8 __attribute__((ext_vector_type(8)));

constexpr int D = 1024, NB = 32, TL = 2048, TC = 256, NLAYER = 2;
constexpr int ZLD = 7936;
constexpr int ZC_P = 0, ZC_Q = 1024, ZC_K = 1536, ZC_V = 2048, ZC_R = 3072, ZC_GZ = 4096, ZC_QDN = 7168, ZC_KVDN = 7552,
              ZC_KROPE = 7808, ZC_LRF = 7872, ZC_LRB = 7888;
constexpr int NEXP = 16384;
constexpr int NWG = 256, NTHR = 512;
constexpr int LDS_BYTES = 147456;

constexpr size_t WO_IN = 0, WO_POOL = WO_IN + (size_t)ZLD * 1024, WO_UQ = WO_POOL + 4 * 256 * 256, WO_KN = WO_UQ + 1536 * 384,
                 WO_V = WO_KN + 1024 * 256, WO_BR = WO_V + 1024 * 256, WO_OUT = WO_BR + 3 * 1024 * 1024, WO_Q = WO_OUT + 1024 * 1024,
                 WO_KEYS = WO_Q + 2048 * 1024, WO_PU = WO_KEYS + 8 * 256 * 256, WO_PV = WO_PU + (size_t)NEXP * 512,
                 W_LAYER = WO_PV + (size_t)NEXP * 512;

constexpr size_t MiB = 1048576;
constexpr size_t WS_CTL = 0;
constexpr size_t CTL_BYTES = 65536;
constexpr size_t WS_MOD = WS_CTL + CTL_BYTES;
constexpr size_t WS_ROPE = WS_MOD + 1792 * 1024;
constexpr size_t WS_W = WS_MOD + 2 * MiB;
constexpr size_t WS_H = WS_W + ((2 * W_LAYER * 2 + 255) / 256) * 256;
constexpr size_t WS_Z = WS_H + 32 * MiB;
constexpr size_t WS_QB = WS_Z + 248 * MiB;
constexpr size_t WS_KN = WS_QB + 48 * MiB;
constexpr size_t WS_VT = WS_KN + 32 * MiB;
constexpr size_t WS_KR = WS_VT + 32 * MiB;
constexpr size_t WS_CKN = WS_KR + 2 * MiB;
constexpr size_t WS_CVT = WS_CKN + 16 * MiB;
constexpr size_t WS_CKR = WS_CVT + 16 * MiB;
constexpr size_t WS_CST = WS_CKR + 1 * MiB;
constexpr size_t WS_RS = WS_CST + 32 * MiB;
constexpr size_t WS_OF = WS_RS + 1 * MiB;
constexpr size_t WS_OB = WS_OF + 32 * MiB;
constexpr size_t WS_MLA = WS_OB + 32 * MiB;
constexpr size_t WS_PD = WS_MLA + 32 * MiB;
constexpr size_t WS_PO = WS_PD + 32 * MiB;
constexpr size_t WS_ROUTE = WS_PO + 32 * MiB;
constexpr size_t WS_XCTX = WS_ROUTE + 16 * MiB;
constexpr size_t WS_XL = WS_XCTX + 16 * MiB;
constexpr size_t WS_END = WS_XL + 128 * MiB;

DI float bf2f(bf16_t b) { return __uint_as_float((unsigned)b << 16); }
DI bf16_t f2bf(float f) { return __builtin_bit_cast(bf16_t, (__bf16)f); }
DI unsigned pk2(float lo, float hi) { bf16x2_t v; v[0] = (__bf16)lo; v[1] = (__bf16)hi; return __builtin_bit_cast(unsigned, v); }
DI float lo2f(unsigned w) { return __uint_as_float(w << 16); }
DI float hi2f(unsigned w) { return __uint_as_float(w & 0xffff0000u); }
DI float shx(float v, int m, int lane) { return __builtin_bit_cast(float, __builtin_amdgcn_ds_bpermute((lane ^ m) << 2, __builtin_bit_cast(int, v))); }
DI float shl(float v, int src) { return __builtin_bit_cast(float, __builtin_amdgcn_ds_bpermute(src << 2, __builtin_bit_cast(int, v))); }
DI float wave_sum(float v, int lane) {
#pragma unroll
    for (int o = 32; o >= 1; o >>= 1) v += shx(v, o, lane);
    return v;
}
DI int ltid() { int t = threadIdx.x; asm volatile("" : "+v"(t)); return t; }
DI int lnd(int x) { asm volatile("" : "+s"(x)); return x; }
DI int lbid() { return lnd((int)blockIdx.x); }
DI int lgdim() { return lnd((int)gridDim.x); }
DI float sigmoidf_(float x) { return 1.0f / (1.0f + __expf(-x)); }

#define XB_TMO      128
#define XB_XCNT(j)  (256  + 64 * (j))
#define XB_XSUB(j)  (1280 + 64 * (j))
#define XB_XGEN(j)  (2304 + 64 * (j))
#define XB_TOP      3328
#define XB_TOPGEN   3392
#define XCD_BAR_WORDS 3456
#define XB_SPIN_CAP (1u << 23)
#define CTL_WORKQ   4096

DI unsigned xb_ld(unsigned* p)              { return __hip_atomic_load(p, __ATOMIC_RELAXED, __HIP_MEMORY_SCOPE_AGENT); }
DI unsigned xb_add(unsigned* p, unsigned v) { return __hip_atomic_fetch_add(p, v, __ATOMIC_RELAXED, __HIP_MEMORY_SCOPE_AGENT); }
DI unsigned xb_xcc_id() { return (unsigned)__builtin_amdgcn_s_getreg((3 << 11) | 20) & 0xFu; }
#define XB_SPIN(cond, bar) do { unsigned _sp = 0; while (cond) { __builtin_amdgcn_s_sleep(1); \
    if ((++_sp & 255u) == 0u) { if (xb_ld(&(bar)[XB_TMO])) break; if (_sp > XB_SPIN_CAP) { atomicAdd(&(bar)[XB_TMO], 1u); break; } } } } while (0)

struct XcdBarrier { unsigned* bar; unsigned x; volatile LAS unsigned* st; };

DI XcdBarrier xcd_barrier_post(unsigned* bar, volatile LAS unsigned* st) {
    XcdBarrier b; b.bar = bar; b.x = xb_xcc_id(); b.st = st;
    if (threadIdx.x == 0) (void)xb_add(&bar[XB_XCNT(b.x)], 1u);
    return b;
}
DI void xcd_barrier_complete(unsigned* bar, unsigned x, unsigned& nloc, unsigned& nx) {
    const unsigned G = gridDim.x * gridDim.y * gridDim.z;
    unsigned sum, cnt, mine, sp = 0u;
    for (;;) {
        sum = 0u; cnt = 0u; mine = 0u;
#pragma unroll
        for (unsigned j = 0; j < 16; ++j) { const unsigned c = xb_ld(&bar[XB_XCNT(j)]); sum += c; cnt += (c > 0u) ? 1u : 0u; mine = (j == x) ? c : mine; }
        if (sum == G) break;
        __builtin_amdgcn_s_sleep(1);
        if ((++sp & 255u) == 0u) { if (xb_ld(&bar[XB_TMO])) break; if (sp > XB_SPIN_CAP) { atomicAdd(&bar[XB_TMO], 1u); break; } }
    }
    nloc = mine > 0u ? mine : 1u; nx = cnt > 0u ? cnt : 1u;
}
DI void xcd_barrier(const XcdBarrier& b) {
    asm volatile("s_waitcnt vmcnt(0)" ::: "memory");
    __syncthreads();
    if (threadIdx.x == 0) {
        __attribute__((address_space(1))) unsigned* gbar = (__attribute__((address_space(1))) unsigned*)b.bar; asm volatile("" : "+s"(gbar)); unsigned* bar = (unsigned*)gbar;
        unsigned bx = b.x; asm volatile("" : "+s"(bx));
        __builtin_amdgcn_s_waitcnt(0);
        unsigned nloc = b.st[0], nx = b.st[1];
        if (nloc == 0u) { xcd_barrier_complete(bar, bx, nloc, nx); b.st[0] = nloc; b.st[1] = nx; }
        const unsigned old = xb_add(&bar[XB_XSUB(bx)], 1u);
        const unsigned gen = old / nloc;
        if (old + 1u == (gen + 1u) * nloc) {
            __builtin_amdgcn_fence(__ATOMIC_RELEASE, "agent");
            asm volatile("s_waitcnt vmcnt(0)" ::: "memory");
            const unsigned og = xb_add(&bar[XB_TOP], 1u);
            const unsigned tg = og / nx;
            if (og + 1u == (tg + 1u) * nx) xb_add(&bar[XB_TOPGEN], 1u);
            else XB_SPIN(xb_ld(&bar[XB_TOPGEN]) == tg, bar);
            __builtin_amdgcn_fence(__ATOMIC_ACQUIRE, "agent");
            xb_add(&bar[XB_XGEN(bx)], 1u);
            asm volatile("s_waitcnt vmcnt(0)" ::: "memory");
        } else {
            XB_SPIN(xb_ld(&bar[XB_XGEN(bx)]) == gen, bar);
            __builtin_amdgcn_fence(__ATOMIC_ACQUIRE, "agent");
            asm volatile("s_waitcnt vmcnt(0)" ::: "memory");
        }
    }
    __syncthreads();
}

namespace pg8 {
constexpr int BM = 256, BK = 64, HALF = 128, HTB = HALF * BK * 2, STAGE_BYTES = 8 * HTB, NXCD = 8, WGM = 8;
DI int lds_byte(int r, int c) { const int st = (r >> 4) * 2 + (c >> 5), rr = r & 15, cc = c & 31, ob = rr * 64 + cc * 2; return st * 1024 + (ob ^ (((ob >> 9) & 1) << 5)); }
DI void stage_rc(int b, int& R, int& C) { const int st = b / 1024, sb = b % 1024, swz = sb ^ (((sb >> 9) & 1) << 5); R = (st >> 1) * 16 + swz / 64; C = (st & 1) * 32 + (swz % 64) / 2; }
DI int perm32(int rho) { const int n = rho >> 4, i = rho & 15; return 8 * (i >> 2) + 4 * n + (i & 3); }

struct Unit { const char* A; const char* B; int pm, pn, z; };

DI void tile_of(int L, int nM, int nN, int& pm, int& pn) {
    const int nwg = nM * nN; int wgid = L;
    { const int q = nwg / NXCD, r = nwg % NXCD, xcd = wgid % NXCD, off = wgid / NXCD; wgid = (xcd < r ? xcd * (q + 1) : r * (q + 1) + (xcd - r) * q) + off; }
    const int nig = WGM * nN, gid = wgid / nig, fm = gid * WGM, gsz = (nM - fm) < WGM ? (nM - fm) : WGM;
    pm = fm + ((wgid % nig) % gsz); pn = (wgid % nig) / gsz;
}

template <class F> DI void epi8(const f32x4 (&acc)[2][2][4][2], int wr, int wc, int fr, int fq, F f) {
#pragma unroll
    for (int ai = 0; ai < 2; ++ai)
#pragma unroll
        for (int m = 0; m < 4; ++m) {
            const int row = ai * HALF + wr * 64 + m * 16 + fr;
#pragma unroll
            for (int bj = 0; bj < 2; ++bj) f(row, bj * HALF + wc * 32 + 8 * fq, acc[ai][bj][m][0], acc[ai][bj][m][1]);
        }
}

template <class Epi, class Sched>
DI void gemm_phase(LAS unsigned char* lds, const int lda, const int ldb, const int K, const Sched& S, const Epi& E) {
    int tid = threadIdx.x; asm volatile("" : "+v"(tid));
    const int wid = __builtin_amdgcn_readfirstlane(tid >> 6), lane = tid & 63, wr = wid >> 2, wc = wid & 3, fr = lane & 15, fq = lane >> 4;
    const int nt = K / BK;
    unsigned voffA[2], voffB[2];
#pragma unroll
    for (int i = 0; i < 2; ++i) { int R, C; stage_rc(tid * 16 + i * 8192, R, C); const int Rb = (R & ~31) + perm32(R & 31);
        voffA[i] = (unsigned)(R * lda + C) * 2u; voffB[i] = (unsigned)(Rb * ldb + C) * 2u; }
    const size_t kstep = (size_t)(BK * 2);
    const size_t hstepA = (size_t)HALF * lda * 2, hstepB = (size_t)HALF * ldb * 2;
    const unsigned ldsw = (unsigned)wid * 1024u;
    const int aoff = lds_byte(wr * 64 + fr, fq * 8), boff = lds_byte(wc * 32 + fr, fq * 8);
#define PG8_SA(b, h) (((b) * 2 + (h)) * HTB)
#define PG8_SB(b, h) ((4 + (b) * 2 + (h)) * HTB)
#define PG8_STAGE(bufoff, gbase, voff) do { _Pragma("unroll") for (int _i = 0; _i < 2; ++_i) \
        __builtin_amdgcn_global_load_lds((const unsigned*)((const char*)(gbase) + (voff)[_i]), (LAS unsigned*)(lds + (bufoff) + ldsw + _i * 8192), 16, 0, 0); } while (0)
#define PG8_LDA(dst, b, h) do { _Pragma("unroll") for (int m = 0; m < 4; ++m) _Pragma("unroll") for (int k = 0; k < 2; ++k) dst[m][k] = *(const LAS bf16x8*)(lds + PG8_SA(b, h) + aoff + m * 2048 + k * 1024); } while (0)
#define PG8_LDB(dst, b, h) do { _Pragma("unroll") for (int n = 0; n < 2; ++n) _Pragma("unroll") for (int k = 0; k < 2; ++k) dst[n][k] = *(const LAS bf16x8*)(lds + PG8_SB(b, h) + boff + n * 2048 + k * 1024); } while (0)
#define PG8_MMA(ai, bj, At, Bt) do { __builtin_amdgcn_s_setprio(1); _Pragma("unroll") for (int m = 0; m < 4; ++m) _Pragma("unroll") for (int n = 0; n < 2; ++n) _Pragma("unroll") for (int k = 0; k < 2; ++k) \
        acc[ai][bj][m][n] = __builtin_amdgcn_mfma_f32_16x16x32_bf16(Bt[n][k], At[m][k], acc[ai][bj][m][n], 0, 0, 0); __builtin_amdgcn_s_setprio(0); } while (0)
#define PG8_WAIT_V(n) asm volatile("s_waitcnt vmcnt(" #n ")" ::: "memory")
#define PG8_WAIT_L(n) asm volatile("s_waitcnt lgkmcnt(" #n ")" ::: "memory")
#define PG8_BAR __builtin_amdgcn_s_barrier()
#define PG8_SCHED __builtin_amdgcn_sched_barrier(0)
    Unit cur, nxt; int ui = 0;
    if (!S.next(0, cur)) return;
    f32x4 acc[2][2][4][2];
#pragma unroll
    for (int a = 0; a < 2; ++a)
#pragma unroll
        for (int b = 0; b < 2; ++b)
#pragma unroll
            for (int m = 0; m < 4; ++m)
#pragma unroll
                for (int n = 0; n < 2; ++n) acc[a][b][m][n] = (f32x4){0.f, 0.f, 0.f, 0.f};
    bf16x8 At[4][2], B0[2][2], B1[2][2];
    const char* cA = cur.A; const char* cB = cur.B;
    PG8_STAGE(PG8_SB(0, 0), cB, voffB); PG8_STAGE(PG8_SA(0, 0), cA, voffA); PG8_STAGE(PG8_SB(0, 1), cB + hstepB, voffB); PG8_STAGE(PG8_SA(0, 1), cA + hstepA, voffA);
    if (wr == 1) PG8_BAR;
    PG8_WAIT_V(4); PG8_BAR;
    PG8_STAGE(PG8_SB(1, 0), cB + kstep, voffB); PG8_STAGE(PG8_SA(1, 0), cA + kstep, voffA); PG8_STAGE(PG8_SB(1, 1), cB + hstepB + kstep, voffB);
    PG8_WAIT_V(6); PG8_BAR;
    for (;;) {
        const bool has_next = S.next(ui + 1, nxt);
        const char* nA = has_next ? nxt.A : cA; const char* nB = has_next ? nxt.B : cB;
#pragma nounroll
        for (int t = 0; t < nt; t += 2) {
            const bool last = (t == nt - 2);
            const char* a1 = cA + (size_t)(t + 1) * kstep;
            const char* a2 = last ? nA : cA + (size_t)(t + 2) * kstep; const char* b2 = last ? nB : cB + (size_t)(t + 2) * kstep;
            const char* a3 = a2 + kstep; const char* b3 = b2 + kstep;
            PG8_LDB(B0, 0, 0); PG8_SCHED; PG8_LDA(At, 0, 0); PG8_STAGE(PG8_SA(1, 1), a1 + hstepA, voffA);
            PG8_WAIT_L(8); PG8_BAR; PG8_WAIT_L(0); PG8_MMA(0, 0, At, B0); PG8_BAR; PG8_SCHED;
            PG8_LDB(B1, 0, 1); PG8_STAGE(PG8_SB(0, 0), b2, voffB);
            PG8_BAR; PG8_WAIT_L(0); PG8_MMA(0, 1, At, B1); PG8_BAR;
            PG8_LDA(At, 0, 1); PG8_STAGE(PG8_SA(0, 0), a2, voffA);
            PG8_BAR; PG8_WAIT_L(0); PG8_MMA(1, 0, At, B0); PG8_BAR; PG8_SCHED;
            PG8_STAGE(PG8_SB(0, 1), b2 + hstepB, voffB);
            PG8_WAIT_V(6); PG8_BAR; PG8_MMA(1, 1, At, B1); PG8_BAR;
            PG8_LDB(B0, 1, 0); PG8_SCHED; PG8_LDA(At, 1, 0); PG8_STAGE(PG8_SA(0, 1), a2 + hstepA, voffA);
            PG8_WAIT_L(8); PG8_BAR; PG8_WAIT_L(0); PG8_MMA(0, 0, At, B0); PG8_BAR; PG8_SCHED;
            PG8_LDB(B1, 1, 1); PG8_STAGE(PG8_SB(1, 0), b3, voffB);
            PG8_BAR; PG8_WAIT_L(0); PG8_MMA(0, 1, At, B1); PG8_BAR;
            PG8_LDA(At, 1, 1); PG8_STAGE(PG8_SA(1, 0), a3, voffA);
            PG8_BAR; PG8_WAIT_L(0); PG8_MMA(1, 0, At, B0); PG8_BAR; PG8_SCHED;
            PG8_STAGE(PG8_SB(1, 1), b3 + hstepB, voffB);
            PG8_WAIT_V(6); PG8_BAR; PG8_MMA(1, 1, At, B1); PG8_BAR;
        }
        E(acc, cur, wr, wc, fr, fq);
        if (!has_next) break;
#pragma unroll
        for (int a = 0; a < 2; ++a)
#pragma unroll
            for (int b = 0; b < 2; ++b)
#pragma unroll
                for (int m = 0; m < 4; ++m)
#pragma unroll
                    for (int n = 0; n < 2; ++n) acc[a][b][m][n] = (f32x4){0.f, 0.f, 0.f, 0.f};
        cur = nxt; cA = nA; cB = nB; ++ui;
    }
    PG8_WAIT_V(0);
    if (wr == 0) PG8_BAR;
    PG8_BAR;
#undef PG8_SA
#undef PG8_SB
#undef PG8_STAGE
#undef PG8_LDA
#undef PG8_LDB
#undef PG8_MMA
#undef PG8_WAIT_V
#undef PG8_WAIT_L
#undef PG8_BAR
#undef PG8_SCHED
}
}
using pg8::Unit;

struct Params {
    const float *x, *c, *ctx, *c_ctx, *ada_w, *ada_b, *norm1_g, *norm2_g, *w_in, *pool_w, *pool_scale, *gla_gate_w, *gla_gate_b, *gla_norm_g,
                *mla_q_norm_g, *mla_kv_norm_g, *mla_w_uq, *mla_w_ukv, *branch_w, *w_out, *peer_wq, *peer_keys, *peer_u, *peer_v, *final_norm_g;
    float* out; unsigned char* ws;
};
struct Chunk { int is_ctx, rows, b0, np; const float* x32; bf16_t* xb; };

DI Chunk make_chunk(const Params& P, int layer, int ci) {
    Chunk c; c.is_ctx = (ci == 0); c.rows = c.is_ctx ? NB * TC : 8 * TL; c.b0 = c.is_ctx ? 0 : 8 * (ci - 1); c.np = c.rows / 256;
    c.xb = c.is_ctx ? (bf16_t*)(P.ws + WS_XCTX) : (bf16_t*)(P.ws + WS_XL) + (size_t)c.b0 * TL * D;
    c.x32 = (layer == 0) ? (c.is_ctx ? P.ctx : P.x + (size_t)c.b0 * TL * D) : nullptr;
    return c;
}
DI const bf16_t* wlayer(const Params& P, int l) { return (const bf16_t*)(P.ws + WS_W) + (size_t)l * W_LAYER; }
DI const float* modlayer(const Params& P, int l) { return (const float*)(P.ws + WS_MOD) + (size_t)l * 33 * 6144; }

template <class SrcF> DI void tconv_tiles(LAS float* tile, bf16_t* dst, int K, int N, SrcF src, int rot) {
    const int tid = ltid(), ntk = K / 64, ntn = N / 64, nwg = lgdim();
    const int wg = (int)(((unsigned)lbid() + (unsigned)rot) % (unsigned)nwg);
    for (int t = wg; t < ntk * ntn; t += nwg) {
        const int kt = t % ntk, nt_ = t / ntk;
#pragma unroll
        for (int rr = 0; rr < 8; ++rr) { const int i = (tid >> 6) + 8 * rr, j = tid & 63; tile[i * 65 + j] = src(kt * 64 + i, nt_ * 64 + j); }
        __syncthreads();
#pragma unroll
        for (int rr = 0; rr < 8; ++rr) { const int jj = (tid >> 6) + 8 * rr, ii = tid & 63; dst[(size_t)(nt_ * 64 + jj) * K + kt * 64 + ii] = f2bf(tile[ii * 65 + jj]); }
        __syncthreads();
    }
}
DI void conv_direct(const float* src, bf16_t* dst, size_t n) {
    const size_t stride = (size_t)lgdim() * NTHR;
    const int tid_ = ltid();
    for (size_t i = (size_t)lbid() * NTHR + tid_; i < n / 4; i += stride) {
        const float4 v = ((const float4*)src)[i]; u32x2 w; w.x = pk2(v.x, v.y); w.y = pk2(v.z, v.w); ((u32x2*)dst)[i] = w; }
}
DI void conv_fp8(const float* src, unsigned* dst, size_t n, float scale) {
    const size_t stride = (size_t)lgdim() * NTHR;
    const int tid_ = ltid();
    for (size_t i = (size_t)lbid() * NTHR + tid_; i < n / 4; i += stride) {
        const float4 v = ((const float4*)src)[i]; int w = 0;
        w = __builtin_amdgcn_cvt_pk_fp8_f32(v.x * scale, v.y * scale, w, false); w = __builtin_amdgcn_cvt_pk_fp8_f32(v.z * scale, v.w * scale, w, true);
        dst[i] = (unsigned)w; }
}
DI void phase_convert(const Params& P, LAS unsigned char* lds) {
    LAS float* tile = (LAS float*)lds;
    for (int l = 0; l < NLAYER; ++l) {
        bf16_t* W = (bf16_t*)(P.ws + WS_W) + (size_t)l * W_LAYER;
        { const float* w = P.w_in + (size_t)l * 1024 * 7904;
          tconv_tiles(tile, W + WO_IN, 1024, ZLD, [=](int k, int n) -> float {
              int sc; float s = 1.0f;
              if (n < 4096) { sc = n; if (n >= 1024 && n < 1536) s = 0.08838834764831845f; }
              else if (n < 7168) sc = n - 4096 + 4832;
              else if (n < 7552) sc = n - 7168 + 4128;
              else if (n < 7808) sc = n - 7552 + 4512;
              else if (n < 7872) sc = n - 7808 + 4768;
              else if (n < 7888) sc = n - 7872 + 4096;
              else if (n < 7904) sc = n - 7888 + 4112;
              else return 0.0f;
              return w[(size_t)k * 7904 + sc] * s; }, 0); }
        { const float* w = P.mla_w_uq + (size_t)l * 384 * 1536; const float* g = P.mla_q_norm_g + l * 384;
          tconv_tiles(tile, W + WO_UQ, 384, 1536, [=](int k, int n) -> float { return g[k] * w[k * 1536 + n]; }, 81); }
        { const float* w = P.mla_w_ukv + (size_t)l * 256 * 2048; const float* g = P.mla_kv_norm_g + l * 256;
          tconv_tiles(tile, W + WO_KN, 256, 1024, [=](int k, int n) -> float { return g[k] * w[k * 2048 + (n >> 7) * 256 + (n & 127)]; }, 120);
          tconv_tiles(tile, W + WO_V, 256, 1024, [=](int k, int n) -> float { return g[k] * w[k * 2048 + (n >> 7) * 256 + 128 + (n & 127)]; }, 184); }
        for (int i = 1; i < 3; ++i) { const float* w = P.branch_w + ((size_t)l * 3 + i) * 1048576;
          tconv_tiles(tile, W + WO_BR + (size_t)i * 1048576, 1024, 1024, [=](int k, int n) -> float { return w[k * 1024 + n]; }, 0); }
        {
            const float* pw = P.pool_w + (size_t)l * 4 * 65536; const float* ps = P.pool_scale + l * 1024; const float* bw = P.branch_w + (size_t)l * 3 * 1048576; bf16_t* dst = W + WO_BR;
            LAS float* AS = (LAS float*)lds; LAS float* BS = AS + 64 * 257;
            const int tid = ltid();
            for (int t = lbid(); t < 256; t += lgdim()) {
                const int g = t >> 6, nb = (t >> 2) & 15, kb = t & 3;
                __syncthreads();
                for (int i = tid; i < 64 * 256; i += NTHR) { const int r = i >> 8, j = i & 255; AS[r * 257 + j] = pw[(size_t)g * 65536 + (kb * 64 + r) * 256 + j] * ps[g * 256 + j]; }
                for (int i = tid; i < 256 * 64; i += NTHR) { const int j = i >> 6, n = i & 63; BS[j * 65 + n] = bw[(size_t)(g * 256 + j) * 1024 + nb * 64 + n]; }
                __syncthreads();
                const int kq = tid & 63, n0 = (tid >> 6) * 8;
                float acc[8];
#pragma unroll
                for (int j = 0; j < 8; ++j) acc[j] = 0.f;
                for (int j = 0; j < 256; ++j) { const float a = AS[kq * 257 + j];
#pragma unroll
                    for (int q = 0; q < 8; ++q) acc[q] += a * BS[j * 65 + n0 + q]; }
#pragma unroll
                for (int q = 0; q < 8; ++q) dst[(size_t)(nb * 64 + n0 + q) * 1024 + g * 256 + kb * 64 + kq] = f2bf(acc[q]);
            }
            __syncthreads();
        }
        { const float* w = P.w_out + (size_t)l * 1048576;
          tconv_tiles(tile, W + WO_OUT, 1024, 1024, [=](int k, int n) -> float { return w[k * 1024 + n]; }, 0); }
        {
            const float* wq = P.peer_wq + (size_t)l * 1024 * 2048; const float* kk = P.peer_keys + (size_t)l * 2 * 8 * 128 * 128; bf16_t* dst = W + WO_Q;
            LAS float* KY = (LAS float*)lds; LAS float* WQS = KY + 128 * 129;
            const int tid = ltid();
            for (int t = lbid(); t < 256; t += lgdim()) {
                const int hs = t >> 4, k0 = (t & 15) * 64, h = hs >> 1, half = hs & 1;
                __syncthreads();
                for (int i = tid; i < 128 * 128; i += NTHR) { const int key = i >> 7, d = i & 127; KY[key * 129 + d] = kk[((size_t)(half * 8 + h) * 128 + key) * 128 + d]; }
                for (int i = tid; i < 64 * 128; i += NTHR) { const int r = i >> 7, d = i & 127; WQS[r * 129 + d] = wq[(size_t)(k0 + r) * 2048 + h * 256 + half * 128 + d]; }
                __syncthreads();
                const int kq = tid & 63, key0 = (tid >> 6) * 16;
                float acc[16];
#pragma unroll
                for (int j = 0; j < 16; ++j) acc[j] = 0.f;
                for (int d = 0; d < 128; ++d) { const float a = WQS[kq * 129 + d];
#pragma unroll
                    for (int j = 0; j < 16; ++j) acc[j] += a * KY[(key0 + j) * 129 + d]; }
#pragma unroll
                for (int j = 0; j < 16; ++j) dst[(size_t)(h * 256 + half * 128 + key0 + j) * 1024 + k0 + kq] = f2bf(acc[j]);
            }
            __syncthreads();
        }
        conv_fp8(P.peer_u + (size_t)l * NEXP * 1024, (unsigned*)(W + WO_PU), (size_t)NEXP * 1024, 32.0f);
        conv_fp8(P.peer_v + (size_t)l * NEXP * 1024, (unsigned*)(W + WO_PV), (size_t)NEXP * 1024, 1.0f);
    }
    if (lbid() == 0) {
        float2* rt = (float2*)(P.ws + WS_ROPE);
        for (int i = ltid(); i < 64 * 16; i += NTHR) { const float inv = exp2f(-(float)(i & 15) * 0.8304820237218406f); float sn, cs; sincosf((float)(i >> 4) * inv, &sn, &cs); rt[i] = make_float2(cs, sn); }
    }
}
DI void phase_mod(const Params& P, LAS unsigned char* lds) {
    LAS float* SC = (LAS float*)lds;
    LAS float* ACC = SC + 33 * 1024;
    const int tid = ltid(), wid = tid >> 6;
    if (lbid() >= 192) return;
    for (int i = tid; i < 33 * 1024; i += NTHR) { const int b = i >> 10, k = i & 1023; const float v = b < 32 ? P.c[b * 1024 + k] : P.c_ctx[k]; SC[i] = v / (1.0f + __expf(-v)); }
    float* MOD = (float*)(P.ws + WS_MOD);
    for (int grp = lbid(); grp < 192; grp += lgdim()) {
        const int l = grp / 96, n0 = (grp % 96) * 64;
        for (int i = tid; i < 33 * 64; i += NTHR) ACC[i] = 0.f;
        __syncthreads();
        const int j = tid & 63, ks = tid >> 6;
        float acc[33];
#pragma unroll
        for (int b = 0; b < 33; ++b) acc[b] = 0.f;
        const float* w = P.ada_w + (size_t)l * 1024 * 6144 + n0 + j;
        for (int k = ks * 128; k < ks * 128 + 128; ++k) { const float wv = w[(size_t)k * 6144];
#pragma unroll
            for (int b = 0; b < 33; ++b) acc[b] += SC[b * 1024 + k] * wv; }
        for (int ww = 0; ww < 8; ++ww) {
            if (wid == ww) {
#pragma unroll
                for (int b = 0; b < 33; ++b) ACC[b * 64 + j] += acc[b]; }
            __syncthreads(); }
        for (int i = tid; i < 33 * 64; i += NTHR) { const int b = i >> 6, jj = i & 63; MOD[(size_t)(l * 33 + b) * 6144 + n0 + jj] = ACC[i] + P.ada_b[l * 6144 + n0 + jj]; }
        __syncthreads();
    }
}

template <bool F32SRC> DI void phase_norm(const void* xsv, int rows, const float* gain, const float* mod, int is_ctx, int b0, int sh_idx, bf16_t* H) {
    const int tid_ = ltid(); const int lane = tid_ & 63, wid = tid_ >> 6;
    for (int r = lbid() * 8 + wid; r < rows; r += lgdim() * 8) {
        const int bi = is_ctx ? 32 : b0 + (r >> 11);
        const float* sh = mod + (size_t)bi * 6144 + sh_idx * 1024; const float* sc = sh + 1024;
        float4 v[4]; float ss = 0.f;
#pragma unroll
        for (int j = 0; j < 4; ++j) {
            if (F32SRC) v[j] = ((const float4*)((const float*)xsv + (size_t)r * 1024))[lane + 64 * j];
            else { const u32x2 w = ((const u32x2*)((const bf16_t*)xsv + (size_t)r * 1024))[lane + 64 * j]; v[j] = make_float4(lo2f(w.x), hi2f(w.x), lo2f(w.y), hi2f(w.y)); }
            ss += v[j].x * v[j].x + v[j].y * v[j].y + v[j].z * v[j].z + v[j].w * v[j].w; }
        ss = wave_sum(ss, lane);
        const float rstd = rsqrtf(ss * (1.0f / 1024.0f) + 1e-6f);
#pragma unroll
        for (int j = 0; j < 4; ++j) { const int c = (lane + 64 * j) * 4;
            const float4 g = *(const float4*)(gain + c), s1 = *(const float4*)(sc + c), s0 = *(const float4*)(sh + c);
            u32x2 w; w.x = pk2(v[j].x * rstd * g.x * (1.f + s1.x) + s0.x, v[j].y * rstd * g.y * (1.f + s1.y) + s0.y);
            w.y = pk2(v[j].z * rstd * g.z * (1.f + s1.z) + s0.z, v[j].w * rstd * g.w * (1.f + s1.w) + s0.w);
            *(u32x2*)(H + (size_t)r * 1024 + c) = w; }
    }
}

DI void phase_prep(const bf16_t* Z, int rows, int is_ctx, float* RS, bf16_t* KR, bf16_t* PD, bool do_pool, const float2* rt) {
    const int tid_ = ltid(); const int lane = tid_ & 63, wid = tid_ >> 6;
    const int seqlen = is_ctx ? TC : TL;
    for (int r = lbid() * 8 + wid; r < rows; r += lgdim() * 8) {
        const bf16_t* zr = Z + (size_t)r * ZLD;
        float sq = 0.f, sk = 0.f;
        { const unsigned* p = (const unsigned*)(zr + ZC_QDN + lane * 6);
#pragma unroll
          for (int i = 0; i < 3; ++i) { const unsigned w = p[i]; const float a = lo2f(w), b = hi2f(w); sq += a * a + b * b; } }
        { const u32x2 w = *(const u32x2*)(zr + ZC_KVDN + lane * 4); const float a = lo2f(w.x), b = hi2f(w.x), c = lo2f(w.y), d = hi2f(w.y); sk = a * a + b * b + c * c + d * d; }
        sq = wave_sum(sq, lane); sk = wave_sum(sk, lane);
        if (lane == 0) { RS[r] = rsqrtf(sq * (1.0f / 384.0f) + 1e-6f); RS[16384 + r] = rsqrtf(sk * (1.0f / 256.0f) + 1e-6f); }
        { const float x = bf2f(zr[ZC_KROPE + lane]); const float xp = shx(x, 16, lane); float o = x;
          if (!is_ctx) { const int t = r & (TL - 1); const int pos = (lane < 32) ? (t >> 6) : (t & 63); const int i = lane & 15;
              const float2 cs = rt[pos * 16 + i]; const float c = cs.x, s = cs.y;
              o = ((lane & 31) < 16) ? (x * c - xp * s) : (xp * s + x * c); }
          KR[(size_t)r * 64 + lane] = f2bf(o); }
        if (do_pool) {
            const int t = r % seqlen, seq0 = r - t;
#pragma unroll
            for (int j = 0; j < 4; ++j) {
                const int hw = 1 << j; const int lo = (t - hw) < 0 ? 0 : (t - hw); const int hi = (t + hw) > seqlen ? seqlen : (t + hw);
                const int c = j * 256 + lane * 4; float s0 = 0.f, s1 = 0.f, s2 = 0.f, s3 = 0.f;
#pragma unroll
                for (int k = 0; k < 2 * hw; ++k) {
                    const int tt = t - hw + k; const bool ok = tt >= 0 && tt < seqlen; const int tc = ok ? tt : t;
                    const u32x2 w = *(const u32x2*)(Z + (size_t)(seq0 + tc) * ZLD + ZC_P + c); const float m = ok ? 1.f : 0.f;
                    s0 += m * lo2f(w.x); s1 += m * hi2f(w.x); s2 += m * lo2f(w.y); s3 += m * hi2f(w.y); }
                const u32x2 me = *(const u32x2*)(zr + ZC_P + c); const float inv = 1.0f / (float)(hi - lo);
                u32x2 o; o.x = pk2(s0 * inv - lo2f(me.x), s1 * inv - hi2f(me.x)); o.y = pk2(s2 * inv - lo2f(me.y), s3 * inv - hi2f(me.y));
                *(u32x2*)(PD + (size_t)r * 1024 + c) = o; }
        }
    }
}

template <class Fill> struct GridSched { int nM, nN, G, c; Fill fill;
    DI bool next(int i, Unit& u) const { const long L = (long)i * G + c; if (L >= (long)nM * nN) return false; int pm, pn; pg8::tile_of((int)L, nM, nN, pm, pn); u.pm = pm; u.pn = pn; u.z = 0; fill(u); return true; } };
template <class Fill> DI GridSched<Fill> make_sched(int nM, int nN, Fill f) { GridSched<Fill> s{nM, nN, lgdim(), lbid(), f}; return s; }
template <class Fill> struct TripleSched { int nM, nN, G, c; Fill fill;
    DI bool next(int i, Unit& u) const { const long L = (long)(i / 3) * G + c; if (L >= (long)nM * nN) return false; int pm, pn; pg8::tile_of((int)L, nM, nN, pm, pn); u.pm = pm; u.pn = pn; u.z = i % 3; fill(u); return true; } };

DI bf16x8 pack8(const f32x16& x, int sp) { u32x4 p; p.x = pk2(x[8 * sp], x[8 * sp + 1]); p.y = pk2(x[8 * sp + 2], x[8 * sp + 3]); p.z = pk2(x[8 * sp + 4], x[8 * sp + 5]); p.w = pk2(x[8 * sp + 6], x[8 * sp + 7]);
    return __builtin_bit_cast(bf16x8, p); }
DI bf16x8 read_perm(const LAS unsigned char* p) {
    const s16x4 lo = *(const LAS s16x4*)p, hi = *(const LAS s16x4*)(p + 16);
    bf16x8 v; v[0] = lo[0]; v[1] = lo[1]; v[2] = lo[2]; v[3] = lo[3]; v[4] = hi[0]; v[5] = hi[1]; v[6] = hi[2]; v[7] = hi[3]; return v; }
DI void store8_bf16(bf16_t* p, const f32x4& a, const f32x4& b) { u32x4 w; w.x = pk2(a[0], a[1]); w.y = pk2(a[2], a[3]); w.z = pk2(b[0], b[1]); w.w = pk2(b[2], b[3]); *(u32x4*)p = w; }

DI void attn_item(LAS unsigned char* lds, const float2* rt, const bf16_t* Qp, int h, bool rope, int tq0,
                  const bf16_t* kn0, const bf16_t* kr0, const bf16_t* vt0, int ldv0, int nt0,
                  const bf16_t* kn1, const bf16_t* kr1, const bf16_t* vt1, int ldv1, int nt1, bf16_t* Op) {
    int tid = threadIdx.x; asm volatile("" : "+v"(tid));
    const int wid = tid >> 6, lane = tid & 63, ql = lane & 31, hh = lane >> 5;
    const bool grpB = __builtin_amdgcn_readfirstlane(wid) >= 4;
    constexpr int KPITCH = 400, VPITCH = 136, VOFF = 64 * KPITCH, BUFB = VOFF + 128 * VPITCH;
    constexpr float SL = 0.10411755f;
    bf16x8 qf[12];
    { const bf16_t* qrow = Qp + (size_t)(wid * 32 + ql) * 1536 + h * 192;
#pragma unroll
      for (int ks = 0; ks < 12; ++ks) qf[ks] = *(const bf16x8*)(qrow + ks * 16 + hh * 8); }
    if (rope) {
        const int t = tq0 + wid * 32 + ql; const int rp = t >> 6, cp = t & 63;
#pragma unroll
        for (int j = 0; j < 8; ++j) {
            float2 cs = rt[rp * 16 + 8 * hh + j]; float c = cs.x, s = cs.y;
            { const float x1 = bf2f((bf16_t)qf[8][j]), x2 = bf2f((bf16_t)qf[9][j]); qf[8][j] = (short)f2bf(x1 * c - x2 * s); qf[9][j] = (short)f2bf(x1 * s + x2 * c); }
            cs = rt[cp * 16 + 8 * hh + j]; c = cs.x; s = cs.y;
            { const float x1 = bf2f((bf16_t)qf[10][j]), x2 = bf2f((bf16_t)qf[11][j]); qf[10][j] = (short)f2bf(x1 * c - x2 * s); qf[11][j] = (short)f2bf(x1 * s + x2 * c); }
        }
    }
    f32x16 oacc[4];
#pragma unroll
    for (int db = 0; db < 4; ++db)
#pragma unroll
        for (int r = 0; r < 16; ++r) oacc[db][r] = 0.f;
    float m_run = -1e30f, l_run = 0.f;
    const int ntile = nt0 + nt1;
    u32x4 kst[3], vst[2];
    auto issueK = [&](int j) {
        const bool s1 = j >= nt0; const int key0 = (s1 ? j - nt0 : j) * 64;
        const bf16_t* kn = s1 ? kn1 : kn0; const bf16_t* kr = s1 ? kr1 : kr0;
#pragma unroll
        for (int i = 0; i < 2; ++i) { const int id = tid + 512 * i, key = id >> 4, c = id & 15;
            kst[i] = *(const u32x4*)(kn + (size_t)(key0 + key) * 1024 + h * 128 + c * 8); }
        { const int key = tid >> 3, c = tid & 7;
            kst[2] = *(const u32x4*)(kr + (size_t)(key0 + key) * 64 + c * 8); } };
    auto issueV = [&](int j) {
        const bool s1 = j >= nt0; const int key0 = (s1 ? j - nt0 : j) * 64;
        const bf16_t* vt = s1 ? vt1 : vt0; const int ldv = s1 ? ldv1 : ldv0;
#pragma unroll
        for (int i = 0; i < 2; ++i) { const int id = tid + 512 * i, d = id >> 3, c = id & 7;
            vst[i] = *(const u32x4*)(vt + (size_t)(h * 128 + d) * ldv + key0 + c * 8); } };
    auto commitK = [&](int buf) {
        LAS unsigned char* base = lds + buf * BUFB;
#pragma unroll
        for (int i = 0; i < 2; ++i) { const int id = tid + 512 * i, key = id >> 4, c = id & 15; *(LAS u32x4*)(base + key * KPITCH + c * 16) = kst[i]; }
        { const int key = tid >> 3, c = tid & 7; *(LAS u32x4*)(base + key * KPITCH + (16 + c) * 16) = kst[2]; } };
    auto commitV = [&](int buf) {
        LAS unsigned char* base = lds + buf * BUFB + VOFF;
#pragma unroll
        for (int i = 0; i < 2; ++i) { const int id = tid + 512 * i, d = id >> 3, c = id & 7; LAS u32x2* p = (LAS u32x2*)(base + d * VPITCH + c * 16);
            u32x2 a; a.x = vst[i].x; a.y = vst[i].y; u32x2 b; b.x = vst[i].z; b.y = vst[i].w; p[0] = a; p[1] = b; } };
    auto wgbar = [&]() { asm volatile("s_waitcnt lgkmcnt(0)" ::: "memory"); __builtin_amdgcn_s_barrier(); asm volatile("" ::: "memory"); };
    f32x16 s0, s1;
    auto scores = [&](int j) {
        const LAS unsigned char* Kb = lds + (j & 1) * BUFB;
#pragma unroll
        for (int r = 0; r < 16; ++r) { s0[r] = 0.f; s1[r] = 0.f; }
        const LAS unsigned char* kp0 = Kb + ql * KPITCH + hh * 16; const LAS unsigned char* kp1 = Kb + (32 + ql) * KPITCH + hh * 16;
        bf16x8 k0c = *(const LAS bf16x8*)kp0, k1c = *(const LAS bf16x8*)kp1;
#pragma unroll
        for (int ks = 0; ks < 12; ++ks) {
            bf16x8 k0n = k0c, k1n = k1c;
            if (ks < 11) { k0n = *(const LAS bf16x8*)(kp0 + (ks + 1) * 32); k1n = *(const LAS bf16x8*)(kp1 + (ks + 1) * 32); }
            __builtin_amdgcn_sched_barrier(0);
            s0 = __builtin_amdgcn_mfma_f32_32x32x16_bf16(k0c, qf[ks], s0, 0, 0, 0);
            s1 = __builtin_amdgcn_mfma_f32_32x32x16_bf16(k1c, qf[ks], s1, 0, 0, 0);
            __builtin_amdgcn_sched_barrier(0);
            k0c = k0n; k1c = k1n;
        }
        float mx = s0[0];
#pragma unroll
        for (int r = 0; r < 16; ++r) { mx = fmaxf(mx, s0[r]); mx = fmaxf(mx, s1[r]); }
        mx = fmaxf(mx, shx(mx, 32, lane));
        const bool grow = (mx - m_run) * SL > 8.0f;
        if (__builtin_amdgcn_ballot_w64(grow) != 0ull) {
            const float m_new = grow ? mx : m_run; const float alpha = exp2f((m_run - m_new) * SL); m_run = m_new;
            l_run *= alpha;
#pragma unroll
            for (int db = 0; db < 4; ++db)
#pragma unroll
                for (int r = 0; r < 16; ++r) oacc[db][r] *= alpha;
        }
    };
    auto pv = [&](int j) {
        { float ps = 0.f; const float mb = m_run * SL;
#pragma unroll
          for (int r = 0; r < 16; ++r) { s0[r] = exp2f(s0[r] * SL - mb); s1[r] = exp2f(s1[r] * SL - mb); ps += s0[r] + s1[r]; }
          l_run += ps; }
        const LAS unsigned char* vbase = lds + (j & 1) * BUFB + VOFF + ql * VPITCH + hh * 8;
        bf16x8 vc = read_perm(vbase);
#pragma unroll
        for (int it = 0; it < 16; ++it) {
            const int kb = it >> 3, sp = (it >> 2) & 1, db = it & 3;
            bf16x8 vn = vc;
            if (it < 15) { const int kb2 = (it + 1) >> 3, sp2 = ((it + 1) >> 2) & 1, db2 = (it + 1) & 3; vn = read_perm(vbase + db2 * 32 * VPITCH + (32 * kb2 + 16 * sp2) * 2); }
            const bf16x8 pf = pack8(kb == 0 ? s0 : s1, sp);
            __builtin_amdgcn_sched_barrier(0);
            if (db == 0) oacc[0] = __builtin_amdgcn_mfma_f32_32x32x16_bf16(vc, pf, oacc[0], 0, 0, 0);
            if (db == 1) oacc[1] = __builtin_amdgcn_mfma_f32_32x32x16_bf16(vc, pf, oacc[1], 0, 0, 0);
            if (db == 2) oacc[2] = __builtin_amdgcn_mfma_f32_32x32x16_bf16(vc, pf, oacc[2], 0, 0, 0);
            if (db == 3) oacc[3] = __builtin_amdgcn_mfma_f32_32x32x16_bf16(vc, pf, oacc[3], 0, 0, 0);
            __builtin_amdgcn_sched_barrier(0);
            vc = vn;
        }
    };
    issueK(0); issueV(0); commitK(0); commitV(0); wgbar();
    if (!grpB) {
        for (int m = 0; m < ntile; ++m) {
            if (m >= 1) commitV(m & 1);
            if (m + 1 < ntile) issueK(m + 1);
            scores(m);
            wgbar();
            if (m + 1 < ntile) { commitK((m + 1) & 1); issueV(m + 1); }
            pv(m);
            wgbar();
        }
        wgbar();
    } else {
        if (1 < ntile) issueK(1);
        wgbar();
        for (int m = 0; m < ntile; ++m) {
            if (m + 1 < ntile) { commitK((m + 1) & 1); issueV(m + 1); }
            scores(m);
            wgbar();
            if (m + 1 < ntile) commitV((m + 1) & 1);
            if (m + 2 < ntile) issueK(m + 2);
            pv(m);
            wgbar();
        }
    }
    const float linv = 1.0f / (l_run + shx(l_run, 32, lane));
    bf16_t* orow = Op + (size_t)(wid * 32 + ql) * 1024 + h * 128;
#pragma unroll
    for (int db = 0; db < 4; ++db)
#pragma unroll
        for (int g = 0; g < 4; ++g) { u32x2 w; w.x = pk2(oacc[db][4 * g] * linv, oacc[db][4 * g + 1] * linv); w.y = pk2(oacc[db][4 * g + 2] * linv, oacc[db][4 * g + 3] * linv);
            *(u32x2*)(orow + db * 32 + g * 8 + hh * 4) = w; }
    __syncthreads();
}

DI void gla_item(LAS unsigned char* lds, const bf16_t* Zseq, int len, int h, int dir, const float* gw, const float* gb,
                 const float* Sin, float* Sout, bf16_t* Oseq) {
    constexpr int QP = 272, KDP = 144, VP = 144;
    LAS unsigned char* QE = lds; LAS unsigned char* KE = lds + 17408; LAS unsigned char* KDT = lds + 34816; LAS unsigned char* VT = lds + 53248;
    LAS float* LR = (LAS float*)(lds + 90112); LAS float* SEG = (LAS float*)(lds + 94208); LAS float* DEC = (LAS float*)(lds + 96256);
    int tid = threadIdx.x; asm volatile("" : "+v"(tid));
    const int wid = tid >> 6, lane = tid & 63, ql = lane & 31, hh = lane >> 5, d = tid & 127, part = tid >> 7;
    float gwr[16];
#pragma unroll
    for (int j = 0; j < 16; ++j) gwr[j] = gw[j * 512 + h * 128 + d];
    const float gbr = gb[h * 128 + d];
    f32x16 S[4];
#pragma unroll
    for (int db = 0; db < 4; ++db)
#pragma unroll
        for (int r = 0; r < 16; ++r) S[db][r] = Sin ? Sin[(size_t)(32 * db + (r & 3) + 8 * (r >> 2) + 4 * hh) * 256 + 32 * wid + ql] : 0.f;
    const int lrcol = dir ? ZC_LRB : ZC_LRF;
    for (int n0 = 0; n0 < len; n0 += 64) {
#pragma unroll
        for (int i = 0; i < 2; ++i) { const int e = tid + 512 * i, row = e >> 4, j = e & 15; const int t = dir ? len - 1 - (n0 + row) : n0 + row;
            LR[e] = bf2f(Zseq[(size_t)t * ZLD + lrcol + j]); }
#pragma unroll
        for (int i = 0; i < 4; ++i) { const int cidx = tid + 512 * i, row = cidx & 63, c8 = cidx >> 6; const int t = dir ? len - 1 - (n0 + row) : n0 + row;
            const u32x4 v = *(const u32x4*)(Zseq + (size_t)t * ZLD + ZC_V + h * 256 + c8 * 8);
            LAS bf16_t* vp = (LAS bf16_t*)(VT + (c8 * 8) * VP + row * 2);
            const unsigned v0 = v.x, v1 = v.y, v2 = v.z, v3 = v.w;
            vp[0 * (VP / 2)] = (bf16_t)v0; vp[1 * (VP / 2)] = (bf16_t)(v0 >> 16); vp[2 * (VP / 2)] = (bf16_t)v1; vp[3 * (VP / 2)] = (bf16_t)(v1 >> 16);
            vp[4 * (VP / 2)] = (bf16_t)v2; vp[5 * (VP / 2)] = (bf16_t)(v2 >> 16); vp[6 * (VP / 2)] = (bf16_t)v3; vp[7 * (VP / 2)] = (bf16_t)(v3 >> 16); }
        bf16_t qraw[16], kraw[16];
#pragma unroll
        for (int ii = 0; ii < 16; ++ii) { const int row = part * 16 + ii; const int t = dir ? len - 1 - (n0 + row) : n0 + row;
            qraw[ii] = Zseq[(size_t)t * ZLD + ZC_Q + h * 128 + d]; kraw[ii] = Zseq[(size_t)t * ZLD + ZC_K + h * 128 + d]; }
        __syncthreads();
        float bl[16]; float run = 0.f;
#pragma unroll
        for (int ii = 0; ii < 16; ++ii) { float z = gbr;
#pragma unroll
            for (int j = 0; j < 16; ++j) z += LR[(part * 16 + ii) * 16 + j] * gwr[j];
            run += (fminf(z, 0.f) - __logf(1.0f + __expf(-fabsf(z)))) * 0.0625f; bl[ii] = run; }
        SEG[part * 128 + d] = run;
        __syncthreads();
        float off = 0.f, blast = 0.f;
#pragma unroll
        for (int pp = 0; pp < 4; ++pp) { const float sg = SEG[pp * 128 + d]; off += (pp < part) ? sg : 0.f; blast += sg; }
        if (part == 0) DEC[d] = __expf(blast);
        unsigned kdp[8];
#pragma unroll
        for (int ii = 0; ii < 16; ++ii) { const int row = part * 16 + ii; const float b = off + bl[ii];
            const float qv = bf2f(qraw[ii]), kv = bf2f(kraw[ii]);
            *(LAS bf16_t*)(QE + row * QP + d * 2) = f2bf(qv * __expf(b));
            *(LAS bf16_t*)(KE + row * QP + d * 2) = f2bf(kv * __expf(-b));
            const unsigned kd = f2bf(kv * __expf(blast - b));
            if (ii & 1) kdp[ii >> 1] |= kd << 16; else kdp[ii >> 1] = kd; }
        { u32x4 a; a.x = kdp[0]; a.y = kdp[1]; a.z = kdp[2]; a.w = kdp[3]; u32x4 b; b.x = kdp[4]; b.y = kdp[5]; b.z = kdp[6]; b.w = kdp[7];
          *(LAS u32x4*)(KDT + d * KDP + part * 32) = a; *(LAS u32x4*)(KDT + d * KDP + part * 32 + 16) = b; }
        __syncthreads();
        f32x16 att00, att01, att11, o0, o1;
#pragma unroll
        for (int r = 0; r < 16; ++r) { att00[r] = 0.f; att01[r] = 0.f; att11[r] = 0.f; o0[r] = 0.f; o1[r] = 0.f; }
#pragma unroll
        for (int ks = 0; ks < 8; ++ks) {
            const int co = (ks * 16 + hh * 8) * 2;
            const bf16x8 kf0 = *(const LAS bf16x8*)(KE + ql * QP + co), kf1 = *(const LAS bf16x8*)(KE + (32 + ql) * QP + co);
            const bf16x8 qf0 = *(const LAS bf16x8*)(QE + ql * QP + co), qf1 = *(const LAS bf16x8*)(QE + (32 + ql) * QP + co);
            att00 = __builtin_amdgcn_mfma_f32_32x32x16_bf16(kf0, qf0, att00, 0, 0, 0);
            att01 = __builtin_amdgcn_mfma_f32_32x32x16_bf16(kf0, qf1, att01, 0, 0, 0);
            att11 = __builtin_amdgcn_mfma_f32_32x32x16_bf16(kf1, qf1, att11, 0, 0, 0);
            if (ks & 1) __builtin_amdgcn_sched_barrier(0);
        }
#pragma unroll
        for (int r = 0; r < 16; ++r) { const int srow = (r & 3) + 8 * (r >> 2) + 4 * hh; if (srow > ql) { att00[r] = 0.f; att11[r] = 0.f; } }
        const LAS unsigned char* vrow = VT + (32 * wid + ql) * VP + hh * 8;
#pragma unroll
        for (int sp = 0; sp < 2; ++sp) {
            const bf16x8 va = read_perm(vrow + (16 * sp) * 2), vb = read_perm(vrow + (32 + 16 * sp) * 2);
            o0 = __builtin_amdgcn_mfma_f32_32x32x16_bf16(va, pack8(att00, sp), o0, 0, 0, 0);
            o1 = __builtin_amdgcn_mfma_f32_32x32x16_bf16(va, pack8(att01, sp), o1, 0, 0, 0);
            o1 = __builtin_amdgcn_mfma_f32_32x32x16_bf16(vb, pack8(att11, sp), o1, 0, 0, 0);
        }
#pragma unroll
        for (int db = 0; db < 4; ++db)
#pragma unroll
            for (int sp = 0; sp < 2; ++sp) {
                const bf16x8 sa = pack8(S[db], sp);
                const int co = (32 * db + 16 * sp + 4 * hh) * 2;
                const bf16x8 qb0 = read_perm(QE + ql * QP + co), qb1 = read_perm(QE + (32 + ql) * QP + co);
                o0 = __builtin_amdgcn_mfma_f32_32x32x16_bf16(sa, qb0, o0, 0, 0, 0);
                o1 = __builtin_amdgcn_mfma_f32_32x32x16_bf16(sa, qb1, o1, 0, 0, 0);
                if (sp) __builtin_amdgcn_sched_barrier(0);
            }
#pragma unroll
        for (int db = 0; db < 4; ++db) {
#pragma unroll
            for (int g4 = 0; g4 < 4; ++g4) { const f32x4 dc = *(const LAS f32x4*)(DEC + 32 * db + 8 * g4 + 4 * hh);
#pragma unroll
                for (int i = 0; i < 4; ++i) S[db][4 * g4 + i] *= dc[i]; }
#pragma unroll
            for (int ks = 0; ks < 4; ++ks) {
                const bf16x8 af = *(const LAS bf16x8*)(KDT + (32 * db + ql) * KDP + (16 * ks + 8 * hh) * 2);
                const bf16x8 bv = *(const LAS bf16x8*)(VT + (32 * wid + ql) * VP + (16 * ks + 8 * hh) * 2);
                S[db] = __builtin_amdgcn_mfma_f32_32x32x16_bf16(af, bv, S[db], 0, 0, 0);
            }
            __builtin_amdgcn_sched_barrier(0);
        }
#pragma unroll
        for (int tb = 0; tb < 2; ++tb) { const int row = 32 * tb + ql; const int t = dir ? len - 1 - (n0 + row) : n0 + row;
            bf16_t* op = Oseq + (size_t)t * 1024 + h * 256 + 32 * wid + 4 * hh;
#pragma unroll
            for (int g4 = 0; g4 < 4; ++g4) { u32x2 w2;
                if (tb == 0) { w2.x = pk2(o0[4 * g4], o0[4 * g4 + 1]); w2.y = pk2(o0[4 * g4 + 2], o0[4 * g4 + 3]); }
                else { w2.x = pk2(o1[4 * g4], o1[4 * g4 + 1]); w2.y = pk2(o1[4 * g4 + 2], o1[4 * g4 + 3]); }
                *(u32x2*)(op + 8 * g4) = w2; } }
        __syncthreads();
    }
    if (Sout) {
#pragma unroll
        for (int db = 0; db < 4; ++db)
#pragma unroll
            for (int r = 0; r < 16; ++r) Sout[(size_t)(32 * db + (r & 3) + 8 * (r >> 2) + 4 * hh) * 256 + 32 * wid + ql] = S[db][r]; }
}

DI void phase_glafin(const bf16_t* OF, const bf16_t* OB, const bf16_t* Z, const float* gg, int rows, bf16_t* GF) {
    const int tid_ = ltid(); const int lane = tid_ & 63, wid = tid_ >> 6;
    const float4 g4 = *(const float4*)(gg + lane * 4);
    for (int r = lbid() * 8 + wid; r < rows; r += lgdim() * 8) {
#pragma unroll
        for (int h = 0; h < 4; ++h) {
            const int c = h * 256 + lane * 4;
            const u32x2 a = *(const u32x2*)(OF + (size_t)r * 1024 + c), b = *(const u32x2*)(OB + (size_t)r * 1024 + c), rr = *(const u32x2*)(Z + (size_t)r * ZLD + ZC_R + c);
            const float s0 = lo2f(a.x) + lo2f(b.x), s1 = hi2f(a.x) + hi2f(b.x), s2 = lo2f(a.y) + lo2f(b.y), s3 = hi2f(a.y) + hi2f(b.y);
            const float ss = wave_sum(s0 * s0 + s1 * s1 + s2 * s2 + s3 * s3, lane);
            const float rstd = rsqrtf(ss * (1.0f / 256.0f) + 1e-6f);
            const float r0 = lo2f(rr.x), r1 = hi2f(rr.x), r2 = lo2f(rr.y), r3 = hi2f(rr.y);
            u32x2 o; o.x = pk2(s0 * rstd * g4.x * (r0 * sigmoidf_(r0)), s1 * rstd * g4.y * (r1 * sigmoidf_(r1)));
            o.y = pk2(s2 * rstd * g4.z * (r2 * sigmoidf_(r2)), s3 * rstd * g4.w * (r3 * sigmoidf_(r3)));
            *(u32x2*)(GF + (size_t)r * 1024 + c) = o;
        }
    }
}

DI unsigned fkey(float f) { const unsigned u = __float_as_uint(f); return u ^ ((unsigned)((int)u >> 31) | 0x80000000u); }
DI float unfkey(unsigned k) { return __uint_as_float((k & 0x80000000u) ? (k ^ 0x80000000u) : ~k); }
DI void key_insert(unsigned (&t)[16], unsigned k) {
#pragma unroll
    for (int j = 0; j < 16; ++j) { const unsigned hi = t[j] > k ? t[j] : k; const unsigned lo = t[j] > k ? k : t[j]; t[j] = hi; k = lo; }
}
DI void phase_select(const _Float16* SC, int rows, uint2* ROUTE, unsigned short* EID, LAS unsigned char* lds) {
    const int tid_ = ltid(); const int lane = tid_ & 63, wid = tid_ >> 6;
    LAS float* T = (LAS float*)lds + wid * (64 * 65);
    for (int pbase = (lbid() * 8 + wid) * 64; pbase < rows * 8; pbase += lgdim() * 8 * 64) {
        const int p = pbase + lane;
        unsigned k1[16], k2[16];
#pragma unroll
        for (int j = 0; j < 16; ++j) { k1[j] = 0u; k2[j] = 0u; }
#pragma unroll
        for (int pass = 0; pass < 4; ++pass) {
#pragma unroll
            for (int k = 0; k < 8; ++k) { const int pp = 8 * k + (lane >> 3), c8 = lane & 7;
                const h16x8 v = *(const h16x8*)(SC + (size_t)(pbase + pp) * 256 + pass * 32 + (c8 & 3) * 8 + (c8 >> 2) * 128);
                LAS float* tp = T + (8 * c8) * 65 + pp;
#pragma unroll
                for (int c = 0; c < 8; ++c) tp[c * 65] = (float)v[c]; }
            for (int f = 0; f < 32; ++f) { const float va = T[f * 65 + lane], vb = T[(32 + f) * 65 + lane]; const unsigned ix = (unsigned)(127 - (pass * 32 + f));
                key_insert(k1, (fkey(va) & ~127u) | ix); key_insert(k2, (fkey(vb) & ~127u) | ix); }
        }
        float t1[16], t2[16]; unsigned i1p[4] = {0u, 0u, 0u, 0u}, i2p[4] = {0u, 0u, 0u, 0u};
#pragma unroll
        for (int j = 0; j < 16; ++j) { t1[j] = unfkey(k1[j] & ~127u); t2[j] = unfkey(k2[j] & ~127u);
            i1p[j >> 2] |= (127u - (k1[j] & 127u)) << (8 * (j & 3)); i2p[j >> 2] |= (127u - (k2[j] & 127u)) << (8 * (j & 3)); }
        unsigned kc[16];
#pragma unroll
        for (int j = 0; j < 16; ++j) kc[j] = 0u;
#pragma unroll
        for (int a = 0; a < 16; ++a)
#pragma unroll
            for (int b = 0; b < 16; ++b)
                if ((a + 1) * (b + 1) <= 16) key_insert(kc, (fkey(t1[a] + t2[b]) & ~255u) | (unsigned)(a * 16 + b));
        float e[16]; unsigned ei[16]; float mx = -3.0e38f;
#pragma unroll
        for (int j = 0; j < 16; ++j) { const unsigned a = (kc[j] >> 4) & 15u, b = kc[j] & 15u;
            const unsigned wa = (a >> 2) == 0u ? i1p[0] : (a >> 2) == 1u ? i1p[1] : (a >> 2) == 2u ? i1p[2] : i1p[3];
            const unsigned wb = (b >> 2) == 0u ? i2p[0] : (b >> 2) == 1u ? i2p[1] : (b >> 2) == 2u ? i2p[2] : i2p[3];
            ei[j] = (((wa >> (8 * (a & 3u))) & 127u) << 7) | ((wb >> (8 * (b & 3u))) & 127u);
            e[j] = unfkey(kc[j] & ~255u); mx = fmaxf(mx, e[j]); }
        float sum = 0.f;
#pragma unroll
        for (int j = 0; j < 16; ++j) { e[j] = __expf(e[j] - mx); sum += e[j]; }
        const float inv = 1.0f / sum;
        uint2* dst = ROUTE + (size_t)p * 16; unsigned short* de = EID + (size_t)p * 16;
#pragma unroll
        for (int j = 0; j < 16; ++j) { dst[j] = make_uint2(ei[j], __float_as_uint(e[j] * inv)); de[j] = (unsigned short)ei[j]; }
    }
}

DI float dot2u(unsigned a, unsigned b, float acc) { return __builtin_amdgcn_fdot2_f32_bf16(__builtin_bit_cast(bf16x2_t, a), __builtin_bit_cast(bf16x2_t, b), acc, false); }
DI float dot8(const u32x4& a, const u32x4& b, float acc) {
    const unsigned a0 = a.x, a1 = a.y, a2 = a.z, a3 = a.w, b0 = b.x, b1 = b.y, b2 = b.z, b3 = b.w;
    acc = dot2u(a0, b0, acc); acc = dot2u(a1, b1, acc); acc = dot2u(a2, b2, acc); acc = dot2u(a3, b3, acc);
    return acc;
}
template <int CTRL> DI float dppf(float v) { return __builtin_bit_cast(float, __builtin_amdgcn_update_dpp(0, __builtin_bit_cast(int, v), CTRL, 0xF, 0xF, true)); }
typedef float f32x2_t __attribute__((ext_vector_type(2)));
DI void phase_peer_u(const bf16_t* H2, const unsigned short* EID, const unsigned char* PU, int rows, float* PART) {
    const int tid_ = ltid(); const int lane = tid_ & 63, wid = tid_ >> 6, g = lane >> 3, pc = lane & 7;
    const int x = lbid() & 7, gw = (lbid() >> 3) * 8 + wid, nw = (lgdim() >> 3) * 8;
    const unsigned lbase = (unsigned)(x * 128 + pc * 16);
    auto meta = [&](int r, unsigned (&e)[8], u32x4& h0, u32x4& h1) {
        const int rr = r < rows ? r : rows - 1;
        const u32x4* hp = (const u32x4*)(H2 + (unsigned)(rr * 1024 + x * 128 + pc * 16)); h0 = hp[0]; h1 = hp[1];
        const u32x4* ep = (const u32x4*)(EID + (unsigned)(rr * 128 + g * 16)); const u32x4 t0 = ep[0], t1 = ep[1];
        e[0] = t0.x; e[1] = t0.y; e[2] = t0.z; e[3] = t0.w; e[4] = t1.x; e[5] = t1.y; e[6] = t1.z; e[7] = t1.w; };
    auto finish = [&](int r, const u32x4 (&uv)[16], const u32x4& h0, const u32x4& h1) {
        float hf[16];
        { const unsigned a0 = h0.x, a1 = h0.y, a2 = h0.z, a3 = h0.w, b0 = h1.x, b1 = h1.y, b2 = h1.z, b3 = h1.w;
          hf[0] = lo2f(a0); hf[1] = hi2f(a0); hf[2] = lo2f(a1); hf[3] = hi2f(a1); hf[4] = lo2f(a2); hf[5] = hi2f(a2); hf[6] = lo2f(a3); hf[7] = hi2f(a3);
          hf[8] = lo2f(b0); hf[9] = hi2f(b0); hf[10] = lo2f(b1); hf[11] = hi2f(b1); hf[12] = lo2f(b2); hf[13] = hi2f(b2); hf[14] = lo2f(b3); hf[15] = hi2f(b3); }
        float v0 = 0.f, v1 = 0.f;
#pragma unroll
        for (int j = 0; j < 16; ++j) {
            const unsigned w0 = uv[j].x, w1 = uv[j].y, w2 = uv[j].z, w3 = uv[j].w;
            float a = 0.f;
            { const f32x2_t l = __builtin_amdgcn_cvt_pk_f32_fp8((int)w0, false), hh2 = __builtin_amdgcn_cvt_pk_f32_fp8((int)w0, true); a += l[0] * hf[0] + l[1] * hf[1] + hh2[0] * hf[2] + hh2[1] * hf[3]; }
            { const f32x2_t l = __builtin_amdgcn_cvt_pk_f32_fp8((int)w1, false), hh2 = __builtin_amdgcn_cvt_pk_f32_fp8((int)w1, true); a += l[0] * hf[4] + l[1] * hf[5] + hh2[0] * hf[6] + hh2[1] * hf[7]; }
            { const f32x2_t l = __builtin_amdgcn_cvt_pk_f32_fp8((int)w2, false), hh2 = __builtin_amdgcn_cvt_pk_f32_fp8((int)w2, true); a += l[0] * hf[8] + l[1] * hf[9] + hh2[0] * hf[10] + hh2[1] * hf[11]; }
            { const f32x2_t l = __builtin_amdgcn_cvt_pk_f32_fp8((int)w3, false), hh2 = __builtin_amdgcn_cvt_pk_f32_fp8((int)w3, true); a += l[0] * hf[12] + l[1] * hf[13] + hh2[0] * hf[14] + hh2[1] * hf[15]; }
            a += dppf<0xB1>(a); a += dppf<0x4E>(a); a += dppf<0x141>(a);
            v0 = (j < 8 && pc == (j & 7)) ? a : v0; v1 = (j >= 8 && pc == (j & 7)) ? a : v1;
        }
        if (r < rows) { float* pp = PART + (unsigned)((r * 8 + x) * 128 + g * 16 + pc); pp[0] = v0 * 0.03125f; pp[8] = v1 * 0.03125f; } };
    unsigned eA[8], eB[8]; u32x4 hA0, hA1, hB0, hB1;
    meta(gw, eA, hA0, hA1); meta(gw + nw, eB, hB0, hB1);
    for (int r = gw; r < rows; r += 2 * nw) {
        u32x4 uA[16], uB[16];
#pragma unroll
        for (int j = 0; j < 16; ++j) uA[j] = *(const u32x4*)(PU + ((((j & 1) ? (eA[j >> 1] >> 16) : (eA[j >> 1] & 0xffffu)) << 10) + lbase));
#pragma unroll
        for (int j = 0; j < 16; ++j) uB[j] = *(const u32x4*)(PU + ((((j & 1) ? (eB[j >> 1] >> 16) : (eB[j >> 1] & 0xffffu)) << 10) + lbase));
        const u32x4 cA0 = hA0, cA1 = hA1, cB0 = hB0, cB1 = hB1;
        meta(r + 2 * nw, eA, hA0, hA1); meta(r + 3 * nw, eB, hB0, hB1);
        finish(r, uA, cA0, cA1); finish(r + nw, uB, cB0, cB1);
    }
}
DI void phase_peer_w(const float* PART, const uint2* ROUTE, int rows, bf16_t* WG) {
    const int tid_ = ltid(); const int lane = tid_ & 63, wid = tid_ >> 6;
    for (int r = lbid() * 8 + wid; r < rows; r += lgdim() * 8) {
        float a0 = 0.f, a1 = 0.f;
#pragma unroll
        for (int x = 0; x < 8; ++x) { const float* pp = PART + ((size_t)r * 8 + x) * 128; a0 += pp[lane]; a1 += pp[64 + lane]; }
        const float g0 = __uint_as_float(ROUTE[(size_t)r * 128 + lane].y), g1 = __uint_as_float(ROUTE[(size_t)r * 128 + 64 + lane].y);
        WG[(size_t)r * 128 + lane] = f2bf(g0 * 0.5f * a0 * (1.0f + erff(a0 * 0.70710678118654752f)));
        WG[(size_t)r * 128 + 64 + lane] = f2bf(g1 * 0.5f * a1 * (1.0f + erff(a1 * 0.70710678118654752f)));
    }
}
DI void phase_peer_v(const bf16_t* WG, const unsigned short* EID, const unsigned char* PV, const float* mod, int is_ctx, int b0, int rows, bf16_t* X, bool dry) {
    const int tid_ = ltid(); const int lane = tid_ & 63, wid = tid_ >> 6, g = lane >> 3, pc = lane & 7;
    const int x = lbid() & 7, gw = (lbid() >> 3) * 8 + wid, nw = (lgdim() >> 3) * 8;
    const unsigned lbase = (unsigned)(x * 128 + pc * 16);
    const int mydim = x * 128 + pc * 16 + 8 * ((lane >> 5) & 1) + 4 * ((lane >> 4) & 1) + 2 * ((lane >> 3) & 1);
    auto meta = [&](int r, unsigned (&e)[8]) {
        const int rr = r < rows ? r : rows - 1;
        const u32x4* ep = (const u32x4*)(EID + (unsigned)(rr * 128 + g * 16)); const u32x4 t0 = ep[0], t1 = ep[1];
        e[0] = t0.x; e[1] = t0.y; e[2] = t0.z; e[3] = t0.w; e[4] = t1.x; e[5] = t1.y; e[6] = t1.z; e[7] = t1.w; };
    auto wload = [&](int r, unsigned (&w)[8]) {
        const int rr = r < rows ? r : rows - 1;
        const u32x4* wp = (const u32x4*)(WG + (unsigned)(rr * 128 + g * 16)); const u32x4 t0 = wp[0], t1 = wp[1];
        w[0] = t0.x; w[1] = t0.y; w[2] = t0.z; w[3] = t0.w; w[4] = t1.x; w[5] = t1.y; w[6] = t1.z; w[7] = t1.w; };
    auto finish = [&](int r, const u32x4 (&vv)[16], const unsigned (&w)[8]) {
        float o[16];
#pragma unroll
        for (int i = 0; i < 16; ++i) o[i] = 0.f;
#pragma unroll
        for (int j = 0; j < 16; ++j) { const unsigned w0 = vv[j].x, w1 = vv[j].y, w2 = vv[j].z, w3 = vv[j].w; const float wj = (j & 1) ? hi2f(w[j >> 1]) : lo2f(w[j >> 1]);
            { const f32x2_t l = __builtin_amdgcn_cvt_pk_f32_fp8((int)w0, false), h2 = __builtin_amdgcn_cvt_pk_f32_fp8((int)w0, true); o[0] += wj * l[0]; o[1] += wj * l[1]; o[2] += wj * h2[0]; o[3] += wj * h2[1]; }
            { const f32x2_t l = __builtin_amdgcn_cvt_pk_f32_fp8((int)w1, false), h2 = __builtin_amdgcn_cvt_pk_f32_fp8((int)w1, true); o[4] += wj * l[0]; o[5] += wj * l[1]; o[6] += wj * h2[0]; o[7] += wj * h2[1]; }
            { const f32x2_t l = __builtin_amdgcn_cvt_pk_f32_fp8((int)w2, false), h2 = __builtin_amdgcn_cvt_pk_f32_fp8((int)w2, true); o[8] += wj * l[0]; o[9] += wj * l[1]; o[10] += wj * h2[0]; o[11] += wj * h2[1]; }
            { const f32x2_t l = __builtin_amdgcn_cvt_pk_f32_fp8((int)w3, false), h2 = __builtin_amdgcn_cvt_pk_f32_fp8((int)w3, true); o[12] += wj * l[0]; o[13] += wj * l[1]; o[14] += wj * h2[0]; o[15] += wj * h2[1]; } }
        float k8[8], k4[4], k2[2];
#pragma unroll
        for (int i = 0; i < 8; ++i) { const bool up = (lane & 32) != 0; const float send = up ? o[i] : o[i + 8]; k8[i] = (up ? o[i + 8] : o[i]) + shx(send, 32, lane); }
#pragma unroll
        for (int i = 0; i < 4; ++i) { const bool up = (lane & 16) != 0; const float send = up ? k8[i] : k8[i + 4]; k4[i] = (up ? k8[i + 4] : k8[i]) + shx(send, 16, lane); }
#pragma unroll
        for (int i = 0; i < 2; ++i) { const bool up = (lane & 8) != 0; const float send = up ? k4[i] : k4[i + 2]; k2[i] = (up ? k4[i + 2] : k4[i]) + dppf<0x128>(send); }
        if (dry && k2[0] != 12345.678f) return;
        if (r < rows) {
            const int bi = is_ctx ? 32 : b0 + (r >> 11);
            const float2 m = *(const float2*)(mod + (unsigned)(bi * 6144 + 5 * 1024 + mydim));
            unsigned* xr = (unsigned*)(X + (unsigned)(r * 1024 + mydim)); const unsigned xw = *xr; *xr = pk2(lo2f(xw) + m.x * k2[0], hi2f(xw) + m.y * k2[1]);
        } };
    unsigned eA[8];
    meta(gw, eA);
    for (int r = gw; r < rows; r += nw) {
        u32x4 vA[16]; unsigned wA[8];
#pragma unroll
        for (int j = 0; j < 16; ++j) vA[j] = *(const u32x4*)(PV + ((((j & 1) ? (eA[j >> 1] >> 16) : (eA[j >> 1] & 0xffffu)) << 10) + lbase));
        wload(r, wA);
        meta(r + nw, eA);
        finish(r, vA, wA);
    }
}

DI void phase_final(const bf16_t* xb, float* out, const float* gain, int rows) {
    const int tid_ = ltid(); const int lane = tid_ & 63, wid = tid_ >> 6;
    for (int r = lbid() * 8 + wid; r < rows; r += lgdim() * 8) {
        float4 v[4]; float ss = 0.f;
#pragma unroll
        for (int j = 0; j < 4; ++j) { const u32x2 w = ((const u32x2*)(xb + (size_t)r * 1024))[lane + 64 * j]; v[j] = make_float4(lo2f(w.x), hi2f(w.x), lo2f(w.y), hi2f(w.y));
            ss += v[j].x * v[j].x + v[j].y * v[j].y + v[j].z * v[j].z + v[j].w * v[j].w; }
        ss = wave_sum(ss, lane);
        const float rstd = rsqrtf(ss * (1.0f / 1024.0f) + 1e-6f);
        float4* orow = (float4*)(out + (size_t)r * 1024);
#pragma unroll
        for (int j = 0; j < 4; ++j) { const float4 g = *(const float4*)(gain + (lane + 64 * j) * 4);
            float4 o; o.x = v[j].x * rstd * g.x; o.y = v[j].y * rstd * g.y; o.z = v[j].z * rstd * g.z; o.w = v[j].w * rstd * g.w; orow[lane + 64 * j] = o; }
    }
}

enum { PH_NORM1 = 0, PH_INPROJ, PH_PREP, PH_UPPROJ, PH_MIX, PH_GLAFIN, PH_BRANCH, PH_WOUT, PH_NORM2, PH_WQ, PH_SELECT, PH_PEERU, PH_PEERW, PH_PEERV, PH_COUNT };

struct RunArgs { int mode;
                 int layer, chunk, phase; };

struct Bufs { bf16_t *H, *Z, *QB, *KN, *VT, *KR, *OF, *OB, *MLA, *PD, *PO, *GF, *MMB, *PQ; float *RS, *MMF, *CST, *PART; _Float16* SC; bf16_t* WG; unsigned short* EID; uint2* ROUTE; const bf16_t* W; const float* mod; unsigned* ctl; };
DI Bufs make_bufs(const Params& P, int is_ctx, int layer) {
    __attribute__((address_space(1))) unsigned char* gws = (__attribute__((address_space(1))) unsigned char*)P.ws; asm volatile("" : "+s"(gws));
    unsigned char* ws = (unsigned char*)gws; asm volatile("" : "+s"(layer));
    Bufs B;
    B.H = (bf16_t*)(ws + WS_H); B.Z = (bf16_t*)(ws + WS_Z); B.QB = (bf16_t*)(ws + WS_QB);
    B.KN = (bf16_t*)(ws + (is_ctx ? WS_CKN : WS_KN)); B.VT = (bf16_t*)(ws + (is_ctx ? WS_CVT : WS_VT)); B.KR = (bf16_t*)(ws + (is_ctx ? WS_CKR : WS_KR));
    B.RS = (float*)(ws + WS_RS); B.OF = (bf16_t*)(ws + WS_OF); B.OB = (bf16_t*)(ws + WS_OB); B.MLA = (bf16_t*)(ws + WS_MLA);
    B.PD = (bf16_t*)(ws + WS_PD); B.PO = (bf16_t*)(ws + WS_PO); B.GF = B.PO; B.MMF = (float*)(ws + WS_OF); B.MMB = (bf16_t*)(ws + WS_VT);
    B.PQ = B.QB; B.SC = (_Float16*)(ws + WS_Z); B.ROUTE = (uint2*)(ws + WS_ROUTE); B.PART = (float*)(ws + WS_Z + 128 * MiB); B.WG = (bf16_t*)(ws + WS_Z + 192 * MiB); B.EID = (unsigned short*)(ws + WS_Z + 200 * MiB); B.CST = (float*)(ws + WS_CST);
    B.W = (const bf16_t*)(ws + WS_W) + (size_t)layer * W_LAYER; B.mod = (const float*)(ws + WS_MOD) + (size_t)layer * 33 * 6144; B.ctl = (unsigned*)(ws + WS_CTL);
    return B;
}

DI Params kparams() {
    Params P;
#if defined(__HIP_DEVICE_COMPILE__)
    typedef const void* cvp; typedef const __attribute__((address_space(1))) void* gvp;
    const __attribute__((address_space(4))) gvp* q = (const __attribute__((address_space(4))) gvp*)__builtin_amdgcn_kernarg_segment_ptr();
    asm volatile("" : "+s"(q));
#pragma unroll
    for (int i = 0; i < (int)(sizeof(Params) / sizeof(void*)); ++i) ((cvp*)&P)[i] = (cvp)q[i];
#endif
    return P;
}

__global__ void __launch_bounds__(NTHR, 2) fwd_kernel(Params Pk, RunArgs R) {
    extern __shared__ __attribute__((aligned(16))) unsigned char smem[];
    LAS unsigned char* lds = (LAS unsigned char*)smem;
    LAS unsigned* ctlw = (LAS unsigned*)(lds + LDS_BYTES - 64);
    unsigned* ctl = (unsigned*)(Pk.ws + WS_CTL);
    if (threadIdx.x == 0) { ctlw[0] = 0u; ctlw[1] = 0u; ctlw[2] = 0u; ctlw[3] = 0u; }
    __syncthreads();
    XcdBarrier bar; bar.bar = ctl; bar.x = 0; bar.st = (volatile LAS unsigned*)ctlw;
    const bool single = (R.mode == 0);
    if (single) bar = xcd_barrier_post(ctl, (volatile LAS unsigned*)ctlw);
#define GRID_SYNC() do { if (single) xcd_barrier(bar); } while (0)

    if (R.mode == 0 || R.mode == 1) for (int rep_ = 0; rep_ < ((REP_PHASE) == 100 ? 2 : 1); ++rep_) { const Params P = kparams(); phase_convert(P, lds); phase_mod(P, lds); __syncthreads(); }
    GRID_SYNC();

    if (R.mode == 0 || R.mode == 2) {
    const int l_lo = single ? 0 : R.layer, l_hi = single ? NLAYER : R.layer + 1;
    const int c_lo = single ? 0 : R.chunk, c_hi = single ? 5 : R.chunk + 1;
    for (int layer = l_lo; layer < l_hi; ++layer)
    for (int ci = c_lo; ci < c_hi; ++ci) {
        const bool is_ctx = (ci == 0);
        const bool ctx_kv_only = is_ctx && layer == NLAYER - 1;
#define RUN(ph) (single || lnd(R.phase) == (ph))
#define REP(ph) for (int rep_ = 0; rep_ < (((REP_PHASE) == (ph) || (REP_PHASE) == 999) ? 2 : 1); ++rep_)
#define PHASE_LOCALS const Params P = kparams(); const Chunk ck = make_chunk(P, layer, ci); const Bufs B = make_bufs(P, ck.is_ctx, layer); const int rows = ck.rows, np = ck.np; (void)rows; (void)np;

        if ((REP_PHASE) == 200) { for (int xb = 0; xb < 10; ++xb) GRID_SYNC(); }
        if (RUN(PH_NORM1)) REP(PH_NORM1) { PHASE_LOCALS if (layer == 0) phase_norm<true>(ck.x32, rows, P.norm1_g + layer * 1024, B.mod, ck.is_ctx, ck.b0, 0, B.H); else phase_norm<false>(ck.xb, rows, P.norm1_g + layer * 1024, B.mod, ck.is_ctx, ck.b0, 0, B.H); }
        GRID_SYNC();
        if (RUN(PH_INPROJ)) REP(PH_INPROJ) { PHASE_LOCALS
            const bf16_t* H = B.H; const bf16_t* W = B.W; bf16_t* Z = B.Z;
            auto S = make_sched(np, ZLD / 256, [=](Unit& u) { u.A = (const char*)(H + (size_t)u.pm * 256 * 1024); u.B = (const char*)(W + WO_IN + (size_t)u.pn * 256 * 1024); });
            pg8::gemm_phase(lds, 1024, 1024, 1024, S, [=](const f32x4 (&acc)[2][2][4][2], const Unit& u, int wr, int wc, int fr, int fq) {
                const bool is_gate = (u.pn >= ZC_GZ / 256) && (u.pn < (ZC_GZ + 3072) / 256);
                pg8::epi8(acc, wr, wc, fr, fq, [&](int row, int col, const f32x4& a, const f32x4& b) {
                    f32x4 a2 = a, b2 = b;
                    if (is_gate) {
#pragma unroll
                        for (int j = 0; j < 4; ++j) { a2[j] = sigmoidf_(a[j]); b2[j] = sigmoidf_(b[j]); } }
                    store8_bf16(Z + (size_t)(u.pm * 256 + row) * ZLD + u.pn * 256 + col, a2, b2); }); });
        }
        GRID_SYNC();
        if (RUN(PH_PREP)) REP(PH_PREP) { PHASE_LOCALS phase_prep(B.Z, rows, ck.is_ctx, B.RS, B.KR, B.PD, !ctx_kv_only, (const float2*)(P.ws + WS_ROPE)); }
        GRID_SYNC();
        if (RUN(PH_UPPROJ)) REP(PH_UPPROJ) {
            if (!ctx_kv_only) { PHASE_LOCALS
                const bf16_t* Z = B.Z; const bf16_t* W = B.W; bf16_t* QB = B.QB; const float* RS = B.RS;
                auto S = make_sched(np, 6, [=](Unit& u) { u.A = (const char*)(Z + (size_t)u.pm * 256 * ZLD + ZC_QDN); u.B = (const char*)(W + WO_UQ + (size_t)u.pn * 256 * 384); });
                pg8::gemm_phase(lds, ZLD, 384, 384, S, [=](const f32x4 (&acc)[2][2][4][2], const Unit& u, int wr, int wc, int fr, int fq) {
                    pg8::epi8(acc, wr, wc, fr, fq, [&](int row, int col, const f32x4& a, const f32x4& b) { const int gr = u.pm * 256 + row; const float s = RS[gr];
                        store8_bf16(QB + (size_t)gr * 1536 + u.pn * 256 + col, a * s, b * s); }); });
            }
            { PHASE_LOCALS
                const bf16_t* Z = B.Z; const bf16_t* W = B.W; bf16_t* KN = B.KN; const float* RS = B.RS;
                auto S = make_sched(np, 4, [=](Unit& u) { u.A = (const char*)(Z + (size_t)u.pm * 256 * ZLD + ZC_KVDN); u.B = (const char*)(W + WO_KN + (size_t)u.pn * 256 * 256); });
                pg8::gemm_phase(lds, ZLD, 256, 256, S, [=](const f32x4 (&acc)[2][2][4][2], const Unit& u, int wr, int wc, int fr, int fq) {
                    pg8::epi8(acc, wr, wc, fr, fq, [&](int row, int col, const f32x4& a, const f32x4& b) { const int gr = u.pm * 256 + row; const float s = RS[16384 + gr];
                        store8_bf16(KN + (size_t)gr * 1024 + u.pn * 256 + col, a * s, b * s); }); });
            }
            { PHASE_LOCALS
                const bf16_t* Z = B.Z; const bf16_t* W = B.W; bf16_t* VT = B.VT; const float* RS = B.RS;
                auto S = make_sched(4, np, [=](Unit& u) { u.A = (const char*)(W + WO_V + (size_t)u.pm * 256 * 256); u.B = (const char*)(Z + (size_t)u.pn * 256 * ZLD + ZC_KVDN); });
                pg8::gemm_phase(lds, 256, ZLD, 256, S, [=](const f32x4 (&acc)[2][2][4][2], const Unit& u, int wr, int wc, int fr, int fq) {
                    pg8::epi8(acc, wr, wc, fr, fq, [&](int row, int col, const f32x4& a, const f32x4& b) { const int tk = u.pn * 256 + col;
                        const f32x4 r0 = *(const f32x4*)(RS + 16384 + tk), r1 = *(const f32x4*)(RS + 16384 + tk + 4);
                        store8_bf16(VT + (size_t)(u.pm * 256 + row) * rows + tk, a * r0, b * r1); }); });
            }
        }
        GRID_SYNC();
        if (RUN(PH_MIX)) for (int rep_ = 0; rep_ < (((REP_PHASE) == PH_MIX || (REP_PHASE) == 201 || (REP_PHASE) == 202 || (REP_PHASE) == 999) ? 2 : 1); ++rep_) { PHASE_LOCALS
            const int nbat = ck.is_ctx ? NB : 8;
            const int nG = (rep_ != 0 && (REP_PHASE) == 202) ? 0 : nbat * 8;
            const int nA = (rep_ != 0 && (REP_PHASE) == 201) ? 0 : (ck.is_ctx ? (layer == 0 ? NB * 8 : 0) : 8 * 8 * 8);
            unsigned* ctr = B.ctl + CTL_WORKQ + 64 * (layer * 5 + ci) + 64 * 16 * rep_;
            const int seqlen = ck.is_ctx ? TC : TL;
            for (;;) {
                if (ltid() == 0) ctlw[4] = xb_add(ctr, 1u);
                __syncthreads();
                const int item = (int)ctlw[4];
                __syncthreads();
                if (item >= nG + nA) break;
                if (item < nG) {
                    const int dir = item & 1, h = (item >> 1) & 3, bl = item >> 3;
                    const int b = ck.b0 + bl;
                    float* st = B.CST + (size_t)((b * 4 + h) * 2 + dir) * 128 * 256;
                    gla_item(lds, B.Z + (size_t)bl * seqlen * ZLD, seqlen, h, dir, P.gla_gate_w + ((size_t)layer * 2 + dir) * 16 * 512, P.gla_gate_b + ((size_t)layer * 2 + dir) * 512,
                             ck.is_ctx ? nullptr : st, ck.is_ctx ? st : nullptr, (dir ? B.OB : B.OF) + (size_t)bl * seqlen * 1024);
                } else {
                    const int a = item - nG;
                    int h, nt0, nt1, ldv0, tq0; bool rope; const bf16_t *Qp, *kn0, *kr0, *vt0, *kn1, *kr1, *vt1; bf16_t* Op;
                    if (ck.is_ctx) {
                        h = a & 7; const int bl = a >> 3; rope = false; tq0 = 0;
                        Qp = B.QB + (size_t)bl * TC * 1536; kn0 = B.KN + (size_t)bl * TC * 1024; kr0 = B.KR + (size_t)bl * TC * 64; vt0 = B.VT + (size_t)bl * TC; ldv0 = rows; nt0 = TC / 64;
                        kn1 = kn0; kr1 = kr0; vt1 = vt0; nt1 = 0; Op = B.MLA + (size_t)bl * TC * 1024;
                    } else {
                        const int qb = a & 7; h = (a >> 3) & 7; const int bl = a >> 6; const int b = ck.b0 + bl; rope = true; tq0 = qb * 256;
                        const bf16_t* CKN = (const bf16_t*)(P.ws + WS_CKN); const bf16_t* CKR = (const bf16_t*)(P.ws + WS_CKR); const bf16_t* CVT = (const bf16_t*)(P.ws + WS_CVT);
                        Qp = B.QB + (size_t)(bl * TL + qb * 256) * 1536; kn0 = CKN + (size_t)b * TC * 1024; kr0 = CKR + (size_t)b * TC * 64; vt0 = CVT + (size_t)b * TC; ldv0 = NB * TC; nt0 = TC / 64;
                        kn1 = B.KN + (size_t)bl * TL * 1024; kr1 = B.KR + (size_t)bl * TL * 64; vt1 = B.VT + (size_t)bl * TL; nt1 = TL / 64; Op = B.MLA + (size_t)(bl * TL + qb * 256) * 1024;
                    }
                    attn_item(lds, (const float2*)(P.ws + WS_ROPE), Qp, h, rope, tq0, kn0, kr0, vt0, ldv0, nt0, kn1, kr1, vt1, rows, nt1, Op);
                }
            }
        }
        GRID_SYNC();
        if (!ctx_kv_only) {
        if (RUN(PH_GLAFIN)) REP(PH_GLAFIN) { PHASE_LOCALS phase_glafin(B.OF, B.OB, B.Z, P.gla_norm_g + layer * 256, rows, B.GF); }
        GRID_SYNC();
        if (RUN(PH_BRANCH)) REP(PH_BRANCH) { PHASE_LOCALS
            const bf16_t* PO = B.PD; const bf16_t* GF = B.GF; const bf16_t* MLA = B.MLA; const bf16_t* W = B.W; const bf16_t* Z = B.Z; bf16_t* MMS = (bf16_t*)B.MMF; bf16_t* MMB = B.MMB;
            auto fill = [=](Unit& u) { const bf16_t* a = (u.z == 0) ? PO : (u.z == 1) ? GF : MLA;   u.A = (const char*)(a + (size_t)u.pm * 256 * 1024);
                                       u.B = (const char*)(W + WO_BR + (size_t)u.z * 1048576 + (size_t)u.pn * 256 * 1024); };
            TripleSched<decltype(fill)> S{np, 4, lgdim(), lbid(), fill};
            pg8::gemm_phase(lds, 1024, 1024, 1024, S, [=](const f32x4 (&acc)[2][2][4][2], const Unit& u, int wr, int wc, int fr, int fq) {
                pg8::epi8(acc, wr, wc, fr, fq, [&](int row, int col, const f32x4& a, const f32x4& b) {
                    const int gr = u.pm * 256 + row, c = u.pn * 256 + col;
                    const u32x4 gz = *(const u32x4*)(Z + (size_t)gr * ZLD + ZC_GZ + u.z * 1024 + c);
                    f32x4 va, vb;
                    va[0] = a[0] * lo2f(gz.x); va[1] = a[1] * hi2f(gz.x); va[2] = a[2] * lo2f(gz.y); va[3] = a[3] * hi2f(gz.y);
                    vb[0] = b[0] * lo2f(gz.z); vb[1] = b[1] * hi2f(gz.z); vb[2] = b[2] * lo2f(gz.w); vb[3] = b[3] * hi2f(gz.w);
                    bf16_t* mp = MMS + (size_t)gr * 1024 + c;
                    if (u.z != 0) { const u32x4 pm = *(const u32x4*)mp;
                        va[0] += lo2f(pm.x); va[1] += hi2f(pm.x); va[2] += lo2f(pm.y); va[3] += hi2f(pm.y); vb[0] += lo2f(pm.z); vb[1] += hi2f(pm.z); vb[2] += lo2f(pm.w); vb[3] += hi2f(pm.w); }
                    store8_bf16((u.z == 2 ? MMB : mp) + (u.z == 2 ? (size_t)gr * 1024 + c : 0), va, vb); }); });
        }
        GRID_SYNC();
        if (RUN(PH_WOUT)) for (int rep_ = 0; rep_ < (((REP_PHASE) == PH_WOUT || (REP_PHASE) == 999) && layer == 0 ? 2 : 1); ++rep_) { PHASE_LOCALS
            const bf16_t* MMB = B.MMB; const bf16_t* W = B.W; const float* mod = B.mod;
            auto S = make_sched(np, 4, [=](Unit& u) { u.A = (const char*)(MMB + (size_t)u.pm * 256 * 1024); u.B = (const char*)(W + WO_OUT + (size_t)u.pn * 256 * 1024); });
            const float* x32 = ck.x32; bf16_t* xb = ck.xb; const int isc = ck.is_ctx, b0 = ck.b0;
            pg8::gemm_phase(lds, 1024, 1024, 1024, S, [=](const f32x4 (&acc)[2][2][4][2], const Unit& u, int wr, int wc, int fr, int fq) {
                const int bi = isc ? 32 : b0 + (u.pm >> 3);
                const float* g1 = mod + (size_t)bi * 6144 + 2 * 1024;
                pg8::epi8(acc, wr, wc, fr, fq, [&](int row, int col, const f32x4& a, const f32x4& b) {
                    const int c = u.pn * 256 + col; const size_t o = (size_t)(u.pm * 256 + row) * 1024 + c;
                    const f32x4 ga = *(const f32x4*)(g1 + c), gb = *(const f32x4*)(g1 + c + 4);
                    f32x4 xa, xv;
                    if (x32) { xa = *(const f32x4*)(x32 + o); xv = *(const f32x4*)(x32 + o + 4); }
                    else { const u32x4 w = *(const u32x4*)(xb + o); xa[0] = lo2f(w.x); xa[1] = hi2f(w.x); xa[2] = lo2f(w.y); xa[3] = hi2f(w.y); xv[0] = lo2f(w.z); xv[1] = hi2f(w.z); xv[2] = lo2f(w.w); xv[3] = hi2f(w.w); }
                    store8_bf16(xb + o, xa + ga * a, xv + gb * b); }); });
        }
        GRID_SYNC();
        if (RUN(PH_NORM2)) REP(PH_NORM2) { PHASE_LOCALS phase_norm<false>(ck.xb, rows, P.norm2_g + layer * 1024, B.mod, ck.is_ctx, ck.b0, 3, B.H); }
        GRID_SYNC();
        if (RUN(PH_WQ)) REP(PH_WQ) { PHASE_LOCALS
            const bf16_t* H = B.H; const bf16_t* W = B.W; _Float16* SC = B.SC;
            auto S = make_sched(np, 8, [=](Unit& u) { u.A = (const char*)(H + (size_t)u.pm * 256 * 1024); u.B = (const char*)(W + WO_Q + (size_t)u.pn * 256 * 1024); });
            pg8::gemm_phase(lds, 1024, 1024, 1024, S, [=](const f32x4 (&acc)[2][2][4][2], const Unit& u, int wr, int wc, int fr, int fq) {
                pg8::epi8(acc, wr, wc, fr, fq, [&](int row, int col, const f32x4& a, const f32x4& b) {
                    h16x8 hv; hv[0] = (_Float16)a[0]; hv[1] = (_Float16)a[1]; hv[2] = (_Float16)a[2]; hv[3] = (_Float16)a[3]; hv[4] = (_Float16)b[0]; hv[5] = (_Float16)b[1]; hv[6] = (_Float16)b[2]; hv[7] = (_Float16)b[3];
                    *(h16x8*)(SC + (size_t)(u.pm * 256 + row) * 2048 + u.pn * 256 + col) = hv; }); });
        }
        GRID_SYNC();
        if (RUN(PH_SELECT)) REP(PH_SELECT) { PHASE_LOCALS phase_select(B.SC, rows, B.ROUTE, B.EID, lds); }
        GRID_SYNC();
        if (RUN(PH_PEERU)) REP(PH_PEERU) { PHASE_LOCALS phase_peer_u(B.H, B.EID, (const unsigned char*)(B.W + WO_PU), rows, B.PART); }
        GRID_SYNC();
        if (RUN(PH_PEERW)) REP(PH_PEERW) { PHASE_LOCALS phase_peer_w(B.PART, B.ROUTE, rows, B.WG); }
        GRID_SYNC();
        if (RUN(PH_PEERV)) REP(PH_PEERV) { PHASE_LOCALS phase_peer_v(B.WG, B.EID, (const unsigned char*)(B.W + WO_PV), B.mod, ck.is_ctx, ck.b0, rows, ck.xb, rep_ != 0); }
        GRID_SYNC();
        }
    }
    }
    if (R.mode == 0 || R.mode == 3) { const Params P = kparams(); phase_final((const bf16_t*)(P.ws + WS_XL), P.out, P.final_norm_g, NB * TL); }
#undef RUN
#undef GRID_SYNC
#undef PHASE_LOCALS
}

extern "C" void kernel_launch(void* const* d_in, const int* in_sizes, int n_in, void* d_out, int out_size, void* d_ws, size_t ws_size, hipStream_t stream) {
    static int grid = 0;
    if (grid == 0) {
        if (n_in != 25 || ws_size < WS_END) { fprintf(stderr, "kernel_launch: need 25 inputs and %zu bytes of workspace (got %d, %zu)\n", (size_t)WS_END, n_in, ws_size); grid = -1; return; }
        int dev = 0, cus = 0, per_cu = 0;
        if (hipGetDevice(&dev) != hipSuccess || hipDeviceGetAttribute(&cus, hipDeviceAttributeMultiprocessorCount, dev) != hipSuccess) { grid = -1; return; }
        if (hipFuncSetAttribute((const void*)fwd_kernel, hipFuncAttributeMaxDynamicSharedMemorySize, LDS_BYTES) != hipSuccess) { fprintf(stderr, "kernel_launch: hipFuncSetAttribute failed\n"); grid = -1; return; }
        if (hipOccupancyMaxActiveBlocksPerMultiprocessor(&per_cu, (const void*)fwd_kernel, NTHR, LDS_BYTES) != hipSuccess || per_cu < 1) { fprintf(stderr, "kernel_launch: occupancy query says %d\n", per_cu); grid = -1; return; }
        grid = cus;
    }
    if (grid <= 0) return;
    (void)hipMemsetAsync((char*)d_ws + WS_CTL, 0, CTL_BYTES, stream);
    Params P{};
    const float* const* in = (const float* const*)d_in;
    P.x = in[0]; P.c = in[1]; P.ctx = in[2]; P.c_ctx = in[3]; P.ada_w = in[4]; P.ada_b = in[5]; P.norm1_g = in[6]; P.norm2_g = in[7]; P.w_in = in[8]; P.pool_w = in[9];
    P.pool_scale = in[10]; P.gla_gate_w = in[11]; P.gla_gate_b = in[12]; P.gla_norm_g = in[13]; P.mla_q_norm_g = in[14]; P.mla_kv_norm_g = in[15]; P.mla_w_uq = in[16];
    P.mla_w_ukv = in[17]; P.branch_w = in[18]; P.w_out = in[19]; P.peer_wq = in[20]; P.peer_keys = in[21]; P.peer_u = in[22]; P.peer_v = in[23]; P.final_norm_g = in[24];
    P.out = (float*)d_out; P.ws = (unsigned char*)d_ws;
#if MK_SINGLE
    RunArgs R{0, 0, 0, 0};
    hipLaunchKernelGGL(fwd_kernel, dim3(grid), dim3(NTHR), LDS_BYTES, stream, P, R);
#else
    { RunArgs R{1, 0, 0, 0}; hipLaunchKernelGGL(fwd_kernel, dim3(grid), dim3(NTHR), LDS_BYTES, stream, P, R); }
    for (int layer = 0; layer < NLAYER; ++layer)
        for (int ci = 0; ci < 5; ++ci)
            for (int ph = 0; ph < PH_COUNT; ++ph) {
                if (ci == 0 && layer == NLAYER - 1 && ph >= PH_GLAFIN) continue;
                RunArgs R{2, layer, ci, ph}; hipLaunchKernelGGL(fwd_kernel, dim3(grid), dim3(NTHR), LDS_BYTES, stream, P, R); }
    { RunArgs R{3, 0, 0, 0}; hipLaunchKernelGGL(fwd_kernel, dim3(grid), dim3(NTHR), LDS_BYTES, stream, P, R); }
#endif
}
```

```cpp
#include <hip/hip_runtime.h>
#include <stdint.h>
#include <stdio.h>

#ifndef REP_PHASE
#define REP_PHASE -1
#endif
#ifndef MK_SINGLE
#define MK_SINGLE 1
#endif

#define DI __device__ __forceinline__
#define LAS __attribute__((address_space(3)))

typedef unsigned short bf16_t;
typedef short bf16x8 __attribute__((ext_vector_type(8)));
typedef short s16x4 __attribute__((ext_vector_type(4)));
typedef float f32x4 __attribute__((ext_vector_type(4)));
typedef float f32x16 __attribute__((ext_vector_type(16)));
typedef unsigned u32x4 __attribute__((ext_vector_type(4)));
typedef unsigned u32x2 __attribute__((ext_vector_type(2)));
typedef __bf16 bf16x2_t __attribute__((ext_vector_type(2)));
typedef _Float16 h16x8 __attribute__((ext_vector_type(8)));

constexpr int D = 1024, NB = 32, TL = 2048, TC = 256, NLAYER = 2;
constexpr int ZLD = 7936;
constexpr int ZC_P = 0, ZC_Q = 1024, ZC_K = 1536, ZC_V = 2048, ZC_R = 3072, ZC_GZ = 4096, ZC_QDN = 7168, ZC_KVDN = 7552,
              ZC_KROPE = 7808, ZC_LRF = 7872, ZC_LRB = 7888;
constexpr int NEXP = 16384;
constexpr int NWG = 256, NTHR = 512;
constexpr int LDS_BYTES = 147456;

constexpr size_t WO_IN = 0, WO_POOL = WO_IN + (size_t)ZLD * 1024, WO_UQ = WO_POOL + 4 * 256 * 256, WO_KN = WO_UQ + 1536 * 384,
                 WO_V = WO_KN + 1024 * 256, WO_BR = WO_V + 1024 * 256, WO_OUT = WO_BR + 3 * 1024 * 1024, WO_Q = WO_OUT + 1024 * 1024,
                 WO_KEYS = WO_Q + 2048 * 1024, WO_PU = WO_KEYS + 8 * 256 * 256, WO_PV = WO_PU + (size_t)NEXP * 512,
                 W_LAYER = WO_PV + (size_t)NEXP * 512;

constexpr size_t MiB = 1048576;
constexpr size_t WS_CTL = 0;
constexpr size_t CTL_BYTES = 65536;
constexpr size_t WS_MOD = WS_CTL + CTL_BYTES;
constexpr size_t WS_ROPE = WS_MOD + 1792 * 1024;
constexpr size_t WS_W = WS_MOD + 2 * MiB;
constexpr size_t WS_H = WS_W + ((2 * W_LAYER * 2 + 255) / 256) * 256;
constexpr size_t WS_Z = WS_H + 32 * MiB;
constexpr size_t WS_QB = WS_Z + 248 * MiB;
constexpr size_t WS_KN = WS_QB + 48 * MiB;
constexpr size_t WS_VT = WS_KN + 32 * MiB;
constexpr size_t WS_KR = WS_VT + 32 * MiB;
constexpr size_t WS_CKN = WS_KR + 2 * MiB;
constexpr size_t WS_CVT = WS_CKN + 16 * MiB;
constexpr size_t WS_CKR = WS_CVT + 16 * MiB;
constexpr size_t WS_CST = WS_CKR + 1 * MiB;
constexpr size_t WS_RS = WS_CST + 32 * MiB;
constexpr size_t WS_OF = WS_RS + 1 * MiB;
constexpr size_t WS_OB = WS_OF + 32 * MiB;
constexpr size_t WS_MLA = WS_OB + 32 * MiB;
constexpr size_t WS_PD = WS_MLA + 32 * MiB;
constexpr size_t WS_PO = WS_PD + 32 * MiB;
constexpr size_t WS_ROUTE = WS_PO + 32 * MiB;
constexpr size_t WS_XCTX = WS_ROUTE + 16 * MiB;
constexpr size_t WS_XL = WS_XCTX + 16 * MiB;
constexpr size_t WS_END = WS_XL + 128 * MiB;

DI float bf2f(bf16_t b) { return __uint_as_float((unsigned)b << 16); }
DI bf16_t f2bf(float f) { return __builtin_bit_cast(bf16_t, (__bf16)f); }
DI unsigned pk2(float lo, float hi) { bf16x2_t v; v[0] = (__bf16)lo; v[1] = (__bf16)hi; return __builtin_bit_cast(unsigned, v); }
DI float lo2f(unsigned w) { return __uint_as_float(w << 16); }
DI float hi2f(unsigned w) { return __uint_as_float(w & 0xffff0000u); }
DI float shx(float v, int m, int lane) { return __builtin_bit_cast(float, __builtin_amdgcn_ds_bpermute((lane ^ m) << 2, __builtin_bit_cast(int, v))); }
DI float shl(float v, int src) { return __builtin_bit_cast(float, __builtin_amdgcn_ds_bpermute(src << 2, __builtin_bit_cast(int, v))); }
DI float wave_sum(float v, int lane) {
#pragma unroll
    for (int o = 32; o >= 1; o >>= 1) v += shx(v, o, lane);
    return v;
}
DI int ltid() { int t = threadIdx.x; asm volatile("" : "+v"(t)); return t; }
DI int lnd(int x) { asm volatile("" : "+s"(x)); return x; }
DI int lbid() { return lnd((int)blockIdx.x); }
DI int lgdim() { return lnd((int)gridDim.x); }
DI float sigmoidf_(float x) { return 1.0f / (1.0f + __expf(-x)); }

#define XB_TMO      128
#define XB_XCNT(j)  (256  + 64 * (j))
#define XB_XSUB(j)  (1280 + 64 * (j))
#define XB_XGEN(j)  (2304 + 64 * (j))
#define XB_TOP      3328
#define XB_TOPGEN   3392
#define XCD_BAR_WORDS 3456
#define XB_SPIN_CAP (1u << 23)
#define CTL_WORKQ   4096

DI unsigned xb_ld(unsigned* p)              { return __hip_atomic_load(p, __ATOMIC_RELAXED, __HIP_MEMORY_SCOPE_AGENT); }
DI unsigned xb_add(unsigned* p, unsigned v) { return __hip_atomic_fetch_add(p, v, __ATOMIC_RELAXED, __HIP_MEMORY_SCOPE_AGENT); }
DI unsigned xb_xcc_id() { return (unsigned)__builtin_amdgcn_s_getreg((3 << 11) | 20) & 0xFu; }
#define XB_SPIN(cond, bar) do { unsigned _sp = 0; while (cond) { __builtin_amdgcn_s_sleep(1); \
    if ((++_sp & 255u) == 0u) { if (xb_ld(&(bar)[XB_TMO])) break; if (_sp > XB_SPIN_CAP) { atomicAdd(&(bar)[XB_TMO], 1u); break; } } } } while (0)

struct XcdBarrier { unsigned* bar; unsigned x; volatile LAS unsigned* st; };

DI XcdBarrier xcd_barrier_post(unsigned* bar, volatile LAS unsigned* st) {
    XcdBarrier b; b.bar = bar; b.x = xb_xcc_id(); b.st = st;
    if (threadIdx.x == 0) (void)xb_add(&bar[XB_XCNT(b.x)], 1u);
    return b;
}
DI void xcd_barrier_complete(unsigned* bar, unsigned x, unsigned& nloc, unsigned& nx) {
    const unsigned G = gridDim.x * gridDim.y * gridDim.z;
    unsigned sum, cnt, mine, sp = 0u;
    for (;;) {
        sum = 0u; cnt = 0u; mine = 0u;
#pragma unroll
        for (unsigned j = 0; j < 16; ++j) { const unsigned c = xb_ld(&bar[XB_XCNT(j)]); sum += c; cnt += (c > 0u) ? 1u : 0u; mine = (j == x) ? c : mine; }
        if (sum == G) break;
        __builtin_amdgcn_s_sleep(1);
        if ((++sp & 255u) == 0u) { if (xb_ld(&bar[XB_TMO])) break; if (sp > XB_SPIN_CAP) { atomicAdd(&bar[XB_TMO], 1u); break; } }
    }
    nloc = mine > 0u ? mine : 1u; nx = cnt > 0u ? cnt : 1u;
}
DI void xcd_barrier(const XcdBarrier& b) {
    asm volatile("s_waitcnt vmcnt(0)" ::: "memory");
    __syncthreads();
    if (threadIdx.x == 0) {
        __attribute__((address_space(1))) unsigned* gbar = (__attribute__((address_space(1))) unsigned*)b.bar; asm volatile("" : "+s"(gbar)); unsigned* bar = (unsigned*)gbar;
        unsigned bx = b.x; asm volatile("" : "+s"(bx));
        __builtin_amdgcn_s_waitcnt(0);
        unsigned nloc = b.st[0], nx = b.st[1];
        if (nloc == 0u) { xcd_barrier_complete(bar, bx, nloc, nx); b.st[0] = nloc; b.st[1] = nx; }
        const unsigned old = xb_add(&bar[XB_XSUB(bx)], 1u);
        const unsigned gen = old / nloc;
        if (old + 1u == (gen + 1u) * nloc) {
            __builtin_amdgcn_fence(__ATOMIC_RELEASE, "agent");
            asm volatile("s_waitcnt vmcnt(0)" ::: "memory");
            const unsigned og = xb_add(&bar[XB_TOP], 1u);
            const unsigned tg = og / nx;
            if (og + 1u == (tg + 1u) * nx) xb_add(&bar[XB_TOPGEN], 1u);
            else XB_SPIN(xb_ld(&bar[XB_TOPGEN]) == tg, bar);
            __builtin_amdgcn_fence(__ATOMIC_ACQUIRE, "agent");
            xb_add(&bar[XB_XGEN(bx)], 1u);
            asm volatile("s_waitcnt vmcnt(0)" ::: "memory");
        } else {
            XB_SPIN(xb_ld(&bar[XB_XGEN(bx)]) == gen, bar);
            __builtin_amdgcn_fence(__ATOMIC_ACQUIRE, "agent");
            asm volatile("s_waitcnt vmcnt(0)" ::: "memory");
        }
    }
    __syncthreads();
}

namespace pg8 {
constexpr int BM = 256, BK = 64, HALF = 128, HTB = HALF * BK * 2, STAGE_BYTES = 8 * HTB, NXCD = 8, WGM = 8;
DI int lds_byte(int r, int c) { const int st = (r >> 4) * 2 + (c >> 5), rr = r & 15, cc = c & 31, ob = rr * 64 + cc * 2; return st * 1024 + (ob ^ (((ob >> 9) & 1) << 5)); }
DI void stage_rc(int b, int& R, int& C) { const int st = b / 1024, sb = b % 1024, swz = sb ^ (((sb >> 9) & 1) << 5); R = (st >> 1) * 16 + swz / 64; C = (st & 1) * 32 + (swz % 64) / 2; }
DI int perm32(int rho) { const int n = rho >> 4, i = rho & 15; return 8 * (i >> 2) + 4 * n + (i & 3); }

struct Unit { const char* A; const char* B; int pm, pn, z; };

DI void tile_of(int L, int nM, int nN, int& pm, int& pn) {
    const int nwg = nM * nN; int wgid = L;
    { const int q = nwg / NXCD, r = nwg % NXCD, xcd = wgid % NXCD, off = wgid / NXCD; wgid = (xcd < r ? xcd * (q + 1) : r * (q + 1) + (xcd - r) * q) + off; }
    const int nig = WGM * nN, gid = wgid / nig, fm = gid * WGM, gsz = (nM - fm) < WGM ? (nM - fm) : WGM;
    pm = fm + ((wgid % nig) % gsz); pn = (wgid % nig) / gsz;
}

template <class F> DI void epi8(const f32x4 (&acc)[2][2][4][2], int wr, int wc, int fr, int fq, F f) {
#pragma unroll
    for (int ai = 0; ai < 2; ++ai)
#pragma unroll
        for (int m = 0; m < 4; ++m) {
            const int row = ai * HALF + wr * 64 + m * 16 + fr;
#pragma unroll
            for (int bj = 0; bj < 2; ++bj) f(row, bj * HALF + wc * 32 + 8 * fq, acc[ai][bj][m][0], acc[ai][bj][m][1]);
        }
}

template <class Epi, class Sched>
DI void gemm_phase(LAS unsigned char* lds, const int lda, const int ldb, const int K, const Sched& S, const Epi& E) {
    int tid = threadIdx.x; asm volatile("" : "+v"(tid));
    const int wid = __builtin_amdgcn_readfirstlane(tid >> 6), lane = tid & 63, wr = wid >> 2, wc = wid & 3, fr = lane & 15, fq = lane >> 4;
    const int nt = K / BK;
    unsigned voffA[2], voffB[2];
#pragma unroll
    for (int i = 0; i < 2; ++i) { int R, C; stage_rc(tid * 16 + i * 8192, R, C); const int Rb = (R & ~31) + perm32(R & 31);
        voffA[i] = (unsigned)(R * lda + C) * 2u; voffB[i] = (unsigned)(Rb * ldb + C) * 2u; }
    const size_t kstep = (size_t)(BK * 2);
    const size_t hstepA = (size_t)HALF * lda * 2, hstepB = (size_t)HALF * ldb * 2;
    const unsigned ldsw = (unsigned)wid * 1024u;
    const int aoff = lds_byte(wr * 64 + fr, fq * 8), boff = lds_byte(wc * 32 + fr, fq * 8);
#define PG8_SA(b, h) (((b) * 2 + (h)) * HTB)
#define PG8_SB(b, h) ((4 + (b) * 2 + (h)) * HTB)
#define PG8_STAGE(bufoff, gbase, voff) do { _Pragma("unroll") for (int _i = 0; _i < 2; ++_i) \
        __builtin_amdgcn_global_load_lds((const unsigned*)((const char*)(gbase) + (voff)[_i]), (LAS unsigned*)(lds + (bufoff) + ldsw + _i * 8192), 16, 0, 0); } while (0)
#define PG8_LDA(dst, b, h) do { _Pragma("unroll") for (int m = 0; m < 4; ++m) _Pragma("unroll") for (int k = 0; k < 2; ++k) dst[m][k] = *(const LAS bf16x8*)(lds + PG8_SA(b, h) + aoff + m * 2048 + k * 1024); } while (0)
#define PG8_LDB(dst, b, h) do { _Pragma("unroll") for (int n = 0; n < 2; ++n) _Pragma("unroll") for (int k = 0; k < 2; ++k) dst[n][k] = *(const LAS bf16x8*)(lds + PG8_SB(b, h) + boff + n * 2048 + k * 1024); } while (0)
#define PG8_MMA(ai, bj, At, Bt) do { __builtin_amdgcn_s_setprio(1); _Pragma("unroll") for (int m = 0; m < 4; ++m) _Pragma("unroll") for (int n = 0; n < 2; ++n) _Pragma("unroll") for (int k = 0; k < 2; ++k) \
        acc[ai][bj][m][n] = __builtin_amdgcn_mfma_f32_16x16x32_bf16(Bt[n][k], At[m][k], acc[ai][bj][m][n], 0, 0, 0); __builtin_amdgcn_s_setprio(0); } while (0)
#define PG8_WAIT_V(n) asm volatile("s_waitcnt vmcnt(" #n ")" ::: "memory")
#define PG8_WAIT_L(n) asm volatile("s_waitcnt lgkmcnt(" #n ")" ::: "memory")
#define PG8_BAR __builtin_amdgcn_s_barrier()
#define PG8_SCHED __builtin_amdgcn_sched_barrier(0)
    Unit cur, nxt; int ui = 0;
    if (!S.next(0, cur)) return;
    f32x4 acc[2][2][4][2];
#pragma unroll
    for (int a = 0; a < 2; ++a)
#pragma unroll
        for (int b = 0; b < 2; ++b)
#pragma unroll
            for (int m = 0; m < 4; ++m)
#pragma unroll
                for (int n = 0; n < 2; ++n) acc[a][b][m][n] = (f32x4){0.f, 0.f, 0.f, 0.f};
    bf16x8 At[4][2], B0[2][2], B1[2][2];
    const char* cA = cur.A; const char* cB = cur.B;
    PG8_STAGE(PG8_SB(0, 0), cB, voffB); PG8_STAGE(PG8_SA(0, 0), cA, voffA); PG8_STAGE(PG8_SB(0, 1), cB + hstepB, voffB); PG8_STAGE(PG8_SA(0, 1), cA + hstepA, voffA);
    if (wr == 1) PG8_BAR;
    PG8_WAIT_V(4); PG8_BAR;
    PG8_STAGE(PG8_SB(1, 0), cB + kstep, voffB); PG8_STAGE(PG8_SA(1, 0), cA + kstep, voffA); PG8_STAGE(PG8_SB(1, 1), cB + hstepB + kstep, voffB);
    PG8_WAIT_V(6); PG8_BAR;
    for (;;) {
        const bool has_next = S.next(ui + 1, nxt);
        const char* nA = has_next ? nxt.A : cA; const char* nB = has_next ? nxt.B : cB;
#pragma nounroll
        for (int t = 0; t < nt; t += 2) {
            const bool last = (t == nt - 2);
            const char* a1 = cA + (size_t)(t + 1) * kstep;
            const char* a2 = last ? nA : cA + (size_t)(t + 2) * kstep; const char* b2 = last ? nB : cB + (size_t)(t + 2) * kstep;
            const char* a3 = a2 + kstep; const char* b3 = b2 + kstep;
            PG8_LDB(B0, 0, 0); PG8_SCHED; PG8_LDA(At, 0, 0); PG8_STAGE(PG8_SA(1, 1), a1 + hstepA, voffA);
            PG8_WAIT_L(8); PG8_BAR; PG8_WAIT_L(0); PG8_MMA(0, 0, At, B0); PG8_BAR; PG8_SCHED;
            PG8_LDB(B1, 0, 1); PG8_STAGE(PG8_SB(0, 0), b2, voffB);
            PG8_BAR; PG8_WAIT_L(0); PG8_MMA(0, 1, At, B1); PG8_BAR;
            PG8_LDA(At, 0, 1); PG8_STAGE(PG8_SA(0, 0), a2, voffA);
            PG8_BAR; PG8_WAIT_L(0); PG8_MMA(1, 0, At, B0); PG8_BAR; PG8_SCHED;
            PG8_STAGE(PG8_SB(0, 1), b2 + hstepB, voffB);
            PG8_WAIT_V(6); PG8_BAR; PG8_MMA(1, 1, At, B1); PG8_BAR;
            PG8_LDB(B0, 1, 0); PG8_SCHED; PG8_LDA(At, 1, 0); PG8_STAGE(PG8_SA(0, 1), a2 + hstepA, voffA);
            PG8_WAIT_L(8); PG8_BAR; PG8_WAIT_L(0); PG8_MMA(0, 0, At, B0); PG8_BAR; PG8_SCHED;
            PG8_LDB(B1, 1, 1); PG8_STAGE(PG8_SB(1, 0), b3, voffB);
            PG8_BAR; PG8_WAIT_L(0); PG8_MMA(0, 1, At, B1); PG8_BAR;
            PG8_LDA(At, 1, 1); PG8_STAGE(PG8_SA(1, 0), a3, voffA);
            PG8_BAR; PG8_WAIT_L(0); PG8_MMA(1, 0, At, B0); PG8_BAR; PG8_SCHED;
            PG8_STAGE(PG8_SB(1, 1), b3 + hstepB, voffB);
            PG8_WAIT_V(6); PG8_BAR; PG8_MMA(1, 1, At, B1); PG8_BAR;
        }
        E(acc, cur, wr, wc, fr, fq);
        if (!has_next) break;
#pragma unroll
        for (int a = 0; a < 2; ++a)
#pragma unroll
            for (int b = 0; b < 2; ++b)
#pragma unroll
                for (int m = 0; m < 4; ++m)
#pragma unroll
                    for (int n = 0; n < 2; ++n) acc[a][b][m][n] = (f32x4){0.f, 0.f, 0.f, 0.f};
        cur = nxt; cA = nA; cB = nB; ++ui;
    }
    PG8_WAIT_V(0);
    if (wr == 0) PG8_BAR;
    PG8_BAR;
#undef PG8_SA
#undef PG8_SB
#undef PG8_STAGE
#undef PG8_LDA
#undef PG8_LDB
#undef PG8_MMA
#undef PG8_WAIT_V
#undef PG8_WAIT_L
#undef PG8_BAR
#undef PG8_SCHED
}
}
using pg8::Unit;

struct Params {
    const float *x, *c, *ctx, *c_ctx, *ada_w, *ada_b, *norm1_g, *norm2_g, *w_in, *pool_w, *pool_scale, *gla_gate_w, *gla_gate_b, *gla_norm_g,
                *mla_q_norm_g, *mla_kv_norm_g, *mla_w_uq, *mla_w_ukv, *branch_w, *w_out, *peer_wq, *peer_keys, *peer_u, *peer_v, *final_norm_g;
    float* out; unsigned char* ws;
};
struct Chunk { int is_ctx, rows, b0, np; const float* x32; bf16_t* xb; };

DI Chunk make_chunk(const Params& P, int layer, int ci) {
    Chunk c; c.is_ctx = (ci == 0); c.rows = c.is_ctx ? NB * TC : 8 * TL; c.b0 = c.is_ctx ? 0 : 8 * (ci - 1); c.np = c.rows / 256;
    c.xb = c.is_ctx ? (bf16_t*)(P.ws + WS_XCTX) : (bf16_t*)(P.ws + WS_XL) + (size_t)c.b0 * TL * D;
    c.x32 = (layer == 0) ? (c.is_ctx ? P.ctx : P.x + (size_t)c.b0 * TL * D) : nullptr;
    return c;
}
DI const bf16_t* wlayer(const Params& P, int l) { return (const bf16_t*)(P.ws + WS_W) + (size_t)l * W_LAYER; }
DI const float* modlayer(const Params& P, int l) { return (const float*)(P.ws + WS_MOD) + (size_t)l * 33 * 6144; }

template <class SrcF> DI void tconv_tiles(LAS float* tile, bf16_t* dst, int K, int N, SrcF src, int rot) {
    const int tid = ltid(), ntk = K / 64, ntn = N / 64, nwg = lgdim();
    const int wg = (int)(((unsigned)lbid() + (unsigned)rot) % (unsigned)nwg);
    for (int t = wg; t < ntk * ntn; t += nwg) {
        const int kt = t % ntk, nt_ = t / ntk;
#pragma unroll
        for (int rr = 0; rr < 8; ++rr) { const int i = (tid >> 6) + 8 * rr, j = tid & 63; tile[i * 65 + j] = src(kt * 64 + i, nt_ * 64 + j); }
        __syncthreads();
#pragma unroll
        for (int rr = 0; rr < 8; ++rr) { const int jj = (tid >> 6) + 8 * rr, ii = tid & 63; dst[(size_t)(nt_ * 64 + jj) * K + kt * 64 + ii] = f2bf(tile[ii * 65 + jj]); }
        __syncthreads();
    }
}
DI void conv_direct(const float* src, bf16_t* dst, size_t n) {
    const size_t stride = (size_t)lgdim() * NTHR;
    const int tid_ = ltid();
    for (size_t i = (size_t)lbid() * NTHR + tid_; i < n / 4; i += stride) {
        const float4 v = ((const float4*)src)[i]; u32x2 w; w.x = pk2(v.x, v.y); w.y = pk2(v.z, v.w); ((u32x2*)dst)[i] = w; }
}
DI void conv_fp8(const float* src, unsigned* dst, size_t n, float scale) {
    const size_t stride = (size_t)lgdim() * NTHR;
    const int tid_ = ltid();
    for (size_t i = (size_t)lbid() * NTHR + tid_; i < n / 4; i += stride) {
        const float4 v = ((const float4*)src)[i]; int w = 0;
        w = __builtin_amdgcn_cvt_pk_fp8_f32(v.x * scale, v.y * scale, w, false); w = __builtin_amdgcn_cvt_pk_fp8_f32(v.z * scale, v.w * scale, w, true);
        dst[i] = (unsigned)w; }
}
DI void phase_convert(const Params& P, LAS unsigned char* lds) {
    LAS float* tile = (LAS float*)lds;
    for (int l = 0; l < NLAYER; ++l) {
        bf16_t* W = (bf16_t*)(P.ws + WS_W) + (size_t)l * W_LAYER;
        { const float* w = P.w_in + (size_t)l * 1024 * 7904;
          tconv_tiles(tile, W + WO_IN, 1024, ZLD, [=](int k, int n) -> float {
              int sc; float s = 1.0f;
              if (n < 4096) { sc = n; if (n >= 1024 && n < 1536) s = 0.08838834764831845f; }
              else if (n < 7168) sc = n - 4096 + 4832;
              else if (n < 7552) sc = n - 7168 + 4128;
              else if (n < 7808) sc = n - 7552 + 4512;
              else if (n < 7872) sc = n - 7808 + 4768;
              else if (n < 7888) sc = n - 7872 + 4096;
              else if (n < 7904) sc = n - 7888 + 4112;
              else return 0.0f;
              return w[(size_t)k * 7904 + sc] * s; }, 0); }
        { const float* w = P.mla_w_uq + (size_t)l * 384 * 1536; const float* g = P.mla_q_norm_g + l * 384;
          tconv_tiles(tile, W + WO_UQ, 384, 1536, [=](int k, int n) -> float { return g[k] * w[k * 1536 + n]; }, 81); }
        { const float* w = P.mla_w_ukv + (size_t)l * 256 * 2048; const float* g = P.mla_kv_norm_g + l * 256;
          tconv_tiles(tile, W + WO_KN, 256, 1024, [=](int k, int n) -> float { return g[k] * w[k * 2048 + (n >> 7) * 256 + (n & 127)]; }, 120);
          tconv_tiles(tile, W + WO_V, 256, 1024, [=](int k, int n) -> float { return g[k] * w[k * 2048 + (n >> 7) * 256 + 128 + (n & 127)]; }, 184); }
        for (int i = 1; i < 3; ++i) { const float* w = P.branch_w + ((size_t)l * 3 + i) * 1048576;
          tconv_tiles(tile, W + WO_BR + (size_t)i * 1048576, 1024, 1024, [=](int k, int n) -> float { return w[k * 1024 + n]; }, 0); }
        {
            const float* pw = P.pool_w + (size_t)l * 4 * 65536; const float* ps = P.pool_scale + l * 1024; const float* bw = P.branch_w + (size_t)l * 3 * 1048576; bf16_t* dst = W + WO_BR;
            LAS float* AS = (LAS float*)lds; LAS float* BS = AS + 64 * 257;
            const int tid = ltid();
            for (int t = lbid(); t < 256; t += lgdim()) {
                const int g = t >> 6, nb = (t >> 2) & 15, kb = t & 3;
                __syncthreads();
                for (int i = tid; i < 64 * 256; i += NTHR) { const int r = i >> 8, j = i & 255; AS[r * 257 + j] = pw[(size_t)g * 65536 + (kb * 64 + r) * 256 + j] * ps[g * 256 + j]; }
                for (int i = tid; i < 256 * 64; i += NTHR) { const int j = i >> 6, n = i & 63; BS[j * 65 + n] = bw[(size_t)(g * 256 + j) * 1024 + nb * 64 + n]; }
                __syncthreads();
                const int kq = tid & 63, n0 = (tid >> 6) * 8;
                float acc[8];
#pragma unroll
                for (int j = 0; j < 8; ++j) acc[j] = 0.f;
                for (int j = 0; j < 256; ++j) { const float a = AS[kq * 257 + j];
#pragma unroll
                    for (int q = 0; q < 8; ++q) acc[q] += a * BS[j * 65 + n0 + q]; }
#pragma unroll
                for (int q = 0; q < 8; ++q) dst[(size_t)(nb * 64 + n0 + q) * 1024 + g * 256 + kb * 64 + kq] = f2bf(acc[q]);
            }
            __syncthreads();
        }
        { const float* w = P.w_out + (size_t)l * 1048576;
          tconv_tiles(tile, W + WO_OUT, 1024, 1024, [=](int k, int n) -> float { return w[k * 1024 + n]; }, 0); }
        {
            const float* wq = P.peer_wq + (size_t)l * 1024 * 2048; const float* kk = P.peer_keys + (size_t)l * 2 * 8 * 128 * 128; bf16_t* dst = W + WO_Q;
            LAS float* KY = (LAS float*)lds; LAS float* WQS = KY + 128 * 129;
            const int tid = ltid();
            for (int t = lbid(); t < 256; t += lgdim()) {
                const int hs = t >> 4, k0 = (t & 15) * 64, h = hs >> 1, half = hs & 1;
                __syncthreads();
                for (int i = tid; i < 128 * 128; i += NTHR) { const int key = i >> 7, d = i & 127; KY[key * 129 + d] = kk[((size_t)(half * 8 + h) * 128 + key) * 128 + d]; }
                for (int i = tid; i < 64 * 128; i += NTHR) { const int r = i >> 7, d = i & 127; WQS[r * 129 + d] = wq[(size_t)(k0 + r) * 2048 + h * 256 + half * 128 + d]; }
                __syncthreads();
                const int kq = tid & 63, key0 = (tid >> 6) * 16;
                float acc[16];
#pragma unroll
                for (int j = 0; j < 16; ++j) acc[j] = 0.f;
                for (int d = 0; d < 128; ++d) { const float a = WQS[kq * 129 + d];
#pragma unroll
                    for (int j = 0; j < 16; ++j) acc[j] += a * KY[(key0 + j) * 129 + d]; }
#pragma unroll
                for (int j = 0; j < 16; ++j) dst[(size_t)(h * 256 + half * 128 + key0 + j) * 1024 + k0 + kq] = f2bf(acc[j]);
            }
            __syncthreads();
        }
        conv_fp8(P.peer_u + (size_t)l * NEXP * 1024, (unsigned*)(W + WO_PU), (size_t)NEXP * 1024, 32.0f);
        conv_fp8(P.peer_v + (size_t)l * NEXP * 1024, (unsigned*)(W + WO_PV), (size_t)NEXP * 1024, 1.0f);
    }
    if (lbid() == 0) {
        float2* rt = (float2*)(P.ws + WS_ROPE);
        for (int i = ltid(); i < 64 * 16; i += NTHR) { const float inv = exp2f(-(float)(i & 15) * 0.8304820237218406f); float sn, cs; sincosf((float)(i >> 4) * inv, &sn, &cs); rt[i] = make_float2(cs, sn); }
    }
}
DI void phase_mod(const Params& P, LAS unsigned char* lds) {
    LAS float* SC = (LAS float*)lds;
    LAS float* ACC = SC + 33 * 1024;
    const int tid = ltid(), wid = tid >> 6;
    if (lbid() >= 192) return;
    for (int i = tid; i < 33 * 1024; i += NTHR) { const int b = i >> 10, k = i & 1023; const float v = b < 32 ? P.c[b * 1024 + k] : P.c_ctx[k]; SC[i] = v / (1.0f + __expf(-v)); }
    float* MOD = (float*)(P.ws + WS_MOD);
    for (int grp = lbid(); grp < 192; grp += lgdim()) {
        const int l = grp / 96, n0 = (grp % 96) * 64;
        for (int i = tid; i < 33 * 64; i += NTHR) ACC[i] = 0.f;
        __syncthreads();
        const int j = tid & 63, ks = tid >> 6;
        float acc[33];
#pragma unroll
        for (int b = 0; b < 33; ++b) acc[b] = 0.f;
        const float* w = P.ada_w + (size_t)l * 1024 * 6144 + n0 + j;
        for (int k = ks * 128; k < ks * 128 + 128; ++k) { const float wv = w[(size_t)k * 6144];
#pragma unroll
            for (int b = 0; b < 33; ++b) acc[b] += SC[b * 1024 + k] * wv; }
        for (int ww = 0; ww < 8; ++ww) {
            if (wid == ww) {
#pragma unroll
                for (int b = 0; b < 33; ++b) ACC[b * 64 + j] += acc[b]; }
            __syncthreads(); }
        for (int i = tid; i < 33 * 64; i += NTHR) { const int b = i >> 6, jj = i & 63; MOD[(size_t)(l * 33 + b) * 6144 + n0 + jj] = ACC[i] + P.ada_b[l * 6144 + n0 + jj]; }
        __syncthreads();
    }
}

template <bool F32SRC> DI void phase_norm(const void* xsv, int rows, const float* gain, const float* mod, int is_ctx, int b0, int sh_idx, bf16_t* H) {
    const int tid_ = ltid(); const int lane = tid_ & 63, wid = tid_ >> 6;
    for (int r = lbid() * 8 + wid; r < rows; r += lgdim() * 8) {
        const int bi = is_ctx ? 32 : b0 + (r >> 11);
        const float* sh = mod + (size_t)bi * 6144 + sh_idx * 1024; const float* sc = sh + 1024;
        float4 v[4]; float ss = 0.f;
#pragma unroll
        for (int j = 0; j < 4; ++j) {
            if (F32SRC) v[j] = ((const float4*)((const float*)xsv + (size_t)r * 1024))[lane + 64 * j];
            else { const u32x2 w = ((const u32x2*)((const bf16_t*)xsv + (size_t)r * 1024))[lane + 64 * j]; v[j] = make_float4(lo2f(w.x), hi2f(w.x), lo2f(w.y), hi2f(w.y)); }
            ss += v[j].x * v[j].x + v[j].y * v[j].y + v[j].z * v[j].z + v[j].w * v[j].w; }
        ss = wave_sum(ss, lane);
        const float rstd = rsqrtf(ss * (1.0f / 1024.0f) + 1e-6f);
#pragma unroll
        for (int j = 0; j < 4; ++j) { const int c = (lane + 64 * j) * 4;
            const float4 g = *(const float4*)(gain + c), s1 = *(const float4*)(sc + c), s0 = *(const float4*)(sh + c);
            u32x2 w; w.x = pk2(v[j].x * rstd * g.x * (1.f + s1.x) + s0.x, v[j].y * rstd * g.y * (1.f + s1.y) + s0.y);
            w.y = pk2(v[j].z * rstd * g.z * (1.f + s1.z) + s0.z, v[j].w * rstd * g.w * (1.f + s1.w) + s0.w);
            *(u32x2*)(H + (size_t)r * 1024 + c) = w; }
    }
}

DI void phase_prep(const bf16_t* Z, int rows, int is_ctx, float* RS, bf16_t* KR, bf16_t* PD, bool do_pool, const float2* rt) {
    const int tid_ = ltid(); const int lane = tid_ & 63, wid = tid_ >> 6;
    const int seqlen = is_ctx ? TC : TL;
    for (int r = lbid() * 8 + wid; r < rows; r += lgdim() * 8) {
        const bf16_t* zr = Z + (size_t)r * ZLD;
        float sq = 0.f, sk = 0.f;
        { const unsigned* p = (const unsigned*)(zr + ZC_QDN + lane * 6);
#pragma unroll
          for (int i = 0; i < 3; ++i) { const unsigned w = p[i]; const float a = lo2f(w), b = hi2f(w); sq += a * a + b * b; } }
        { const u32x2 w = *(const u32x2*)(zr + ZC_KVDN + lane * 4); const float a = lo2f(w.x), b = hi2f(w.x), c = lo2f(w.y), d = hi2f(w.y); sk = a * a + b * b + c * c + d * d; }
        sq = wave_sum(sq, lane); sk = wave_sum(sk, lane);
        if (lane == 0) { RS[r] = rsqrtf(sq * (1.0f / 384.0f) + 1e-6f); RS[16384 + r] = rsqrtf(sk * (1.0f / 256.0f) + 1e-6f); }
        { const float x = bf2f(zr[ZC_KROPE + lane]); const float xp = shx(x, 16, lane); float o = x;
          if (!is_ctx) { const int t = r & (TL - 1); const int pos = (lane < 32) ? (t >> 6) : (t & 63); const int i = lane & 15;
              const float2 cs = rt[pos * 16 + i]; const float c = cs.x, s = cs.y;
              o = ((lane & 31) < 16) ? (x * c - xp * s) : (xp * s + x * c); }
          KR[(size_t)r * 64 + lane] = f2bf(o); }
        if (do_pool) {
            const int t = r % seqlen, seq0 = r - t;
#pragma unroll
            for (int j = 0; j < 4; ++j) {
                const int hw = 1 << j; const int lo = (t - hw) < 0 ? 0 : (t - hw); const int hi = (t + hw) > seqlen ? seqlen : (t + hw);
                const int c = j * 256 + lane * 4; float s0 = 0.f, s1 = 0.f, s2 = 0.f, s3 = 0.f;
#pragma unroll
                for (int k = 0; k < 2 * hw; ++k) {
                    const int tt = t - hw + k; const bool ok = tt >= 0 && tt < seqlen; const int tc = ok ? tt : t;
                    const u32x2 w = *(const u32x2*)(Z + (size_t)(seq0 + tc) * ZLD + ZC_P + c); const float m = ok ? 1.f : 0.f;
                    s0 += m * lo2f(w.x); s1 += m * hi2f(w.x); s2 += m * lo2f(w.y); s3 += m * hi2f(w.y); }
                const u32x2 me = *(const u32x2*)(zr + ZC_P + c); const float inv = 1.0f / (float)(hi - lo);
                u32x2 o; o.x = pk2(s0 * inv - lo2f(me.x), s1 * inv - hi2f(me.x)); o.y = pk2(s2 * inv - lo2f(me.y), s3 * inv - hi2f(me.y));
                *(u32x2*)(PD + (size_t)r * 1024 + c) = o; }
        }
    }
}

template <class Fill> struct GridSched { int nM, nN, G, c; Fill fill;
    DI bool next(int i, Unit& u) const { const long L = (long)i * G + c; if (L >= (long)nM * nN) return false; int pm, pn; pg8::tile_of((int)L, nM, nN, pm, pn); u.pm = pm; u.pn = pn; u.z = 0; fill(u); return true; } };
template <class Fill> DI GridSched<Fill> make_sched(int nM, int nN, Fill f) { GridSched<Fill> s{nM, nN, lgdim(), lbid(), f}; return s; }
template <class Fill> struct TripleSched { int nM, nN, G, c; Fill fill;
    DI bool next(int i, Unit& u) const { const long L = (long)(i / 3) * G + c; if (L >= (long)nM * nN) return false; int pm, pn; pg8::tile_of((int)L, nM, nN, pm, pn); u.pm = pm; u.pn = pn; u.z = i % 3; fill(u); return true; } };

DI bf16x8 pack8(const f32x16& x, int sp) { u32x4 p; p.x = pk2(x[8 * sp], x[8 * sp + 1]); p.y = pk2(x[8 * sp + 2], x[8 * sp + 3]); p.z = pk2(x[8 * sp + 4], x[8 * sp + 5]); p.w = pk2(x[8 * sp + 6], x[8 * sp + 7]);
    return __builtin_bit_cast(bf16x8, p); }
DI bf16x8 read_perm(const LAS unsigned char* p) {
    const s16x4 lo = *(const LAS s16x4*)p, hi = *(const LAS s16x4*)(p + 16);
    bf16x8 v; v[0] = lo[0]; v[1] = lo[1]; v[2] = lo[2]; v[3] = lo[3]; v[4] = hi[0]; v[5] = hi[1]; v[6] = hi[2]; v[7] = hi[3]; return v; }
DI void store8_bf16(bf16_t* p, const f32x4& a, const f32x4& b) { u32x4 w; w.x = pk2(a[0], a[1]); w.y = pk2(a[2], a[3]); w.z = pk2(b[0], b[1]); w.w = pk2(b[2], b[3]); *(u32x4*)p = w; }

DI void attn_item(LAS unsigned char* lds, const float2* rt, const bf16_t* Qp, int h, bool rope, int tq0,
                  const bf16_t* kn0, const bf16_t* kr0, const bf16_t* vt0, int ldv0, int nt0,
                  const bf16_t* kn1, const bf16_t* kr1, const bf16_t* vt1, int ldv1, int nt1, bf16_t* Op) {
    int tid = threadIdx.x; asm volatile("" : "+v"(tid));
    const int wid = tid >> 6, lane = tid & 63, ql = lane & 31, hh = lane >> 5;
    const bool grpB = __builtin_amdgcn_readfirstlane(wid) >= 4;
    constexpr int KPITCH = 400, VPITCH = 136, VOFF = 64 * KPITCH, BUFB = VOFF + 128 * VPITCH;
    constexpr float SL = 0.10411755f;
    bf16x8 qf[12];
    { const bf16_t* qrow = Qp + (size_t)(wid * 32 + ql) * 1536 + h * 192;
#pragma unroll
      for (int ks = 0; ks < 12; ++ks) qf[ks] = *(const bf16x8*)(qrow + ks * 16 + hh * 8); }
    if (rope) {
        const int t = tq0 + wid * 32 + ql; const int rp = t >> 6, cp = t & 63;
#pragma unroll
        for (int j = 0; j < 8; ++j) {
            float2 cs = rt[rp * 16 + 8 * hh + j]; float c = cs.x, s = cs.y;
            { const float x1 = bf2f((bf16_t)qf[8][j]), x2 = bf2f((bf16_t)qf[9][j]); qf[8][j] = (short)f2bf(x1 * c - x2 * s); qf[9][j] = (short)f2bf(x1 * s + x2 * c); }
            cs = rt[cp * 16 + 8 * hh + j]; c = cs.x; s = cs.y;
            { const float x1 = bf2f((bf16_t)qf[10][j]), x2 = bf2f((bf16_t)qf[11][j]); qf[10][j] = (short)f2bf(x1 * c - x2 * s); qf[11][j] = (short)f2bf(x1 * s + x2 * c); }
        }
    }
    f32x16 oacc[4];
#pragma unroll
    for (int db = 0; db < 4; ++db)
#pragma unroll
        for (int r = 0; r < 16; ++r) oacc[db][r] = 0.f;
    float m_run = -1e30f, l_run = 0.f;
    const int ntile = nt0 + nt1;
    u32x4 kst[3], vst[2];
    auto issueK = [&](int j) {
        const bool s1 = j >= nt0; const int key0 = (s1 ? j - nt0 : j) * 64;
        const bf16_t* kn = s1 ? kn1 : kn0; const bf16_t* kr = s1 ? kr1 : kr0;
#pragma unroll
        for (int i = 0; i < 2; ++i) { const int id = tid + 512 * i, key = id >> 4, c = id & 15;
            kst[i] = *(const u32x4*)(kn + (size_t)(key0 + key) * 1024 + h * 128 + c * 8); }
        { const int key = tid >> 3, c = tid & 7;
            kst[2] = *(const u32x4*)(kr + (size_t)(key0 + key) * 64 + c * 8); } };
    auto issueV = [&](int j) {
        const bool s1 = j >= nt0; const int key0 = (s1 ? j - nt0 : j) * 64;
        const bf16_t* vt = s1 ? vt1 : vt0; const int ldv = s1 ? ldv1 : ldv0;
#pragma unroll
        for (int i = 0; i < 2; ++i) { const int id = tid + 512 * i, d = id >> 3, c = id & 7;
            vst[i] = *(const u32x4*)(vt + (size_t)(h * 128 + d) * ldv + key0 + c * 8); } };
    auto commitK = [&](int buf) {
        LAS unsigned char* base = lds + buf * BUFB;
#pragma unroll
        for (int i = 0; i < 2; ++i) { const int id = tid + 512 * i, key = id >> 4, c = id & 15; *(LAS u32x4*)(base + key * KPITCH + c * 16) = kst[i]; }
        { const int key = tid >> 3, c = tid & 7; *(LAS u32x4*)(base + key * KPITCH + (16 + c) * 16) = kst[2]; } };
    auto commitV = [&](int buf) {
        LAS unsigned char* base = lds + buf * BUFB + VOFF;
#pragma unroll
        for (int i = 0; i < 2; ++i) { const int id = tid + 512 * i, d = id >> 3, c = id & 7; LAS u32x2* p = (LAS u32x2*)(base + d * VPITCH + c * 16);
            u32x2 a; a.x = vst[i].x; a.y = vst[i].y; u32x2 b; b.x = vst[i].z; b.y = vst[i].w; p[0] = a; p[1] = b; } };
    auto wgbar = [&]() { asm volatile("s_waitcnt lgkmcnt(0)" ::: "memory"); __builtin_amdgcn_s_barrier(); asm volatile("" ::: "memory"); };
    f32x16 s0, s1;
    auto scores = [&](int j) {
        const LAS unsigned char* Kb = lds + (j & 1) * BUFB;
#pragma unroll
        for (int r = 0; r < 16; ++r) { s0[r] = 0.f; s1[r] = 0.f; }
        const LAS unsigned char* kp0 = Kb + ql * KPITCH + hh * 16; const LAS unsigned char* kp1 = Kb + (32 + ql) * KPITCH + hh * 16;
        bf16x8 k0c = *(const LAS bf16x8*)kp0, k1c = *(const LAS bf16x8*)kp1;
#pragma unroll
        for (int ks = 0; ks < 12; ++ks) {
            bf16x8 k0n = k0c, k1n = k1c;
            if (ks < 11) { k0n = *(const LAS bf16x8*)(kp0 + (ks + 1) * 32); k1n = *(const LAS bf16x8*)(kp1 + (ks + 1) * 32); }
            __builtin_amdgcn_sched_barrier(0);
            s0 = __builtin_amdgcn_mfma_f32_32x32x16_bf16(k0c, qf[ks], s0, 0, 0, 0);
            s1 = __builtin_amdgcn_mfma_f32_32x32x16_bf16(k1c, qf[ks], s1, 0, 0, 0);
            __builtin_amdgcn_sched_barrier(0);
            k0c = k0n; k1c = k1n;
        }
        float mx = s0[0];
#pragma unroll
        for (int r = 0; r < 16; ++r) { mx = fmaxf(mx, s0[r]); mx = fmaxf(mx, s1[r]); }
        mx = fmaxf(mx, shx(mx, 32, lane));
        const bool grow = (mx - m_run) * SL > 8.0f;
        if (__builtin_amdgcn_ballot_w64(grow) != 0ull) {
            const float m_new = grow ? mx : m_run; const float alpha = exp2f((m_run - m_new) * SL); m_run = m_new;
            l_run *= alpha;
#pragma unroll
            for (int db = 0; db < 4; ++db)
#pragma unroll
                for (int r = 0; r < 16; ++r) oacc[db][r] *= alpha;
        }
    };
    auto pv = [&](int j) {
        { float ps = 0.f; const float mb = m_run * SL;
#pragma unroll
          for (int r = 0; r < 16; ++r) { s0[r] = exp2f(s0[r] * SL - mb); s1[r] = exp2f(s1[r] * SL - mb); ps += s0[r] + s1[r]; }
          l_run += ps; }
        const LAS unsigned char* vbase = lds + (j & 1) * BUFB + VOFF + ql * VPITCH + hh * 8;
        bf16x8 vc = read_perm(vbase);
#pragma unroll
        for (int it = 0; it < 16; ++it) {
            const int kb = it >> 3, sp = (it >> 2) & 1, db = it & 3;
            bf16x8 vn = vc;
            if (it < 15) { const int kb2 = (it + 1) >> 3, sp2 = ((it + 1) >> 2) & 1, db2 = (it + 1) & 3; vn = read_perm(vbase + db2 * 32 * VPITCH + (32 * kb2 + 16 * sp2) * 2); }
            const bf16x8 pf = pack8(kb == 0 ? s0 : s1, sp);
            __builtin_amdgcn_sched_barrier(0);
            if (db == 0) oacc[0] = __builtin_amdgcn_mfma_f32_32x32x16_bf16(vc, pf, oacc[0], 0, 0, 0);
            if (db == 1) oacc[1] = __builtin_amdgcn_mfma_f32_32x32x16_bf16(vc, pf, oacc[1], 0, 0, 0);
            if (db == 2) oacc[2] = __builtin_amdgcn_mfma_f32_32x32x16_bf16(vc, pf, oacc[2], 0, 0, 0);
            if (db == 3) oacc[3] = __builtin_amdgcn_mfma_f32_32x32x16_bf16(vc, pf, oacc[3], 0, 0, 0);
            __builtin_amdgcn_sched_barrier(0);
            vc = vn;
        }
    };
    issueK(0); issueV(0); commitK(0); commitV(0); wgbar();
    if (!grpB) {
        for (int m = 0; m < ntile; ++m) {
            if (m >= 1) commitV(m & 1);
            if (m + 1 < ntile) issueK(m + 1);
            scores(m);
            wgbar();
            if (m + 1 < ntile) { commitK((m + 1) & 1); issueV(m + 1); }
            pv(m);
            wgbar();
        }
        wgbar();
    } else {
        if (1 < ntile) issueK(1);
        wgbar();
        for (int m = 0; m < ntile; ++m) {
            if (m + 1 < ntile) { commitK((m + 1) & 1); issueV(m + 1); }
            scores(m);
            wgbar();
            if (m + 1 < ntile) commitV((m + 1) & 1);
            if (m + 2 < ntile) issueK(m + 2);
            pv(m);
            wgbar();
        }
    }
    const float linv = 1.0f / (l_run + shx(l_run, 32, lane));
    bf16_t* orow = Op + (size_t)(wid * 32 + ql) * 1024 + h * 128;
#pragma unroll
    for (int db = 0; db < 4; ++db)
#pragma unroll
        for (int g = 0; g < 4; ++g) { u32x2 w; w.x = pk2(oacc[db][4 * g] * linv, oacc[db][4 * g + 1] * linv); w.y = pk2(oacc[db][4 * g + 2] * linv, oacc[db][4 * g + 3] * linv);
            *(u32x2*)(orow + db * 32 + g * 8 + hh * 4) = w; }
    __syncthreads();
}

DI void gla_item(LAS unsigned char* lds, const bf16_t* Zseq, int len, int h, int dir, const float* gw, const float* gb,
                 const float* Sin, float* Sout, bf16_t* Oseq) {
    constexpr int QP = 272, KDP = 144, VP = 144;
    LAS unsigned char* QE = lds; LAS unsigned char* KE = lds + 17408; LAS unsigned char* KDT = lds + 34816; LAS unsigned char* VT = lds + 53248;
    LAS float* LR = (LAS float*)(lds + 90112); LAS float* SEG = (LAS float*)(lds + 94208); LAS float* DEC = (LAS float*)(lds + 96256);
    int tid = threadIdx.x; asm volatile("" : "+v"(tid));
    const int wid = tid >> 6, lane = tid & 63, ql = lane & 31, hh = lane >> 5, d = tid & 127, part = tid >> 7;
    float gwr[16];
#pragma unroll
    for (int j = 0; j < 16; ++j) gwr[j] = gw[j * 512 + h * 128 + d];
    const float gbr = gb[h * 128 + d];
    f32x16 S[4];
#pragma unroll
    for (int db = 0; db < 4; ++db)
#pragma unroll
        for (int r = 0; r < 16; ++r) S[db][r] = Sin ? Sin[(size_t)(32 * db + (r & 3) + 8 * (r >> 2) + 4 * hh) * 256 + 32 * wid + ql] : 0.f;
    const int lrcol = dir ? ZC_LRB : ZC_LRF;
    for (int n0 = 0; n0 < len; n0 += 64) {
#pragma unroll
        for (int i = 0; i < 2; ++i) { const int e = tid + 512 * i, row = e >> 4, j = e & 15; const int t = dir ? len - 1 - (n0 + row) : n0 + row;
            LR[e] = bf2f(Zseq[(size_t)t * ZLD + lrcol + j]); }
#pragma unroll
        for (int i = 0; i < 4; ++i) { const int cidx = tid + 512 * i, row = cidx & 63, c8 = cidx >> 6; const int t = dir ? len - 1 - (n0 + row) : n0 + row;
            const u32x4 v = *(const u32x4*)(Zseq + (size_t)t * ZLD + ZC_V + h * 256 + c8 * 8);
            LAS bf16_t* vp = (LAS bf16_t*)(VT + (c8 * 8) * VP + row * 2);
            const unsigned v0 = v.x, v1 = v.y, v2 = v.z, v3 = v.w;
            vp[0 * (VP / 2)] = (bf16_t)v0; vp[1 * (VP / 2)] = (bf16_t)(v0 >> 16); vp[2 * (VP / 2)] = (bf16_t)v1; vp[3 * (VP / 2)] = (bf16_t)(v1 >> 16);
            vp[4 * (VP / 2)] = (bf16_t)v2; vp[5 * (VP / 2)] = (bf16_t)(v2 >> 16); vp[6 * (VP / 2)] = (bf16_t)v3; vp[7 * (VP / 2)] = (bf16_t)(v3 >> 16); }
        bf16_t qraw[16], kraw[16];
#pragma unroll
        for (int ii = 0; ii < 16; ++ii) { const int row = part * 16 + ii; const int t = dir ? len - 1 - (n0 + row) : n0 + row;
            qraw[ii] = Zseq[(size_t)t * ZLD + ZC_Q + h * 128 + d]; kraw[ii] = Zseq[(size_t)t * ZLD + ZC_K + h * 128 + d]; }
        __syncthreads();
        float bl[16]; float run = 0.f;
#pragma unroll
        for (int ii = 0; ii < 16; ++ii) { float z = gbr;
#pragma unroll
            for (int j = 0; j < 16; ++j) z += LR[(part * 16 + ii) * 16 + j] * gwr[j];
            run += (fminf(z, 0.f) - __logf(1.0f + __expf(-fabsf(z)))) * 0.0625f; bl[ii] = run; }
        SEG[part * 128 + d] = run;
        __syncthreads();
        float off = 0.f, blast = 0.f;
#pragma unroll
        for (int pp = 0; pp < 4; ++pp) { const float sg = SEG[pp * 128 + d]; off += (pp < part) ? sg : 0.f; blast += sg; }
        if (part == 0) DEC[d] = __expf(blast);
        unsigned kdp[8];
#pragma unroll
        for (int ii = 0; ii < 16; ++ii) { const int row = part * 16 + ii; const float b = off + bl[ii];
            const float qv = bf2f(qraw[ii]), kv = bf2f(kraw[ii]);
            *(LAS bf16_t*)(QE + row * QP + d * 2) = f2bf(qv * __expf(b));
            *(LAS bf16_t*)(KE + row * QP + d * 2) = f2bf(kv * __expf(-b));
            const unsigned kd = f2bf(kv * __expf(blast - b));
            if (ii & 1) kdp[ii >> 1] |= kd << 16; else kdp[ii >> 1] = kd; }
        { u32x4 a; a.x = kdp[0]; a.y = kdp[1]; a.z = kdp[2]; a.w = kdp[3]; u32x4 b; b.x = kdp[4]; b.y = kdp[5]; b.z = kdp[6]; b.w = kdp[7];
          *(LAS u32x4*)(KDT + d * KDP + part * 32) = a; *(LAS u32x4*)(KDT + d * KDP + part * 32 + 16) = b; }
        __syncthreads();
        f32x16 att00, att01, att11, o0, o1;
#pragma unroll
        for (int r = 0; r < 16; ++r) { att00[r] = 0.f; att01[r] = 0.f; att11[r] = 0.f; o0[r] = 0.f; o1[r] = 0.f; }
#pragma unroll
        for (int ks = 0; ks < 8; ++ks) {
            const int co = (ks * 16 + hh * 8) * 2;
            const bf16x8 kf0 = *(const LAS bf16x8*)(KE + ql * QP + co), kf1 = *(const LAS bf16x8*)(KE + (32 + ql) * QP + co);
            const bf16x8 qf0 = *(const LAS bf16x8*)(QE + ql * QP + co), qf1 = *(const LAS bf16x8*)(QE + (32 + ql) * QP + co);
            att00 = __builtin_amdgcn_mfma_f32_32x32x16_bf16(kf0, qf0, att00, 0, 0, 0);
            att01 = __builtin_amdgcn_mfma_f32_32x32x16_bf16(kf0, qf1, att01, 0, 0, 0);
            att11 = __builtin_amdgcn_mfma_f32_32x32x16_bf16(kf1, qf1, att11, 0, 0, 0);
            if (ks & 1) __builtin_amdgcn_sched_barrier(0);
        }
#pragma unroll
        for (int r = 0; r < 16; ++r) { const int srow = (r & 3) + 8 * (r >> 2) + 4 * hh; if (srow > ql) { att00[r] = 0.f; att11[r] = 0.f; } }
        const LAS unsigned char* vrow = VT + (32 * wid + ql) * VP + hh * 8;
#pragma unroll
        for (int sp = 0; sp < 2; ++sp) {
            const bf16x8 va = read_perm(vrow + (16 * sp) * 2), vb = read_perm(vrow + (32 + 16 * sp) * 2);
            o0 = __builtin_amdgcn_mfma_f32_32x32x16_bf16(va, pack8(att00, sp), o0, 0, 0, 0);
            o1 = __builtin_amdgcn_mfma_f32_32x32x16_bf16(va, pack8(att01, sp), o1, 0, 0, 0);
            o1 = __builtin_amdgcn_mfma_f32_32x32x16_bf16(vb, pack8(att11, sp), o1, 0, 0, 0);
        }
#pragma unroll
        for (int db = 0; db < 4; ++db)
#pragma unroll
            for (int sp = 0; sp < 2; ++sp) {
                const bf16x8 sa = pack8(S[db], sp);
                const int co = (32 * db + 16 * sp + 4 * hh) * 2;
                const bf16x8 qb0 = read_perm(QE + ql * QP + co), qb1 = read_perm(QE + (32 + ql) * QP + co);
                o0 = __builtin_amdgcn_mfma_f32_32x32x16_bf16(sa, qb0, o0, 0, 0, 0);
                o1 = __builtin_amdgcn_mfma_f32_32x32x16_bf16(sa, qb1, o1, 0, 0, 0);
                if (sp) __builtin_amdgcn_sched_barrier(0);
            }
#pragma unroll
        for (int db = 0; db < 4; ++db) {
#pragma unroll
            for (int g4 = 0; g4 < 4; ++g4) { const f32x4 dc = *(const LAS f32x4*)(DEC + 32 * db + 8 * g4 + 4 * hh);
#pragma unroll
                for (int i = 0; i < 4; ++i) S[db][4 * g4 + i] *= dc[i]; }
#pragma unroll
            for (int ks = 0; ks < 4; ++ks) {
                const bf16x8 af = *(const LAS bf16x8*)(KDT + (32 * db + ql) * KDP + (16 * ks + 8 * hh) * 2);
                const bf16x8 bv = *(const LAS bf16x8*)(VT + (32 * wid + ql) * VP + (16 * ks + 8 * hh) * 2);
                S[db] = __builtin_amdgcn_mfma_f32_32x32x16_bf16(af, bv, S[db], 0, 0, 0);
            }
            __builtin_amdgcn_sched_barrier(0);
        }
#pragma unroll
        for (int tb = 0; tb < 2; ++tb) { const int row = 32 * tb + ql; const int t = dir ? len - 1 - (n0 + row) : n0 + row;
            bf16_t* op = Oseq + (size_t)t * 1024 + h * 256 + 32 * wid + 4 * hh;
#pragma unroll
            for (int g4 = 0; g4 < 4; ++g4) { u32x2 w2;
                if (tb == 0) { w2.x = pk2(o0[4 * g4], o0[4 * g4 + 1]); w2.y = pk2(o0[4 * g4 + 2], o0[4 * g4 + 3]); }
                else { w2.x = pk2(o1[4 * g4], o1[4 * g4 + 1]); w2.y = pk2(o1[4 * g4 + 2], o1[4 * g4 + 3]); }
                *(u32x2*)(op + 8 * g4) = w2; } }
        __syncthreads();
    }
    if (Sout) {
#pragma unroll
        for (int db = 0; db < 4; ++db)
#pragma unroll
            for (int r = 0; r < 16; ++r) Sout[(size_t)(32 * db + (r & 3) + 8 * (r >> 2) + 4 * hh) * 256 + 32 * wid + ql] = S[db][r]; }
}

DI void phase_glafin(const bf16_t* OF, const bf16_t* OB, const bf16_t* Z, const float* gg, int rows, bf16_t* GF) {
    const int tid_ = ltid(); const int lane = tid_ & 63, wid = tid_ >> 6;
    const float4 g4 = *(const float4*)(gg + lane * 4);
    for (int r = lbid() * 8 + wid; r < rows; r += lgdim() * 8) {
#pragma unroll
        for (int h = 0; h < 4; ++h) {
            const int c = h * 256 + lane * 4;
            const u32x2 a = *(const u32x2*)(OF + (size_t)r * 1024 + c), b = *(const u32x2*)(OB + (size_t)r * 1024 + c), rr = *(const u32x2*)(Z + (size_t)r * ZLD + ZC_R + c);
            const float s0 = lo2f(a.x) + lo2f(b.x), s1 = hi2f(a.x) + hi2f(b.x), s2 = lo2f(a.y) + lo2f(b.y), s3 = hi2f(a.y) + hi2f(b.y);
            const float ss = wave_sum(s0 * s0 + s1 * s1 + s2 * s2 + s3 * s3, lane);
            const float rstd = rsqrtf(ss * (1.0f / 256.0f) + 1e-6f);
            const float r0 = lo2f(rr.x), r1 = hi2f(rr.x), r2 = lo2f(rr.y), r3 = hi2f(rr.y);
            u32x2 o; o.x = pk2(s0 * rstd * g4.x * (r0 * sigmoidf_(r0)), s1 * rstd * g4.y * (r1 * sigmoidf_(r1)));
            o.y = pk2(s2 * rstd * g4.z * (r2 * sigmoidf_(r2)), s3 * rstd * g4.w * (r3 * sigmoidf_(r3)));
            *(u32x2*)(GF + (size_t)r * 1024 + c) = o;
        }
    }
}

DI unsigned fkey(float f) { const unsigned u = __float_as_uint(f); return u ^ ((unsigned)((int)u >> 31) | 0x80000000u); }
DI float unfkey(unsigned k) { return __uint_as_float((k & 0x80000000u) ? (k ^ 0x80000000u) : ~k); }
DI void key_insert(unsigned (&t)[16], unsigned k) {
#pragma unroll
    for (int j = 0; j < 16; ++j) { const unsigned hi = t[j] > k ? t[j] : k; const unsigned lo = t[j] > k ? k : t[j]; t[j] = hi; k = lo; }
}
DI void phase_select(const _Float16* SC, int rows, uint2* ROUTE, unsigned short* EID, LAS unsigned char* lds) {
    const int tid_ = ltid(); const int lane = tid_ & 63, wid = tid_ >> 6;
    LAS float* T = (LAS float*)lds + wid * (64 * 65);
    for (int pbase = (lbid() * 8 + wid) * 64; pbase < rows * 8; pbase += lgdim() * 8 * 64) {
        const int p = pbase + lane;
        unsigned k1[16], k2[16];
#pragma unroll
        for (int j = 0; j < 16; ++j) { k1[j] = 0u; k2[j] = 0u; }
#pragma unroll
        for (int pass = 0; pass < 4; ++pass) {
#pragma unroll
            for (int k = 0; k < 8; ++k) { const int pp = 8 * k + (lane >> 3), c8 = lane & 7;
                const h16x8 v = *(const h16x8*)(SC + (size_t)(pbase + pp) * 256 + pass * 32 + (c8 & 3) * 8 + (c8 >> 2) * 128);
                LAS float* tp = T + (8 * c8) * 65 + pp;
#pragma unroll
                for (int c = 0; c < 8; ++c) tp[c * 65] = (float)v[c]; }
            for (int f = 0; f < 32; ++f) { const float va = T[f * 65 + lane], vb = T[(32 + f) * 65 + lane]; const unsigned ix = (unsigned)(127 - (pass * 32 + f));
                key_insert(k1, (fkey(va) & ~127u) | ix); key_insert(k2, (fkey(vb) & ~127u) | ix); }
        }
        float t1[16], t2[16]; unsigned i1p[4] = {0u, 0u, 0u, 0u}, i2p[4] = {0u, 0u, 0u, 0u};
#pragma unroll
        for (int j = 0; j < 16; ++j) { t1[j] = unfkey(k1[j] & ~127u); t2[j] = unfkey(k2[j] & ~127u);
            i1p[j >> 2] |= (127u - (k1[j] & 127u)) << (8 * (j & 3)); i2p[j >> 2] |= (127u - (k2[j] & 127u)) << (8 * (j & 3)); }
        unsigned kc[16];
#pragma unroll
        for (int j = 0; j < 16; ++j) kc[j] = 0u;
#pragma unroll
        for (int a = 0; a < 16; ++a)
#pragma unroll
            for (int b = 0; b < 16; ++b)
                if ((a + 1) * (b + 1) <= 16) key_insert(kc, (fkey(t1[a] + t2[b]) & ~255u) | (unsigned)(a * 16 + b));
        float e[16]; unsigned ei[16]; float mx = -3.0e38f;
#pragma unroll
        for (int j = 0; j < 16; ++j) { const unsigned a = (kc[j] >> 4) & 15u, b = kc[j] & 15u;
            const unsigned wa = (a >> 2) == 0u ? i1p[0] : (a >> 2) == 1u ? i1p[1] : (a >> 2) == 2u ? i1p[2] : i1p[3];
            const unsigned wb = (b >> 2) == 0u ? i2p[0] : (b >> 2) == 1u ? i2p[1] : (b >> 2) == 2u ? i2p[2] : i2p[3];
            ei[j] = (((wa >> (8 * (a & 3u))) & 127u) << 7) | ((wb >> (8 * (b & 3u))) & 127u);
            e[j] = unfkey(kc[j] & ~255u); mx = fmaxf(mx, e[j]); }
        float sum = 0.f;
#pragma unroll
        for (int j = 0; j < 16; ++j) { e[j] = __expf(e[j] - mx); sum += e[j]; }
        const float inv = 1.0f / sum;
        uint2* dst = ROUTE + (size_t)p * 16; unsigned short* de = EID + (size_t)p * 16;
#pragma unroll
        for (int j = 0; j < 16; ++j) { dst[j] = make_uint2(ei[j], __float_as_uint(e[j] * inv)); de[j] = (unsigned short)ei[j]; }
    }
}

DI float dot2u(unsigned a, unsigned b, float acc) { return __builtin_amdgcn_fdot2_f32_bf16(__builtin_bit_cast(bf16x2_t, a), __builtin_bit_cast(bf16x2_t, b), acc, false); }
DI float dot8(const u32x4& a, const u32x4& b, float acc) {
    const unsigned a0 = a.x, a1 = a.y, a2 = a.z, a3 = a.w, b0 = b.x, b1 = b.y, b2 = b.z, b3 = b.w;
    acc = dot2u(a0, b0, acc); acc = dot2u(a1, b1, acc); acc = dot2u(a2, b2, acc); acc = dot2u(a3, b3, acc);
    return acc;
}
template <int CTRL> DI float dppf(float v) { return __builtin_bit_cast(float, __builtin_amdgcn_update_dpp(0, __builtin_bit_cast(int, v), CTRL, 0xF, 0xF, true)); }
typedef float f32x2_t __attribute__((ext_vector_type(2)));
DI void phase_peer_u(const bf16_t* H2, const unsigned short* EID, const unsigned char* PU, int rows, float* PART) {
    const int tid_ = ltid(); const int lane = tid_ & 63, wid = tid_ >> 6, g = lane >> 3, pc = lane & 7;
    const int x = lbid() & 7, gw = (lbid() >> 3) * 8 + wid, nw = (lgdim() >> 3) * 8;
    const unsigned lbase = (unsigned)(x * 128 + pc * 16);
    auto meta = [&](int r, unsigned (&e)[8], u32x4& h0, u32x4& h1) {
        const int rr = r < rows ? r : rows - 1;
        const u32x4* hp = (const u32x4*)(H2 + (unsigned)(rr * 1024 + x * 128 + pc * 16)); h0 = hp[0]; h1 = hp[1];
        const u32x4* ep = (const u32x4*)(EID + (unsigned)(rr * 128 + g * 16)); const u32x4 t0 = ep[0], t1 = ep[1];
        e[0] = t0.x; e[1] = t0.y; e[2] = t0.z; e[3] = t0.w; e[4] = t1.x; e[5] = t1.y; e[6] = t1.z; e[7] = t1.w; };
    auto finish = [&](int r, const u32x4 (&uv)[16], const u32x4& h0, const u32x4& h1) {
        float hf[16];
        { const unsigned a0 = h0.x, a1 = h0.y, a2 = h0.z, a3 = h0.w, b0 = h1.x, b1 = h1.y, b2 = h1.z, b3 = h1.w;
          hf[0] = lo2f(a0); hf[1] = hi2f(a0); hf[2] = lo2f(a1); hf[3] = hi2f(a1); hf[4] = lo2f(a2); hf[5] = hi2f(a2); hf[6] = lo2f(a3); hf[7] = hi2f(a3);
          hf[8] = lo2f(b0); hf[9] = hi2f(b0); hf[10] = lo2f(b1); hf[11] = hi2f(b1); hf[12] = lo2f(b2); hf[13] = hi2f(b2); hf[14] = lo2f(b3); hf[15] = hi2f(b3); }
        float v0 = 0.f, v1 = 0.f;
#pragma unroll
        for (int j = 0; j < 16; ++j) {
            const unsigned w0 = uv[j].x, w1 = uv[j].y, w2 = uv[j].z, w3 = uv[j].w;
            float a = 0.f;
            { const f32x2_t l = __builtin_amdgcn_cvt_pk_f32_fp8((int)w0, false), hh2 = __builtin_amdgcn_cvt_pk_f32_fp8((int)w0, true); a += l[0] * hf[0] + l[1] * hf[1] + hh2[0] * hf[2] + hh2[1] * hf[3]; }
            { const f32x2_t l = __builtin_amdgcn_cvt_pk_f32_fp8((int)w1, false), hh2 = __builtin_amdgcn_cvt_pk_f32_fp8((int)w1, true); a += l[0] * hf[4] + l[1] * hf[5] + hh2[0] * hf[6] + hh2[1] * hf[7]; }
            { const f32x2_t l = __builtin_amdgcn_cvt_pk_f32_fp8((int)w2, false), hh2 = __builtin_amdgcn_cvt_pk_f32_fp8((int)w2, true); a += l[0] * hf[8] + l[1] * hf[9] + hh2[0] * hf[10] + hh2[1] * hf[11]; }
            { const f32x2_t l = __builtin_amdgcn_cvt_pk_f32_fp8((int)w3, false), hh2 = __builtin_amdgcn_cvt_pk_f32_fp8((int)w3, true); a += l[0] * hf[12] + l[1] * hf[13] + hh2[0] * hf[14] + hh2[1] * hf[15]; }
            a += dppf<0xB1>(a); a += dppf<0x4E>(a); a += dppf<0x141>(a);
            v0 = (j < 8 && pc == (j & 7)) ? a : v0; v1 = (j >= 8 && pc == (j & 7)) ? a : v1;
        }
        if (r < rows) { float* pp = PART + (unsigned)((r * 8 + x) * 128 + g * 16 + pc); pp[0] = v0 * 0.03125f; pp[8] = v1 * 0.03125f; } };
    unsigned eA[8], eB[8]; u32x4 hA0, hA1, hB0, hB1;
    meta(gw, eA, hA0, hA1); meta(gw + nw, eB, hB0, hB1);
    for (int r = gw; r < rows; r += 2 * nw) {
        u32x4 uA[16], uB[16];
#pragma unroll
        for (int j = 0; j < 16; ++j) uA[j] = *(const u32x4*)(PU + ((((j & 1) ? (eA[j >> 1] >> 16) : (eA[j >> 1] & 0xffffu)) << 10) + lbase));
#pragma unroll
        for (int j = 0; j < 16; ++j) uB[j] = *(const u32x4*)(PU + ((((j & 1) ? (eB[j >> 1] >> 16) : (eB[j >> 1] & 0xffffu)) << 10) + lbase));
        const u32x4 cA0 = hA0, cA1 = hA1, cB0 = hB0, cB1 = hB1;
        meta(r + 2 * nw, eA, hA0, hA1); meta(r + 3 * nw, eB, hB0, hB1);
        finish(r, uA, cA0, cA1); finish(r + nw, uB, cB0, cB1);
    }
}
DI void phase_peer_w(const float* PART, const uint2* ROUTE, int rows, bf16_t* WG) {
    const int tid_ = ltid(); const int lane = tid_ & 63, wid = tid_ >> 6;
    for (int r = lbid() * 8 + wid; r < rows; r += lgdim() * 8) {
        float a0 = 0.f, a1 = 0.f;
#pragma unroll
        for (int x = 0; x < 8; ++x) { const float* pp = PART + ((size_t)r * 8 + x) * 128; a0 += pp[lane]; a1 += pp[64 + lane]; }
        const float g0 = __uint_as_float(ROUTE[(size_t)r * 128 + lane].y), g1 = __uint_as_float(ROUTE[(size_t)r * 128 + 64 + lane].y);
        WG[(size_t)r * 128 + lane] = f2bf(g0 * 0.5f * a0 * (1.0f + erff(a0 * 0.70710678118654752f)));
        WG[(size_t)r * 128 + 64 + lane] = f2bf(g1 * 0.5f * a1 * (1.0f + erff(a1 * 0.70710678118654752f)));
    }
}
DI void phase_peer_v(const bf16_t* WG, const unsigned short* EID, const unsigned char* PV, const float* mod, int is_ctx, int b0, int rows, bf16_t* X, bool dry) {
    const int tid_ = ltid(); const int lane = tid_ & 63, wid = tid_ >> 6, g = lane >> 3, pc = lane & 7;
    const int x = lbid() & 7, gw = (lbid() >> 3) * 8 + wid, nw = (lgdim() >> 3) * 8;
    const unsigned lbase = (unsigned)(x * 128 + pc * 16);
    const int mydim = x * 128 + pc * 16 + 8 * ((lane >> 5) & 1) + 4 * ((lane >> 4) & 1) + 2 * ((lane >> 3) & 1);
    auto meta = [&](int r, unsigned (&e)[8]) {
        const int rr = r < rows ? r : rows - 1;
        const u32x4* ep = (const u32x4*)(EID + (unsigned)(rr * 128 + g * 16)); const u32x4 t0 = ep[0], t1 = ep[1];
        e[0] = t0.x; e[1] = t0.y; e[2] = t0.z; e[3] = t0.w; e[4] = t1.x; e[5] = t1.y; e[6] = t1.z; e[7] = t1.w; };
    auto wload = [&](int r, unsigned (&w)[8]) {
        const int rr = r < rows ? r : rows - 1;
        const u32x4* wp = (const u32x4*)(WG + (unsigned)(rr * 128 + g * 16)); const u32x4 t0 = wp[0], t1 = wp[1];
        w[0] = t0.x; w[1] = t0.y; w[2] = t0.z; w[3] = t0.w; w[4] = t1.x; w[5] = t1.y; w[6] = t1.z; w[7] = t1.w; };
    auto finish = [&](int r, const u32x4 (&vv)[16], const unsigned (&w)[8]) {
        float o[16];
#pragma unroll
        for (int i = 0; i < 16; ++i) o[i] = 0.f;
#pragma unroll
        for (int j = 0; j < 16; ++j) { const unsigned w0 = vv[j].x, w1 = vv[j].y, w2 = vv[j].z, w3 = vv[j].w; const float wj = (j & 1) ? hi2f(w[j >> 1]) : lo2f(w[j >> 1]);
            { const f32x2_t l = __builtin_amdgcn_cvt_pk_f32_fp8((int)w0, false), h2 = __builtin_amdgcn_cvt_pk_f32_fp8((int)w0, true); o[0] += wj * l[0]; o[1] += wj * l[1]; o[2] += wj * h2[0]; o[3] += wj * h2[1]; }
            { const f32x2_t l = __builtin_amdgcn_cvt_pk_f32_fp8((int)w1, false), h2 = __builtin_amdgcn_cvt_pk_f32_fp8((int)w1, true); o[4] += wj * l[0]; o[5] += wj * l[1]; o[6] += wj * h2[0]; o[7] += wj * h2[1]; }
            { const f32x2_t l = __builtin_amdgcn_cvt_pk_f32_fp8((int)w2, false), h2 = __builtin_amdgcn_cvt_pk_f32_fp8((int)w2, true); o[8] += wj * l[0]; o[9] += wj * l[1]; o[10] += wj * h2[0]; o[11] += wj * h2[1]; }
            { const f32x2_t l = __builtin_amdgcn_cvt_pk_f32_fp8((int)w3, false), h2 = __builtin_amdgcn_cvt_pk_f32_fp8((int)w3, true); o[12] += wj * l[0]; o[13] += wj * l[1]; o[14] += wj * h2[0]; o[15] += wj * h2[1]; } }
        float k8[8], k4[4], k2[2];
#pragma unroll
        for (int i = 0; i < 8; ++i) { const bool up = (lane & 32) != 0; const float send = up ? o[i] : o[i + 8]; k8[i] = (up ? o[i + 8] : o[i]) + shx(send, 32, lane); }
#pragma unroll
        for (int i = 0; i < 4; ++i) { const bool up = (lane & 16) != 0; const float send = up ? k8[i] : k8[i + 4]; k4[i] = (up ? k8[i + 4] : k8[i]) + shx(send, 16, lane); }
#pragma unroll
        for (int i = 0; i < 2; ++i) { const bool up = (lane & 8) != 0; const float send = up ? k4[i] : k4[i + 2]; k2[i] = (up ? k4[i + 2] : k4[i]) + dppf<0x128>(send); }
        if (dry && k2[0] != 12345.678f) return;
        if (r < rows) {
            const int bi = is_ctx ? 32 : b0 + (r >> 11);
            const float2 m = *(const float2*)(mod + (unsigned)(bi * 6144 + 5 * 1024 + mydim));
            unsigned* xr = (unsigned*)(X + (unsigned)(r * 1024 + mydim)); const unsigned xw = *xr; *xr = pk2(lo2f(xw) + m.x * k2[0], hi2f(xw) + m.y * k2[1]);
        } };
    unsigned eA[8];
    meta(gw, eA);
    for (int r = gw; r < rows; r += nw) {
        u32x4 vA[16]; unsigned wA[8];
#pragma unroll
        for (int j = 0; j < 16; ++j) vA[j] = *(const u32x4*)(PV + ((((j & 1) ? (eA[j >> 1] >> 16) : (eA[j >> 1] & 0xffffu)) << 10) + lbase));
        wload(r, wA);
        meta(r + nw, eA);
        finish(r, vA, wA);
    }
}

DI void phase_final(const bf16_t* xb, float* out, const float* gain, int rows) {
    const int tid_ = ltid(); const int lane = tid_ & 63, wid = tid_ >> 6;
    for (int r = lbid() * 8 + wid; r < rows; r += lgdim() * 8) {
        float4 v[4]; float ss = 0.f;
#pragma unroll
        for (int j = 0; j < 4; ++j) { const u32x2 w = ((const u32x2*)(xb + (size_t)r * 1024))[lane + 64 * j]; v[j] = make_float4(lo2f(w.x), hi2f(w.x), lo2f(w.y), hi2f(w.y));
            ss += v[j].x * v[j].x + v[j].y * v[j].y + v[j].z * v[j].z + v[j].w * v[j].w; }
        ss = wave_sum(ss, lane);
        const float rstd = rsqrtf(ss * (1.0f / 1024.0f) + 1e-6f);
        float4* orow = (float4*)(out + (size_t)r * 1024);
#pragma unroll
        for (int j = 0; j < 4; ++j) { const float4 g = *(const float4*)(gain + (lane + 64 * j) * 4);
            float4 o; o.x = v[j].x * rstd * g.x; o.y = v[j].y * rstd * g.y; o.z = v[j].z * rstd * g.z; o.w = v[j].w * rstd * g.w; orow[lane + 64 * j] = o; }
    }
}

enum { PH_NORM1 = 0, PH_INPROJ, PH_PREP, PH_UPPROJ, PH_MIX, PH_INPROJ2, PH_GLAFIN, PH_BRANCH, PH_WOUT, PH_NORM2, PH_WQ, PH_SELECT, PH_PEERU, PH_PEERW, PH_PEERV, PH_COUNT };

struct RunArgs { int mode;
                 int layer, chunk, phase; };

struct Bufs { bf16_t *H, *Z, *QB, *KN, *VT, *KR, *OF, *OB, *MLA, *PD, *PO, *GF, *MMB, *PQ; float *RS, *MMF, *CST, *PART; _Float16* SC; bf16_t* WG; unsigned short* EID; uint2* ROUTE; const bf16_t* W; const float* mod; unsigned* ctl; };
DI Bufs make_bufs(const Params& P, int is_ctx, int layer) {
    __attribute__((address_space(1))) unsigned char* gws = (__attribute__((address_space(1))) unsigned char*)P.ws; asm volatile("" : "+s"(gws));
    unsigned char* ws = (unsigned char*)gws; asm volatile("" : "+s"(layer));
    Bufs B;
    B.H = (bf16_t*)(ws + WS_H); B.Z = (bf16_t*)(ws + WS_Z); B.QB = (bf16_t*)(ws + WS_QB);
    B.KN = (bf16_t*)(ws + (is_ctx ? WS_CKN : WS_KN)); B.VT = (bf16_t*)(ws + (is_ctx ? WS_CVT : WS_VT)); B.KR = (bf16_t*)(ws + (is_ctx ? WS_CKR : WS_KR));
    B.RS = (float*)(ws + WS_RS); B.OF = (bf16_t*)(ws + WS_OF); B.OB = (bf16_t*)(ws + WS_OB); B.MLA = (bf16_t*)(ws + WS_MLA);
    B.PD = (bf16_t*)(ws + WS_PD); B.PO = (bf16_t*)(ws + WS_PO); B.GF = B.PO; B.MMF = (float*)(ws + WS_OF); B.MMB = (bf16_t*)(ws + WS_VT);
    B.PQ = B.QB; B.SC = (_Float16*)(ws + WS_Z); B.ROUTE = (uint2*)(ws + WS_ROUTE); B.PART = (float*)(ws + WS_Z + 128 * MiB); B.WG = (bf16_t*)(ws + WS_Z + 192 * MiB); B.EID = (unsigned short*)(ws + WS_Z + 200 * MiB); B.CST = (float*)(ws + WS_CST);
    B.W = (const bf16_t*)(ws + WS_W) + (size_t)layer * W_LAYER; B.mod = (const float*)(ws + WS_MOD) + (size_t)layer * 33 * 6144; B.ctl = (unsigned*)(ws + WS_CTL);
    return B;
}

DI Params kparams() {
    Params P;
#if defined(__HIP_DEVICE_COMPILE__)
    typedef const void* cvp; typedef const __attribute__((address_space(1))) void* gvp;
    const __attribute__((address_space(4))) gvp* q = (const __attribute__((address_space(4))) gvp*)__builtin_amdgcn_kernarg_segment_ptr();
    asm volatile("" : "+s"(q));
#pragma unroll
    for (int i = 0; i < (int)(sizeof(Params) / sizeof(void*)); ++i) ((cvp*)&P)[i] = (cvp)q[i];
#endif
    return P;
}

__global__ void __launch_bounds__(NTHR, 2) fwd_kernel(Params Pk, RunArgs R) {
    extern __shared__ __attribute__((aligned(16))) unsigned char smem[];
    LAS unsigned char* lds = (LAS unsigned char*)smem;
    LAS unsigned* ctlw = (LAS unsigned*)(lds + LDS_BYTES - 64);
    unsigned* ctl = (unsigned*)(Pk.ws + WS_CTL);
    if (threadIdx.x == 0) { ctlw[0] = 0u; ctlw[1] = 0u; ctlw[2] = 0u; ctlw[3] = 0u; }
    __syncthreads();
    XcdBarrier bar; bar.bar = ctl; bar.x = 0; bar.st = (volatile LAS unsigned*)ctlw;
    const bool single = (R.mode == 0);
    if (single) bar = xcd_barrier_post(ctl, (volatile LAS unsigned*)ctlw);
#define GRID_SYNC() do { if (single) xcd_barrier(bar); } while (0)

    if (R.mode == 0 || R.mode == 1) for (int rep_ = 0; rep_ < ((REP_PHASE) == 100 ? 2 : 1); ++rep_) { const Params P = kparams(); phase_convert(P, lds); phase_mod(P, lds); __syncthreads(); }
    GRID_SYNC();

    if (R.mode == 0 || R.mode == 2) {
    const int l_lo = single ? 0 : R.layer, l_hi = single ? NLAYER : R.layer + 1;
    const int c_lo = single ? 0 : R.chunk, c_hi = single ? 5 : R.chunk + 1;
    for (int layer = l_lo; layer < l_hi; ++layer)
    for (int ci = c_lo; ci < c_hi; ++ci) {
        const bool is_ctx = (ci == 0);
        const bool ctx_kv_only = is_ctx && layer == NLAYER - 1;
#define RUN(ph) (single || lnd(R.phase) == (ph))
#define REP(ph) for (int rep_ = 0; rep_ < (((REP_PHASE) == (ph) || (REP_PHASE) == 999) ? 2 : 1); ++rep_)
#define PHASE_LOCALS const Params P = kparams(); const Chunk ck = make_chunk(P, layer, ci); const Bufs B = make_bufs(P, ck.is_ctx, layer); const int rows = ck.rows, np = ck.np; (void)rows; (void)np;

        if ((REP_PHASE) == 200) { for (int xb = 0; xb < 10; ++xb) GRID_SYNC(); }
        if (RUN(PH_NORM1)) REP(PH_NORM1) { PHASE_LOCALS if (layer == 0) phase_norm<true>(ck.x32, rows, P.norm1_g + layer * 1024, B.mod, ck.is_ctx, ck.b0, 0, B.H); else phase_norm<false>(ck.xb, rows, P.norm1_g + layer * 1024, B.mod, ck.is_ctx, ck.b0, 0, B.H); }
        GRID_SYNC();
        if (RUN(PH_INPROJ)) REP(PH_INPROJ) { PHASE_LOCALS
            const bf16_t* H = B.H; const bf16_t* W = B.W; bf16_t* Z = B.Z;
            auto S = make_sched(np, 15, [=](Unit& u) { u.pn = (u.pn < 12) ? u.pn : u.pn + 16;
                u.A = (const char*)(H + (size_t)u.pm * 256 * 1024); u.B = (const char*)(W + WO_IN + (size_t)u.pn * 256 * 1024); });
            pg8::gemm_phase(lds, 1024, 1024, 1024, S, [=](const f32x4 (&acc)[2][2][4][2], const Unit& u, int wr, int wc, int fr, int fq) {
                const bool is_gate = false;
                pg8::epi8(acc, wr, wc, fr, fq, [&](int row, int col, const f32x4& a, const f32x4& b) {
                    f32x4 a2 = a, b2 = b;
                    if (is_gate) {
#pragma unroll
                        for (int j = 0; j < 4; ++j) { a2[j] = sigmoidf_(a[j]); b2[j] = sigmoidf_(b[j]); } }
                    store8_bf16(Z + (size_t)(u.pm * 256 + row) * ZLD + u.pn * 256 + col, a2, b2); }); });
        }
        GRID_SYNC();
        if (RUN(PH_PREP)) REP(PH_PREP) { PHASE_LOCALS phase_prep(B.Z, rows, ck.is_ctx, B.RS, B.KR, B.PD, !ctx_kv_only, (const float2*)(P.ws + WS_ROPE)); }
        GRID_SYNC();
        if (RUN(PH_UPPROJ)) REP(PH_UPPROJ) {
            if (!ctx_kv_only) { PHASE_LOCALS
                const bf16_t* Z = B.Z; const bf16_t* W = B.W; bf16_t* QB = B.QB; const float* RS = B.RS;
                auto S = make_sched(np, 6, [=](Unit& u) { u.A = (const char*)(Z + (size_t)u.pm * 256 * ZLD + ZC_QDN); u.B = (const char*)(W + WO_UQ + (size_t)u.pn * 256 * 384); });
                pg8::gemm_phase(lds, ZLD, 384, 384, S, [=](const f32x4 (&acc)[2][2][4][2], const Unit& u, int wr, int wc, int fr, int fq) {
                    pg8::epi8(acc, wr, wc, fr, fq, [&](int row, int col, const f32x4& a, const f32x4& b) { const int gr = u.pm * 256 + row; const float s = RS[gr];
                        store8_bf16(QB + (size_t)gr * 1536 + u.pn * 256 + col, a * s, b * s); }); });
            }
            { PHASE_LOCALS
                const bf16_t* Z = B.Z; const bf16_t* W = B.W; bf16_t* KN = B.KN; const float* RS = B.RS;
                auto S = make_sched(np, 4, [=](Unit& u) { u.A = (const char*)(Z + (size_t)u.pm * 256 * ZLD + ZC_KVDN); u.B = (const char*)(W + WO_KN + (size_t)u.pn * 256 * 256); });
                pg8::gemm_phase(lds, ZLD, 256, 256, S, [=](const f32x4 (&acc)[2][2][4][2], const Unit& u, int wr, int wc, int fr, int fq) {
                    pg8::epi8(acc, wr, wc, fr, fq, [&](int row, int col, const f32x4& a, const f32x4& b) { const int gr = u.pm * 256 + row; const float s = RS[16384 + gr];
                        store8_bf16(KN + (size_t)gr * 1024 + u.pn * 256 + col, a * s, b * s); }); });
            }
            { PHASE_LOCALS
                const bf16_t* Z = B.Z; const bf16_t* W = B.W; bf16_t* VT = B.VT; const float* RS = B.RS;
                auto S = make_sched(4, np, [=](Unit& u) { u.A = (const char*)(W + WO_V + (size_t)u.pm * 256 * 256); u.B = (const char*)(Z + (size_t)u.pn * 256 * ZLD + ZC_KVDN); });
                pg8::gemm_phase(lds, 256, ZLD, 256, S, [=](const f32x4 (&acc)[2][2][4][2], const Unit& u, int wr, int wc, int fr, int fq) {
                    pg8::epi8(acc, wr, wc, fr, fq, [&](int row, int col, const f32x4& a, const f32x4& b) { const int tk = u.pn * 256 + col;
                        const f32x4 r0 = *(const f32x4*)(RS + 16384 + tk), r1 = *(const f32x4*)(RS + 16384 + tk + 4);
                        store8_bf16(VT + (size_t)(u.pm * 256 + row) * rows + tk, a * r0, b * r1); }); });
            }
        }
        GRID_SYNC();
        if (RUN(PH_MIX)) for (int rep_ = 0; rep_ < (((REP_PHASE) == PH_MIX || (REP_PHASE) == 201 || (REP_PHASE) == 202 || (REP_PHASE) == 999) ? 2 : 1); ++rep_) { PHASE_LOCALS
            const int nbat = ck.is_ctx ? NB : 8;
            const int nG = (rep_ != 0 && (REP_PHASE) == 202) ? 0 : nbat * 8;
            const int nA = (rep_ != 0 && (REP_PHASE) == 201) ? 0 : (ck.is_ctx ? (layer == 0 ? NB * 8 : 0) : 8 * 8 * 8);
            unsigned* ctr = B.ctl + CTL_WORKQ + 64 * (layer * 5 + ci) + 64 * 16 * rep_;
            const int seqlen = ck.is_ctx ? TC : TL;
            for (;;) {
                if (ltid() == 0) ctlw[4] = xb_add(ctr, 1u);
                __syncthreads();
                const int item = (int)ctlw[4];
                __syncthreads();
                if (item >= nG + nA) break;
                if (item < nG) {
                    const int dir = item & 1, h = (item >> 1) & 3, bl = item >> 3;
                    const int b = ck.b0 + bl;
                    float* st = B.CST + (size_t)((b * 4 + h) * 2 + dir) * 128 * 256;
                    gla_item(lds, B.Z + (size_t)bl * seqlen * ZLD, seqlen, h, dir, P.gla_gate_w + ((size_t)layer * 2 + dir) * 16 * 512, P.gla_gate_b + ((size_t)layer * 2 + dir) * 512,
                             ck.is_ctx ? nullptr : st, ck.is_ctx ? st : nullptr, (dir ? B.OB : B.OF) + (size_t)bl * seqlen * 1024);
                } else {
                    const int a = item - nG;
                    int h, nt0, nt1, ldv0, tq0; bool rope; const bf16_t *Qp, *kn0, *kr0, *vt0, *kn1, *kr1, *vt1; bf16_t* Op;
                    if (ck.is_ctx) {
                        h = a & 7; const int bl = a >> 3; rope = false; tq0 = 0;
                        Qp = B.QB + (size_t)bl * TC * 1536; kn0 = B.KN + (size_t)bl * TC * 1024; kr0 = B.KR + (size_t)bl * TC * 64; vt0 = B.VT + (size_t)bl * TC; ldv0 = rows; nt0 = TC / 64;
                        kn1 = kn0; kr1 = kr0; vt1 = vt0; nt1 = 0; Op = B.MLA + (size_t)bl * TC * 1024;
                    } else {
                        const int qb = a & 7; h = (a >> 3) & 7; const int bl = a >> 6; const int b = ck.b0 + bl; rope = true; tq0 = qb * 256;
                        const bf16_t* CKN = (const bf16_t*)(P.ws + WS_CKN); const bf16_t* CKR = (const bf16_t*)(P.ws + WS_CKR); const bf16_t* CVT = (const bf16_t*)(P.ws + WS_CVT);
                        Qp = B.QB + (size_t)(bl * TL + qb * 256) * 1536; kn0 = CKN + (size_t)b * TC * 1024; kr0 = CKR + (size_t)b * TC * 64; vt0 = CVT + (size_t)b * TC; ldv0 = NB * TC; nt0 = TC / 64;
                        kn1 = B.KN + (size_t)bl * TL * 1024; kr1 = B.KR + (size_t)bl * TL * 64; vt1 = B.VT + (size_t)bl * TL; nt1 = TL / 64; Op = B.MLA + (size_t)(bl * TL + qb * 256) * 1024;
                    }
                    attn_item(lds, (const float2*)(P.ws + WS_ROPE), Qp, h, rope, tq0, kn0, kr0, vt0, ldv0, nt0, kn1, kr1, vt1, rows, nt1, Op);
                }
            }
        }
        GRID_SYNC();
        if (!ctx_kv_only) {
        if (RUN(PH_INPROJ2)) REP(PH_INPROJ2) { PHASE_LOCALS
            const bf16_t* H = B.H; const bf16_t* W = B.W; bf16_t* Z = B.Z;
            auto S = make_sched(np, 16, [=](Unit& u) { u.pn += 12; u.A = (const char*)(H + (size_t)u.pm * 256 * 1024); u.B = (const char*)(W + WO_IN + (size_t)u.pn * 256 * 1024); });
            pg8::gemm_phase(lds, 1024, 1024, 1024, S, [=](const f32x4 (&acc)[2][2][4][2], const Unit& u, int wr, int wc, int fr, int fq) {
                const bool is_gate = (u.pn >= ZC_GZ / 256);
                pg8::epi8(acc, wr, wc, fr, fq, [&](int row, int col, const f32x4& a, const f32x4& b) {
                    f32x4 a2 = a, b2 = b;
                    if (is_gate) {
#pragma unroll
                        for (int j = 0; j < 4; ++j) { a2[j] = sigmoidf_(a[j]); b2[j] = sigmoidf_(b[j]); } }
                    store8_bf16(Z + (size_t)(u.pm * 256 + row) * ZLD + u.pn * 256 + col, a2, b2); }); });
        }
        GRID_SYNC();
        if (RUN(PH_GLAFIN)) REP(PH_GLAFIN) { PHASE_LOCALS phase_glafin(B.OF, B.OB, B.Z, P.gla_norm_g + layer * 256, rows, B.GF); }
        GRID_SYNC();
        if (RUN(PH_BRANCH)) REP(PH_BRANCH) { PHASE_LOCALS
            const bf16_t* PO = B.PD; const bf16_t* GF = B.GF; const bf16_t* MLA = B.MLA; const bf16_t* W = B.W; const bf16_t* Z = B.Z; bf16_t* MMS = (bf16_t*)B.MMF; bf16_t* MMB = B.MMB;
            auto fill = [=](Unit& u) { const bf16_t* a = (u.z == 0) ? PO : (u.z == 1) ? GF : MLA;   u.A = (const char*)(a + (size_t)u.pm * 256 * 1024);
                                       u.B = (const char*)(W + WO_BR + (size_t)u.z * 1048576 + (size_t)u.pn * 256 * 1024); };
            TripleSched<decltype(fill)> S{np, 4, lgdim(), lbid(), fill};
            pg8::gemm_phase(lds, 1024, 1024, 1024, S, [=](const f32x4 (&acc)[2][2][4][2], const Unit& u, int wr, int wc, int fr, int fq) {
                pg8::epi8(acc, wr, wc, fr, fq, [&](int row, int col, const f32x4& a, const f32x4& b) {
                    const int gr = u.pm * 256 + row, c = u.pn * 256 + col;
                    const u32x4 gz = *(const u32x4*)(Z + (size_t)gr * ZLD + ZC_GZ + u.z * 1024 + c);
                    f32x4 va, vb;
                    va[0] = a[0] * lo2f(gz.x); va[1] = a[1] * hi2f(gz.x); va[2] = a[2] * lo2f(gz.y); va[3] = a[3] * hi2f(gz.y);
                    vb[0] = b[0] * lo2f(gz.z); vb[1] = b[1] * hi2f(gz.z); vb[2] = b[2] * lo2f(gz.w); vb[3] = b[3] * hi2f(gz.w);
                    bf16_t* mp = MMS + (size_t)gr * 1024 + c;
                    if (u.z != 0) { const u32x4 pm = *(const u32x4*)mp;
                        va[0] += lo2f(pm.x); va[1] += hi2f(pm.x); va[2] += lo2f(pm.y); va[3] += hi2f(pm.y); vb[0] += lo2f(pm.z); vb[1] += hi2f(pm.z); vb[2] += lo2f(pm.w); vb[3] += hi2f(pm.w); }
                    store8_bf16((u.z == 2 ? MMB : mp) + (u.z == 2 ? (size_t)gr * 1024 + c : 0), va, vb); }); });
        }
        GRID_SYNC();
        if (RUN(PH_WOUT)) for (int rep_ = 0; rep_ < (((REP_PHASE) == PH_WOUT || (REP_PHASE) == 999) && layer == 0 ? 2 : 1); ++rep_) { PHASE_LOCALS
            const bf16_t* MMB = B.MMB; const bf16_t* W = B.W; const float* mod = B.mod;
            auto S = make_sched(np, 4, [=](Unit& u) { u.A = (const char*)(MMB + (size_t)u.pm * 256 * 1024); u.B = (const char*)(W + WO_OUT + (size_t)u.pn * 256 * 1024); });
            const float* x32 = ck.x32; bf16_t* xb = ck.xb; const int isc = ck.is_ctx, b0 = ck.b0;
            pg8::gemm_phase(lds, 1024, 1024, 1024, S, [=](const f32x4 (&acc)[2][2][4][2], const Unit& u, int wr, int wc, int fr, int fq) {
                const int bi = isc ? 32 : b0 + (u.pm >> 3);
                const float* g1 = mod + (size_t)bi * 6144 + 2 * 1024;
                pg8::epi8(acc, wr, wc, fr, fq, [&](int row, int col, const f32x4& a, const f32x4& b) {
                    const int c = u.pn * 256 + col; const size_t o = (size_t)(u.pm * 256 + row) * 1024 + c;
                    const f32x4 ga = *(const f32x4*)(g1 + c), gb = *(const f32x4*)(g1 + c + 4);
                    f32x4 xa, xv;
                    if (x32) { xa = *(const f32x4*)(x32 + o); xv = *(const f32x4*)(x32 + o + 4); }
                    else { const u32x4 w = *(const u32x4*)(xb + o); xa[0] = lo2f(w.x); xa[1] = hi2f(w.x); xa[2] = lo2f(w.y); xa[3] = hi2f(w.y); xv[0] = lo2f(w.z); xv[1] = hi2f(w.z); xv[2] = lo2f(w.w); xv[3] = hi2f(w.w); }
                    store8_bf16(xb + o, xa + ga * a, xv + gb * b); }); });
        }
        GRID_SYNC();
        if (RUN(PH_NORM2)) REP(PH_NORM2) { PHASE_LOCALS phase_norm<false>(ck.xb, rows, P.norm2_g + layer * 1024, B.mod, ck.is_ctx, ck.b0, 3, B.H); }
        GRID_SYNC();
        if (RUN(PH_WQ)) REP(PH_WQ) { PHASE_LOCALS
            const bf16_t* H = B.H; const bf16_t* W = B.W; _Float16* SC = B.SC;
            auto S = make_sched(np, 8, [=](Unit& u) { u.A = (const char*)(H + (size_t)u.pm * 256 * 1024); u.B = (const char*)(W + WO_Q + (size_t)u.pn * 256 * 1024); });
            pg8::gemm_phase(lds, 1024, 1024, 1024, S, [=](const f32x4 (&acc)[2][2][4][2], const Unit& u, int wr, int wc, int fr, int fq) {
                pg8::epi8(acc, wr, wc, fr, fq, [&](int row, int col, const f32x4& a, const f32x4& b) {
                    h16x8 hv; hv[0] = (_Float16)a[0]; hv[1] = (_Float16)a[1]; hv[2] = (_Float16)a[2]; hv[3] = (_Float16)a[3]; hv[4] = (_Float16)b[0]; hv[5] = (_Float16)b[1]; hv[6] = (_Float16)b[2]; hv[7] = (_Float16)b[3];
                    *(h16x8*)(SC + (size_t)(u.pm * 256 + row) * 2048 + u.pn * 256 + col) = hv; }); });
        }
        GRID_SYNC();
        if (RUN(PH_SELECT)) REP(PH_SELECT) { PHASE_LOCALS phase_select(B.SC, rows, B.ROUTE, B.EID, lds); }
        GRID_SYNC();
        if (RUN(PH_PEERU)) REP(PH_PEERU) { PHASE_LOCALS phase_peer_u(B.H, B.EID, (const unsigned char*)(B.W + WO_PU), rows, B.PART); }
        GRID_SYNC();
        if (RUN(PH_PEERW)) REP(PH_PEERW) { PHASE_LOCALS phase_peer_w(B.PART, B.ROUTE, rows, B.WG); }
        GRID_SYNC();
        if (RUN(PH_PEERV)) REP(PH_PEERV) { PHASE_LOCALS phase_peer_v(B.WG, B.EID, (const unsigned char*)(B.W + WO_PV), B.mod, ck.is_ctx, ck.b0, rows, ck.xb, rep_ != 0); }
        GRID_SYNC();
        }
    }
    }
    if (R.mode == 0 || R.mode == 3) { const Params P = kparams(); phase_final((const bf16_t*)(P.ws + WS_XL), P.out, P.final_norm_g, NB * TL); }
#undef RUN
#undef GRID_SYNC
#undef PHASE_LOCALS
}

extern "C" void kernel_launch(void* const* d_in, const int* in_sizes, int n_in, void* d_out, int out_size, void* d_ws, size_t ws_size, hipStream_t stream) {
    static int grid = 0;
    if (grid == 0) {
        if (n_in != 25 || ws_size < WS_END) { fprintf(stderr, "kernel_launch: need 25 inputs and %zu bytes of workspace (got %d, %zu)\n", (size_t)WS_END, n_in, ws_size); grid = -1; return; }
        int dev = 0, cus = 0, per_cu = 0;
        if (hipGetDevice(&dev) != hipSuccess || hipDeviceGetAttribute(&cus, hipDeviceAttributeMultiprocessorCount, dev) != hipSuccess) { grid = -1; return; }
        if (hipFuncSetAttribute((const void*)fwd_kernel, hipFuncAttributeMaxDynamicSharedMemorySize, LDS_BYTES) != hipSuccess) { fprintf(stderr, "kernel_launch: hipFuncSetAttribute failed\n"); grid = -1; return; }
        if (hipOccupancyMaxActiveBlocksPerMultiprocessor(&per_cu, (const void*)fwd_kernel, NTHR, LDS_BYTES) != hipSuccess || per_cu < 1) { fprintf(stderr, "kernel_launch: occupancy query says %d\n", per_cu); grid = -1; return; }
        grid = cus;
    }
    if (grid <= 0) return;
    (void)hipMemsetAsync((char*)d_ws + WS_CTL, 0, CTL_BYTES, stream);
    Params P{};
    const float* const* in = (const float* const*)d_in;
    P.x = in[0]; P.c = in[1]; P.ctx = in[2]; P.c_ctx = in[3]; P.ada_w = in[4]; P.ada_b = in[5]; P.norm1_g = in[6]; P.norm2_g = in[7]; P.w_in = in[8]; P.pool_w = in[9];
    P.pool_scale = in[10]; P.gla_gate_w = in[11]; P.gla_gate_b = in[12]; P.gla_norm_g = in[13]; P.mla_q_norm_g = in[14]; P.mla_kv_norm_g = in[15]; P.mla_w_uq = in[16];
    P.mla_w_ukv = in[17]; P.branch_w = in[18]; P.w_out = in[19]; P.peer_wq = in[20]; P.peer_keys = in[21]; P.peer_u = in[22]; P.peer_v = in[23]; P.final_norm_g = in[24];
    P.out = (float*)d_out; P.ws = (unsigned char*)d_ws;
#if MK_SINGLE
    RunArgs R{0, 0, 0, 0};
    hipLaunchKernelGGL(fwd_kernel, dim3(grid), dim3(NTHR), LDS_BYTES, stream, P, R);
#else
    { RunArgs R{1, 0, 0, 0}; hipLaunchKernelGGL(fwd_kernel, dim3(grid), dim3(NTHR), LDS_BYTES, stream, P, R); }
    for (int layer = 0; layer < NLAYER; ++layer)
        for (int ci = 0; ci < 5; ++ci)
            for (int ph = 0; ph < PH_COUNT; ++ph) {
                if (ci == 0 && layer == NLAYER - 1 && ph >= PH_INPROJ2) continue;
                RunArgs R{2, layer, ci, ph}; hipLaunchKernelGGL(fwd_kernel, dim3(grid), dim3(NTHR), LDS_BYTES, stream, P, R); }
    { RunArgs R{3, 0, 0, 0}; hipLaunchKernelGGL(fwd_kernel, dim3(grid), dim3(NTHR), LDS_BYTES, stream, P, R); }
#endif
}
```

```cpp
#include <hip/hip_runtime.h>
#include <stdint.h>
#include <stdio.h>

#ifndef REP_PHASE
#define REP_PHASE -1
#endif
#ifndef MK_SINGLE
#define MK_SINGLE 1
#endif

#define DI __device__ __forceinline__
#define LAS __attribute__((address_space(3)))

typedef unsigned short bf16_t;
typedef short bf16x8 __attribute__((ext_vector_type(8)));
typedef short s16x4 __attribute__((ext_vector_type(4)));
typedef float f32x4 __attribute__((ext_vector_type(4)));
typedef float f32x16 __attribute__((ext_vector_type(16)));
typedef unsigned u32x4 __attribute__((ext_vector_type(4)));
typedef unsigned u32x2 __attribute__((ext_vector_type(2)));
typedef __bf16 bf16x2_t __attribute__((ext_vector_type(2)));
typedef _Float16 h16x8 __attribute__((ext_vector_type(8)));
typedef int i32x4 __attribute__((ext_vector_type(4)));
typedef int i32x8 __attribute__((ext_vector_type(8)));

constexpr int D = 1024, NB = 32, TL = 2048, TC = 256, NLAYER = 2;
constexpr int ZLD = 7936;
constexpr int ZC_P = 0, ZC_Q = 1024, ZC_K = 1536, ZC_V = 2048, ZC_R = 3072, ZC_GZ = 4096, ZC_QDN = 7168, ZC_KVDN = 7552,
              ZC_KROPE = 7808, ZC_LRF = 7872, ZC_LRB = 7888;
constexpr int NEXP = 16384;
constexpr int NWG = 256, NTHR = 512;
constexpr int LDS_BYTES = 147456;

constexpr size_t WO_IN = 0, WO_POOL = WO_IN + (size_t)ZLD * 1024, WO_UQ = WO_POOL + 4 * 256 * 256, WO_KN = WO_UQ + 1536 * 384,
                 WO_V = WO_KN + 1024 * 256, WO_BR = WO_V + 1024 * 256, WO_OUT = WO_BR + 3 * 1024 * 1024, WO_Q = WO_OUT + 1024 * 1024,
                 WO_KEYS = WO_Q + 2048 * 1024, WO_PU = WO_KEYS + 8 * 256 * 256, WO_PV = WO_PU + (size_t)NEXP * 512,
                 W_LAYER = WO_PV + (size_t)NEXP * 512;

constexpr size_t MiB = 1048576;
constexpr size_t WS_CTL = 0;
constexpr size_t CTL_BYTES = 65536;
constexpr size_t WS_MOD = WS_CTL + CTL_BYTES;
constexpr size_t WS_ROPE = WS_MOD + 1792 * 1024;
constexpr size_t WS_W = WS_MOD + 2 * MiB;
constexpr size_t WS_H = WS_W + ((2 * W_LAYER * 2 + 255) / 256) * 256;
constexpr size_t WS_Z = WS_H + 32 * MiB;
constexpr size_t WS_QB = WS_Z + 248 * MiB;
constexpr size_t WS_KN = WS_QB + 48 * MiB;
constexpr size_t WS_VT = WS_KN + 32 * MiB;
constexpr size_t WS_KR = WS_VT + 32 * MiB;
constexpr size_t WS_CKN = WS_KR + 2 * MiB;
constexpr size_t WS_CVT = WS_CKN + 16 * MiB;
constexpr size_t WS_CKR = WS_CVT + 16 * MiB;
constexpr size_t WS_CST = WS_CKR + 1 * MiB;
constexpr size_t WS_RS = WS_CST + 32 * MiB;
constexpr size_t WS_OF = WS_RS + 1 * MiB;
constexpr size_t WS_OB = WS_OF + 32 * MiB;
constexpr size_t WS_MLA = WS_OB + 32 * MiB;
constexpr size_t WS_PD = WS_MLA + 32 * MiB;
constexpr size_t WS_PO = WS_PD + 32 * MiB;
constexpr size_t WS_ROUTE = WS_PO + 32 * MiB;
constexpr size_t WS_XCTX = WS_ROUTE + 16 * MiB;
constexpr size_t WS_XL = WS_XCTX + 16 * MiB;
constexpr size_t WS_END = WS_XL + 128 * MiB;

DI float bf2f(bf16_t b) { return __uint_as_float((unsigned)b << 16); }
DI bf16_t f2bf(float f) { return __builtin_bit_cast(bf16_t, (__bf16)f); }
DI unsigned pk2(float lo, float hi) { bf16x2_t v; v[0] = (__bf16)lo; v[1] = (__bf16)hi; return __builtin_bit_cast(unsigned, v); }
DI unsigned pk4_fp8(float a, float b, float c, float d) { int w = 0; w = __builtin_amdgcn_cvt_pk_fp8_f32(a, b, w, false); w = __builtin_amdgcn_cvt_pk_fp8_f32(c, d, w, true); return (unsigned)w; }
DI unsigned char f2fp8(float a) { return (unsigned char)(__builtin_amdgcn_cvt_pk_fp8_f32(a, a, 0, false) & 0xff); }
DI float lo2f(unsigned w) { return __uint_as_float(w << 16); }
DI float hi2f(unsigned w) { return __uint_as_float(w & 0xffff0000u); }
DI float shx(float v, int m, int lane) { return __builtin_bit_cast(float, __builtin_amdgcn_ds_bpermute((lane ^ m) << 2, __builtin_bit_cast(int, v))); }
DI float shl(float v, int src) { return __builtin_bit_cast(float, __builtin_amdgcn_ds_bpermute(src << 2, __builtin_bit_cast(int, v))); }
DI float wave_sum(float v, int lane) {
#pragma unroll
    for (int o = 32; o >= 1; o >>= 1) v += shx(v, o, lane);
    return v;
}
DI int ltid() { int t = threadIdx.x; asm volatile("" : "+v"(t)); return t; }
DI int lnd(int x) { asm volatile("" : "+s"(x)); return x; }
DI int lbid() { return lnd((int)blockIdx.x); }
DI int lgdim() { return lnd((int)gridDim.x); }
DI float sigmoidf_(float x) { return 1.0f / (1.0f + __expf(-x)); }

#define XB_TMO      128
#define XB_XCNT(j)  (256  + 64 * (j))
#define XB_XSUB(j)  (1280 + 64 * (j))
#define XB_XGEN(j)  (2304 + 64 * (j))
#define XB_TOP      3328
#define XB_TOPGEN   3392
#define XCD_BAR_WORDS 3456
#define XB_SPIN_CAP (1u << 23)
#define CTL_WORKQ   4096

DI unsigned xb_ld(unsigned* p)              { return __hip_atomic_load(p, __ATOMIC_RELAXED, __HIP_MEMORY_SCOPE_AGENT); }
DI unsigned xb_add(unsigned* p, unsigned v) { return __hip_atomic_fetch_add(p, v, __ATOMIC_RELAXED, __HIP_MEMORY_SCOPE_AGENT); }
DI unsigned xb_xcc_id() { return (unsigned)__builtin_amdgcn_s_getreg((3 << 11) | 20) & 0xFu; }
#define XB_SPIN(cond, bar) do { unsigned _sp = 0; while (cond) { __builtin_amdgcn_s_sleep(1); \
    if ((++_sp & 255u) == 0u) { if (xb_ld(&(bar)[XB_TMO])) break; if (_sp > XB_SPIN_CAP) { atomicAdd(&(bar)[XB_TMO], 1u); break; } } } } while (0)

struct XcdBarrier { unsigned* bar; unsigned x; volatile LAS unsigned* st; };

DI XcdBarrier xcd_barrier_post(unsigned* bar, volatile LAS unsigned* st) {
    XcdBarrier b; b.bar = bar; b.x = xb_xcc_id(); b.st = st;
    if (threadIdx.x == 0) (void)xb_add(&bar[XB_XCNT(b.x)], 1u);
    return b;
}
DI void xcd_barrier_complete(unsigned* bar, unsigned x, unsigned& nloc, unsigned& nx) {
    const unsigned G = gridDim.x * gridDim.y * gridDim.z;
    unsigned sum, cnt, mine, sp = 0u;
    for (;;) {
        sum = 0u; cnt = 0u; mine = 0u;
#pragma unroll
        for (unsigned j = 0; j < 16; ++j) { const unsigned c = xb_ld(&bar[XB_XCNT(j)]); sum += c; cnt += (c > 0u) ? 1u : 0u; mine = (j == x) ? c : mine; }
        if (sum == G) break;
        __builtin_amdgcn_s_sleep(1);
        if ((++sp & 255u) == 0u) { if (xb_ld(&bar[XB_TMO])) break; if (sp > XB_SPIN_CAP) { atomicAdd(&bar[XB_TMO], 1u); break; } }
    }
    nloc = mine > 0u ? mine : 1u; nx = cnt > 0u ? cnt : 1u;
}
DI void xcd_barrier(const XcdBarrier& b) {
    asm volatile("s_waitcnt vmcnt(0)" ::: "memory");
    __syncthreads();
    if (threadIdx.x == 0) {
        __attribute__((address_space(1))) unsigned* gbar = (__attribute__((address_space(1))) unsigned*)b.bar; asm volatile("" : "+s"(gbar)); unsigned* bar = (unsigned*)gbar;
        unsigned bx = b.x; asm volatile("" : "+s"(bx));
        __builtin_amdgcn_s_waitcnt(0);
        unsigned nloc = b.st[0], nx = b.st[1];
        if (nloc == 0u) { xcd_barrier_complete(bar, bx, nloc, nx); b.st[0] = nloc; b.st[1] = nx; }
        const unsigned old = xb_add(&bar[XB_XSUB(bx)], 1u);
        const unsigned gen = old / nloc;
        if (old + 1u == (gen + 1u) * nloc) {
            __builtin_amdgcn_fence(__ATOMIC_RELEASE, "agent");
            asm volatile("s_waitcnt vmcnt(0)" ::: "memory");
            const unsigned og = xb_add(&bar[XB_TOP], 1u);
            const unsigned tg = og / nx;
            if (og + 1u == (tg + 1u) * nx) xb_add(&bar[XB_TOPGEN], 1u);
            else XB_SPIN(xb_ld(&bar[XB_TOPGEN]) == tg, bar);
            __builtin_amdgcn_fence(__ATOMIC_ACQUIRE, "agent");
            xb_add(&bar[XB_XGEN(bx)], 1u);
            asm volatile("s_waitcnt vmcnt(0)" ::: "memory");
        } else {
            XB_SPIN(xb_ld(&bar[XB_XGEN(bx)]) == gen, bar);
            __builtin_amdgcn_fence(__ATOMIC_ACQUIRE, "agent");
            asm volatile("s_waitcnt vmcnt(0)" ::: "memory");
        }
    }
    __syncthreads();
}

namespace pg8 {
constexpr int BM = 256, BK = 64, HALF = 128, HTB = HALF * BK * 2, STAGE_BYTES = 8 * HTB, NXCD = 8, WGM = 8;
DI int lds_byte(int r, int c) { const int st = (r >> 4) * 2 + (c >> 5), rr = r & 15, cc = c & 31, ob = rr * 64 + cc * 2; return st * 1024 + (ob ^ (((ob >> 9) & 1) << 5)); }
DI void stage_rc(int b, int& R, int& C) { const int st = b / 1024, sb = b % 1024, swz = sb ^ (((sb >> 9) & 1) << 5); R = (st >> 1) * 16 + swz / 64; C = (st & 1) * 32 + (swz % 64) / 2; }
DI int perm32(int rho) { const int n = rho >> 4, i = rho & 15; return 8 * (i >> 2) + 4 * n + (i & 3); }

struct Unit { const char* A; const char* B; int pm, pn, z; unsigned sa; };

DI void tile_of(int L, int nM, int nN, int& pm, int& pn) {
    const int nwg = nM * nN; int wgid = L;
    { const int q = nwg / NXCD, r = nwg % NXCD, xcd = wgid % NXCD, off = wgid / NXCD; wgid = (xcd < r ? xcd * (q + 1) : r * (q + 1) + (xcd - r) * q) + off; }
    const int nig = WGM * nN, gid = wgid / nig, fm = gid * WGM, gsz = (nM - fm) < WGM ? (nM - fm) : WGM;
    pm = fm + ((wgid % nig) % gsz); pn = (wgid % nig) / gsz;
}

template <class F> DI void epi8(const f32x4 (&acc)[2][2][4][2], int wr, int wc, int fr, int fq, F f) {
#pragma unroll
    for (int ai = 0; ai < 2; ++ai)
#pragma unroll
        for (int m = 0; m < 4; ++m) {
            const int row = ai * HALF + wr * 64 + m * 16 + fr;
#pragma unroll
            for (int bj = 0; bj < 2; ++bj) f(row, bj * HALF + wc * 32 + 8 * fq, acc[ai][bj][m][0], acc[ai][bj][m][1]);
        }
}

template <int ES, class Epi, class Sched>
DI void gemm_phase(LAS unsigned char* lds, const int lda, const int ldb, const int K, const Sched& S, const Epi& E) {
    int tid = threadIdx.x; asm volatile("" : "+v"(tid));
    const int wid = __builtin_amdgcn_readfirstlane(tid >> 6), lane = tid & 63, wr = wid >> 2, wc = wid & 3, fr = lane & 15, fq = lane >> 4;
    const int nt = K * ES / (BK * 2);
    unsigned voffA[2], voffB[2];
#pragma unroll
    for (int i = 0; i < 2; ++i) { int R, C; stage_rc(tid * 16 + i * 8192, R, C); const int Rb = (R & ~31) + perm32(R & 31);
        voffA[i] = (unsigned)(R * lda * ES + C * 2); voffB[i] = (unsigned)(Rb * ldb * ES + C * 2); }
    const size_t kstep = (size_t)(BK * 2);
    const size_t hstepA = (size_t)HALF * lda * ES, hstepB = (size_t)HALF * ldb * ES;
    const unsigned ldsw = (unsigned)wid * 1024u;
    LAS unsigned char* ldsA = lds + lds_byte(wr * 64 + fr, fq * 8); LAS unsigned char* ldsB = lds + 4 * HTB + lds_byte(wc * 32 + fr, fq * 8);
    asm volatile("" : "+v"(ldsA), "+v"(ldsB));
#define PG8_SA(b, h) (((b) * 2 + (h)) * HTB)
#define PG8_SB(b, h) ((4 + (b) * 2 + (h)) * HTB)
#define PG8_STAGE(bufoff, gbase, voff) do { const char* _g = (const char*)(gbase); asm volatile("" : "+s"(_g)); _Pragma("unroll") for (int _i = 0; _i < 2; ++_i) \
        __builtin_amdgcn_global_load_lds((const unsigned*)(_g + (voff)[_i]), (LAS unsigned*)(lds + (bufoff) + ldsw + _i * 8192), 16, 0, 0); } while (0)
#define PG8_LD16(p) (*(const LAS i32x4*)(p))
#define PG8_LDA(dst, b, h) do { _Pragma("unroll") for (int m = 0; m < 4; ++m) { \
        if constexpr (ES == 2) { _Pragma("unroll") for (int k = 0; k < 2; ++k) dst[m][k] = *(const LAS bf16x8*)(ldsA + PG8_SA(b, h) + m * 2048 + k * 1024); } \
        else dst##8[m] = __builtin_shufflevector(PG8_LD16(ldsA + PG8_SA(b, h) + m * 2048), PG8_LD16(ldsA + PG8_SA(b, h) + m * 2048 + 1024), 0, 1, 2, 3, 4, 5, 6, 7); } } while (0)
#define PG8_LDB(dst, b, h) do { _Pragma("unroll") for (int n = 0; n < 2; ++n) { \
        if constexpr (ES == 2) { _Pragma("unroll") for (int k = 0; k < 2; ++k) dst[n][k] = *(const LAS bf16x8*)(ldsB + PG8_SA(b, h) + n * 2048 + k * 1024); } \
        else dst##8[n] = __builtin_shufflevector(PG8_LD16(ldsB + PG8_SA(b, h) + n * 2048), PG8_LD16(ldsB + PG8_SA(b, h) + n * 2048 + 1024), 0, 1, 2, 3, 4, 5, 6, 7); } } while (0)
#define PG8_MMA(ai, bj, At, Bt) do { __builtin_amdgcn_s_setprio(1); _Pragma("unroll") for (int m = 0; m < 4; ++m) _Pragma("unroll") for (int n = 0; n < 2; ++n) { \
        if constexpr (ES == 2) { _Pragma("unroll") for (int k = 0; k < 2; ++k) acc[ai][bj][m][n] = __builtin_amdgcn_mfma_f32_16x16x32_bf16(Bt[n][k], At[m][k], acc[ai][bj][m][n], 0, 0, 0); } \
        else asm volatile("v_mfma_scale_f32_16x16x128_f8f6f4 %0, %1, %2, %0, %3, %4 op_sel_hi:[0,0,0]" : "+v"(acc[ai][bj][m][n]) : "v"(Bt##8[n]), "v"(At##8[m]), "v"(0x7a7a7a7a), "v"(cur.sa)); } \
        __builtin_amdgcn_s_setprio(0); if constexpr (ES == 1) __builtin_amdgcn_sched_barrier(0); } while (0)
#define PG8_WAIT_V(n) asm volatile("s_waitcnt vmcnt(" #n ")" ::: "memory")
#define PG8_WAIT_L(n) asm volatile("s_waitcnt lgkmcnt(" #n ")" ::: "memory")
#define PG8_BAR __builtin_amdgcn_s_barrier()
#define PG8_SCHED __builtin_amdgcn_sched_barrier(0)
    Unit cur, nxt; int ui = 0;
    if (!S.next(0, cur)) return;
    f32x4 acc[2][2][4][2];
#pragma unroll
    for (int a = 0; a < 2; ++a)
#pragma unroll
        for (int b = 0; b < 2; ++b)
#pragma unroll
            for (int m = 0; m < 4; ++m)
#pragma unroll
                for (int n = 0; n < 2; ++n) acc[a][b][m][n] = (f32x4){0.f, 0.f, 0.f, 0.f};
    bf16x8 At[4][2], B0[2][2], B1[2][2];
    i32x8 At8[4], B08[2], B18[2];
    const char* cA = cur.A; const char* cB = cur.B;
    PG8_STAGE(PG8_SB(0, 0), cB, voffB); PG8_STAGE(PG8_SA(0, 0), cA, voffA); PG8_STAGE(PG8_SB(0, 1), cB + hstepB, voffB); PG8_STAGE(PG8_SA(0, 1), cA + hstepA, voffA);
    if (wr == 1) PG8_BAR;
    PG8_WAIT_V(4); PG8_BAR;
    PG8_STAGE(PG8_SB(1, 0), cB + kstep, voffB); PG8_STAGE(PG8_SA(1, 0), cA + kstep, voffA); PG8_STAGE(PG8_SB(1, 1), cB + hstepB + kstep, voffB);
    PG8_WAIT_V(6); PG8_BAR;
    for (;;) {
        const bool has_next = S.next(ui + 1, nxt);
        const char* nA = has_next ? nxt.A : cA; const char* nB = has_next ? nxt.B : cB;
#pragma nounroll
        for (int t = 0; t < nt; t += 2) {
            const bool last = (t == nt - 2);
            const char* a1 = cA + (size_t)(t + 1) * kstep;
            const char* a2 = last ? nA : cA + (size_t)(t + 2) * kstep; const char* b2 = last ? nB : cB + (size_t)(t + 2) * kstep;
            const char* a3 = a2 + kstep; const char* b3 = b2 + kstep;
            PG8_LDB(B0, 0, 0); PG8_SCHED; PG8_LDA(At, 0, 0); PG8_STAGE(PG8_SA(1, 1), a1 + hstepA, voffA);
            PG8_WAIT_L(8); PG8_BAR; PG8_WAIT_L(0); PG8_MMA(0, 0, At, B0); PG8_BAR; PG8_SCHED;
            PG8_LDB(B1, 0, 1); PG8_STAGE(PG8_SB(0, 0), b2, voffB);
            PG8_BAR; PG8_WAIT_L(0); PG8_MMA(0, 1, At, B1); PG8_BAR;
            PG8_LDA(At, 0, 1); PG8_STAGE(PG8_SA(0, 0), a2, voffA);
            PG8_BAR; PG8_WAIT_L(0); PG8_MMA(1, 0, At, B0); PG8_BAR; PG8_SCHED;
            PG8_STAGE(PG8_SB(0, 1), b2 + hstepB, voffB);
            PG8_WAIT_V(6); PG8_BAR; PG8_MMA(1, 1, At, B1); PG8_BAR;
            PG8_LDB(B0, 1, 0); PG8_SCHED; PG8_LDA(At, 1, 0); PG8_STAGE(PG8_SA(0, 1), a2 + hstepA, voffA);
            PG8_WAIT_L(8); PG8_BAR; PG8_WAIT_L(0); PG8_MMA(0, 0, At, B0); PG8_BAR; PG8_SCHED;
            PG8_LDB(B1, 1, 1); PG8_STAGE(PG8_SB(1, 0), b3, voffB);
            PG8_BAR; PG8_WAIT_L(0); PG8_MMA(0, 1, At, B1); PG8_BAR;
            PG8_LDA(At, 1, 1); PG8_STAGE(PG8_SA(1, 0), a3, voffA);
            PG8_BAR; PG8_WAIT_L(0); PG8_MMA(1, 0, At, B0); PG8_BAR; PG8_SCHED;
            PG8_STAGE(PG8_SB(1, 1), b3 + hstepB, voffB);
            PG8_WAIT_V(6); PG8_BAR; PG8_MMA(1, 1, At, B1); PG8_BAR;
        }
        if constexpr (ES == 1) asm volatile("s_nop 15\n\ts_nop 15" ::: "memory");
        E(acc, cur, wr, wc, fr, fq);
        if (!has_next) break;
#pragma unroll
        for (int a = 0; a < 2; ++a)
#pragma unroll
            for (int b = 0; b < 2; ++b)
#pragma unroll
                for (int m = 0; m < 4; ++m)
#pragma unroll
                    for (int n = 0; n < 2; ++n) acc[a][b][m][n] = (f32x4){0.f, 0.f, 0.f, 0.f};
        cur = nxt; cA = nA; cB = nB; ++ui;
    }
    PG8_WAIT_V(0);
    if (wr == 0) PG8_BAR;
    PG8_BAR;
#undef PG8_SA
#undef PG8_SB
#undef PG8_STAGE
#undef PG8_LDA
#undef PG8_LDB
#undef PG8_MMA
#undef PG8_WAIT_V
#undef PG8_WAIT_L
#undef PG8_BAR
#undef PG8_SCHED
}
}
using pg8::Unit;

struct Params {
    const float *x, *c, *ctx, *c_ctx, *ada_w, *ada_b, *norm1_g, *norm2_g, *w_in, *pool_w, *pool_scale, *gla_gate_w, *gla_gate_b, *gla_norm_g,
                *mla_q_norm_g, *mla_kv_norm_g, *mla_w_uq, *mla_w_ukv, *branch_w, *w_out, *peer_wq, *peer_keys, *peer_u, *peer_v, *final_norm_g;
    float* out; unsigned char* ws;
};
struct Chunk { int is_ctx, rows, b0, np; const float* x32; bf16_t* xb; };

DI Chunk make_chunk(const Params& P, int layer, int ci) {
    Chunk c; c.is_ctx = (ci == 0); c.rows = c.is_ctx ? NB * TC : 8 * TL; c.b0 = c.is_ctx ? 0 : 8 * (ci - 1); c.np = c.rows / 256;
    c.xb = c.is_ctx ? (bf16_t*)(P.ws + WS_XCTX) : (bf16_t*)(P.ws + WS_XL) + (size_t)c.b0 * TL * D;
    c.x32 = (layer == 0) ? (c.is_ctx ? P.ctx : P.x + (size_t)c.b0 * TL * D) : nullptr;
    return c;
}
DI const bf16_t* wlayer(const Params& P, int l) { return (const bf16_t*)(P.ws + WS_W) + (size_t)l * W_LAYER; }
DI const float* modlayer(const Params& P, int l) { return (const float*)(P.ws + WS_MOD) + (size_t)l * 33 * 6144; }

template <bool FP8 = false, class SrcF> DI void tconv_tiles(LAS float* tile, bf16_t* dst, int K, int N, SrcF src, int rot) {
    const int tid = ltid(), ntk = K / 64, ntn = N / 64, nwg = lgdim();
    const int wg = (int)(((unsigned)lbid() + (unsigned)rot) % (unsigned)nwg);
    for (int t = wg; t < ntk * ntn; t += nwg) {
        const int kt = t % ntk, nt_ = t / ntk;
#pragma unroll
        for (int rr = 0; rr < 8; ++rr) { const int i = (tid >> 6) + 8 * rr, j = tid & 63; tile[i * 65 + j] = src(kt * 64 + i, nt_ * 64 + j); }
        __syncthreads();
#pragma unroll
        for (int rr = 0; rr < 8; ++rr) { const int jj = (tid >> 6) + 8 * rr, ii = tid & 63; const size_t o = (size_t)(nt_ * 64 + jj) * K + kt * 64 + ii;
            if (FP8) ((unsigned char*)dst)[o] = f2fp8(tile[ii * 65 + jj] * 32.0f); else dst[o] = f2bf(tile[ii * 65 + jj]); }
        __syncthreads();
    }
}
DI void conv_direct(const float* src, bf16_t* dst, size_t n) {
    const size_t stride = (size_t)lgdim() * NTHR;
    const int tid_ = ltid();
    for (size_t i = (size_t)lbid() * NTHR + tid_; i < n / 4; i += stride) {
        const float4 v = ((const float4*)src)[i]; u32x2 w; w.x = pk2(v.x, v.y); w.y = pk2(v.z, v.w); ((u32x2*)dst)[i] = w; }
}
DI void conv_fp8(const float* src, unsigned* dst, size_t n, float scale) {
    const size_t stride = (size_t)lgdim() * NTHR;
    const int tid_ = ltid();
    for (size_t i = (size_t)lbid() * NTHR + tid_; i < n / 4; i += stride) {
        const float4 v = ((const float4*)src)[i]; int w = 0;
        w = __builtin_amdgcn_cvt_pk_fp8_f32(v.x * scale, v.y * scale, w, false); w = __builtin_amdgcn_cvt_pk_fp8_f32(v.z * scale, v.w * scale, w, true);
        dst[i] = (unsigned)w; }
}
DI void phase_convert(const Params& P, LAS unsigned char* lds) {
    LAS float* tile = (LAS float*)lds;
    for (int l = 0; l < NLAYER; ++l) {
        bf16_t* W = (bf16_t*)(P.ws + WS_W) + (size_t)l * W_LAYER;
        { const float* w = P.w_in + (size_t)l * 1024 * 7904;
          tconv_tiles<true>(tile, W + WO_IN, 1024, ZLD, [=](int k, int n) -> float {
              int sc; float s = 1.0f;
              if (n < 4096) { sc = n; if (n >= 1024 && n < 1536) s = 0.08838834764831845f; }
              else if (n < 7168) sc = n - 4096 + 4832;
              else if (n < 7552) sc = n - 7168 + 4128;
              else if (n < 7808) sc = n - 7552 + 4512;
              else if (n < 7872) sc = n - 7808 + 4768;
              else if (n < 7888) sc = n - 7872 + 4096;
              else if (n < 7904) sc = n - 7888 + 4112;
              else return 0.0f;
              return w[(size_t)k * 7904 + sc] * s; }, 0); }
        { const float* w = P.mla_w_uq + (size_t)l * 384 * 1536; const float* g = P.mla_q_norm_g + l * 384;
          tconv_tiles(tile, W + WO_UQ, 384, 1536, [=](int k, int n) -> float { return g[k] * w[k * 1536 + n]; }, 81); }
        { const float* w = P.mla_w_ukv + (size_t)l * 256 * 2048; const float* g = P.mla_kv_norm_g + l * 256;
          tconv_tiles(tile, W + WO_KN, 256, 1024, [=](int k, int n) -> float { return g[k] * w[k * 2048 + (n >> 7) * 256 + (n & 127)]; }, 120);
          tconv_tiles(tile, W + WO_V, 256, 1024, [=](int k, int n) -> float { return g[k] * w[k * 2048 + (n >> 7) * 256 + 128 + (n & 127)]; }, 184); }
        for (int i = 1; i < 3; ++i) { const float* w = P.branch_w + ((size_t)l * 3 + i) * 1048576;
          tconv_tiles<true>(tile, (bf16_t*)((unsigned char*)(W + WO_BR) + (size_t)i * 1048576), 1024, 1024, [=](int k, int n) -> float { return w[k * 1024 + n]; }, 0); }
        {
            const float* pw = P.pool_w + (size_t)l * 4 * 65536; const float* ps = P.pool_scale + l * 1024; const float* bw = P.branch_w + (size_t)l * 3 * 1048576; unsigned char* dst = (unsigned char*)(W + WO_BR);
            LAS float* AS = (LAS float*)lds; LAS float* BS = AS + 64 * 257;
            const int tid = ltid();
            for (int t = lbid(); t < 256; t += lgdim()) {
                const int g = t >> 6, nb = (t >> 2) & 15, kb = t & 3;
                __syncthreads();
                for (int i = tid; i < 64 * 256; i += NTHR) { const int r = i >> 8, j = i & 255; AS[r * 257 + j] = pw[(size_t)g * 65536 + (kb * 64 + r) * 256 + j] * ps[g * 256 + j]; }
                for (int i = tid; i < 256 * 64; i += NTHR) { const int j = i >> 6, n = i & 63; BS[j * 65 + n] = bw[(size_t)(g * 256 + j) * 1024 + nb * 64 + n]; }
                __syncthreads();
                const int kq = tid & 63, n0 = (tid >> 6) * 8;
                float acc[8];
#pragma unroll
                for (int j = 0; j < 8; ++j) acc[j] = 0.f;
                for (int j = 0; j < 256; ++j) { const float a = AS[kq * 257 + j];
#pragma unroll
                    for (int q = 0; q < 8; ++q) acc[q] += a * BS[j * 65 + n0 + q]; }
#pragma unroll
                for (int q = 0; q < 8; ++q) dst[(size_t)(nb * 64 + n0 + q) * 1024 + g * 256 + kb * 64 + kq] = f2fp8(acc[q] * 32.0f);
            }
            __syncthreads();
        }
        { const float* w = P.w_out + (size_t)l * 1048576;
          tconv_tiles<true>(tile, W + WO_OUT, 1024, 1024, [=](int k, int n) -> float { return w[k * 1024 + n]; }, 0); }
        {
            const float* wq = P.peer_wq + (size_t)l * 1024 * 2048; const float* kk = P.peer_keys + (size_t)l * 2 * 8 * 128 * 128; bf16_t* dst = W + WO_Q;
            LAS float* KY = (LAS float*)lds; LAS float* WQS = KY + 128 * 129;
            const int tid = ltid();
            for (int t = lbid(); t < 256; t += lgdim()) {
                const int hs = t >> 4, k0 = (t & 15) * 64, h = hs >> 1, half = hs & 1;
                __syncthreads();
                for (int i = tid; i < 128 * 128; i += NTHR) { const int key = i >> 7, d = i & 127; KY[key * 129 + d] = kk[((size_t)(half * 8 + h) * 128 + key) * 128 + d]; }
                for (int i = tid; i < 64 * 128; i += NTHR) { const int r = i >> 7, d = i & 127; WQS[r * 129 + d] = wq[(size_t)(k0 + r) * 2048 + h * 256 + half * 128 + d]; }
                __syncthreads();
                const int kq = tid & 63, key0 = (tid >> 6) * 16;
                float acc[16];
#pragma unroll
                for (int j = 0; j < 16; ++j) acc[j] = 0.f;
                for (int d = 0; d < 128; ++d) { const float a = WQS[kq * 129 + d];
#pragma unroll
                    for (int j = 0; j < 16; ++j) acc[j] += a * KY[(key0 + j) * 129 + d]; }
#pragma unroll
                for (int j = 0; j < 16; ++j) dst[(size_t)(h * 256 + half * 128 + key0 + j) * 1024 + k0 + kq] = f2bf(acc[j]);
            }
            __syncthreads();
        }
        conv_fp8(P.peer_u + (size_t)l * NEXP * 1024, (unsigned*)(W + WO_PU), (size_t)NEXP * 1024, 32.0f);
        conv_fp8(P.peer_v + (size_t)l * NEXP * 1024, (unsigned*)(W + WO_PV), (size_t)NEXP * 1024, 1.0f);
    }
    if (lbid() == 0) {
        float2* rt = (float2*)(P.ws + WS_ROPE);
        for (int i = ltid(); i < 64 * 16; i += NTHR) { const float inv = exp2f(-(float)(i & 15) * 0.8304820237218406f); float sn, cs; sincosf((float)(i >> 4) * inv, &sn, &cs); rt[i] = make_float2(cs, sn); }
    }
}
DI void phase_mod(const Params& P, LAS unsigned char* lds) {
    LAS float* SC = (LAS float*)lds;
    LAS float* ACC = SC + 33 * 1024;
    const int tid = ltid(), wid = tid >> 6;
    if (lbid() >= 192) return;
    for (int i = tid; i < 33 * 1024; i += NTHR) { const int b = i >> 10, k = i & 1023; const float v = b < 32 ? P.c[b * 1024 + k] : P.c_ctx[k]; SC[i] = v / (1.0f + __expf(-v)); }
    float* MOD = (float*)(P.ws + WS_MOD);
    for (int grp = lbid(); grp < 192; grp += lgdim()) {
        const int l = grp / 96, n0 = (grp % 96) * 64;
        for (int i = tid; i < 33 * 64; i += NTHR) ACC[i] = 0.f;
        __syncthreads();
        const int j = tid & 63, ks = tid >> 6;
        float acc[33];
#pragma unroll
        for (int b = 0; b < 33; ++b) acc[b] = 0.f;
        const float* w = P.ada_w + (size_t)l * 1024 * 6144 + n0 + j;
        for (int k = ks * 128; k < ks * 128 + 128; ++k) { const float wv = w[(size_t)k * 6144];
#pragma unroll
            for (int b = 0; b < 33; ++b) acc[b] += SC[b * 1024 + k] * wv; }
        for (int ww = 0; ww < 8; ++ww) {
            if (wid == ww) {
#pragma unroll
                for (int b = 0; b < 33; ++b) ACC[b * 64 + j] += acc[b]; }
            __syncthreads(); }
        for (int i = tid; i < 33 * 64; i += NTHR) { const int b = i >> 6, jj = i & 63; MOD[(size_t)(l * 33 + b) * 6144 + n0 + jj] = ACC[i] + P.ada_b[l * 6144 + n0 + jj]; }
        __syncthreads();
    }
}

template <bool F32SRC, bool FP8OUT> DI void phase_norm(const void* xsv, int rows, const float* gain, const float* mod, int is_ctx, int b0, int sh_idx, bf16_t* H) {
    const int tid_ = ltid(); const int lane = tid_ & 63, wid = tid_ >> 6;
    for (int r = lbid() * 8 + wid; r < rows; r += lgdim() * 8) {
        const int bi = is_ctx ? 32 : b0 + (r >> 11);
        const float* sh = mod + (size_t)bi * 6144 + sh_idx * 1024; const float* sc = sh + 1024;
        float4 v[4]; float ss = 0.f;
#pragma unroll
        for (int j = 0; j < 4; ++j) {
            if (F32SRC) v[j] = ((const float4*)((const float*)xsv + (size_t)r * 1024))[lane + 64 * j];
            else { const u32x2 w = ((const u32x2*)((const bf16_t*)xsv + (size_t)r * 1024))[lane + 64 * j]; v[j] = make_float4(lo2f(w.x), hi2f(w.x), lo2f(w.y), hi2f(w.y)); }
            ss += v[j].x * v[j].x + v[j].y * v[j].y + v[j].z * v[j].z + v[j].w * v[j].w; }
        ss = wave_sum(ss, lane);
        const float rstd = rsqrtf(ss * (1.0f / 1024.0f) + 1e-6f);
#pragma unroll
        for (int j = 0; j < 4; ++j) { const int c = (lane + 64 * j) * 4;
            const float4 g = *(const float4*)(gain + c), s1 = *(const float4*)(sc + c), s0 = *(const float4*)(sh + c);
            const float y0 = v[j].x * rstd * g.x * (1.f + s1.x) + s0.x, y1 = v[j].y * rstd * g.y * (1.f + s1.y) + s0.y, y2 = v[j].z * rstd * g.z * (1.f + s1.z) + s0.z, y3 = v[j].w * rstd * g.w * (1.f + s1.w) + s0.w;
            if (FP8OUT) *(unsigned*)((unsigned char*)H + (size_t)r * 1024 + c) = pk4_fp8(y0, y1, y2, y3);
            else { u32x2 w; w.x = pk2(y0, y1); w.y = pk2(y2, y3); *(u32x2*)(H + (size_t)r * 1024 + c) = w; } }
    }
}

DI void phase_prep(const bf16_t* Z, int rows, int is_ctx, float* RS, bf16_t* KR, bf16_t* PD, bool do_pool, const float2* rt) {
    const int tid_ = ltid(); const int lane = tid_ & 63, wid = tid_ >> 6;
    const int seqlen = is_ctx ? TC : TL;
    for (int r = lbid() * 8 + wid; r < rows; r += lgdim() * 8) {
        const bf16_t* zr = Z + (size_t)r * ZLD;
        float sq = 0.f, sk = 0.f;
        { const unsigned* p = (const unsigned*)(zr + ZC_QDN + lane * 6);
#pragma unroll
          for (int i = 0; i < 3; ++i) { const unsigned w = p[i]; const float a = lo2f(w), b = hi2f(w); sq += a * a + b * b; } }
        { const u32x2 w = *(const u32x2*)(zr + ZC_KVDN + lane * 4); const float a = lo2f(w.x), b = hi2f(w.x), c = lo2f(w.y), d = hi2f(w.y); sk = a * a + b * b + c * c + d * d; }
        sq = wave_sum(sq, lane); sk = wave_sum(sk, lane);
        if (lane == 0) { RS[r] = rsqrtf(sq * (1.0f / 384.0f) + 1e-6f); RS[16384 + r] = rsqrtf(sk * (1.0f / 256.0f) + 1e-6f); }
        { const float x = bf2f(zr[ZC_KROPE + lane]); const float xp = shx(x, 16, lane); float o = x;
          if (!is_ctx) { const int t = r & (TL - 1); const int pos = (lane < 32) ? (t >> 6) : (t & 63); const int i = lane & 15;
              const float2 cs = rt[pos * 16 + i]; const float c = cs.x, s = cs.y;
              o = ((lane & 31) < 16) ? (x * c - xp * s) : (xp * s + x * c); }
          KR[(size_t)r * 64 + lane] = f2bf(o); }
        if (do_pool) {
            const int t = r % seqlen, seq0 = r - t;
#pragma unroll
            for (int j = 0; j < 4; ++j) {
                const int hw = 1 << j; const int lo = (t - hw) < 0 ? 0 : (t - hw); const int hi = (t + hw) > seqlen ? seqlen : (t + hw);
                const int c = j * 256 + lane * 4; float s0 = 0.f, s1 = 0.f, s2 = 0.f, s3 = 0.f;
#pragma unroll
                for (int k = 0; k < 2 * hw; ++k) {
                    const int tt = t - hw + k; const bool ok = tt >= 0 && tt < seqlen; const int tc = ok ? tt : t;
                    const u32x2 w = *(const u32x2*)(Z + (size_t)(seq0 + tc) * ZLD + ZC_P + c); const float m = ok ? 1.f : 0.f;
                    s0 += m * lo2f(w.x); s1 += m * hi2f(w.x); s2 += m * lo2f(w.y); s3 += m * hi2f(w.y); }
                const u32x2 me = *(const u32x2*)(zr + ZC_P + c); const float inv = 1.0f / (float)(hi - lo);
                *(unsigned*)((unsigned char*)PD + (size_t)r * 1024 + c) = pk4_fp8(s0 * inv - lo2f(me.x), s1 * inv - hi2f(me.x), s2 * inv - lo2f(me.y), s3 * inv - hi2f(me.y)); }
        }
    }
}

template <class Fill> struct GridSched { int nM, nN, G, c; Fill fill;
    DI bool next(int i, Unit& u) const { const long L = (long)i * G + c; if (L >= (long)nM * nN) return false; int pm, pn; pg8::tile_of((int)L, nM, nN, pm, pn); u.pm = pm; u.pn = pn; u.z = 0; u.sa = 0x7f7f7f7fu; fill(u); return true; } };
template <class Fill> DI GridSched<Fill> make_sched(int nM, int nN, Fill f) { GridSched<Fill> s{nM, nN, lgdim(), lbid(), f}; return s; }
template <class Fill> struct TripleSched { int nM, nN, G, c; Fill fill;
    DI bool next(int i, Unit& u) const { const long L = (long)(i / 3) * G + c; if (L >= (long)nM * nN) return false; int pm, pn; pg8::tile_of((int)L, nM, nN, pm, pn); u.pm = pm; u.pn = pn; u.z = i % 3; u.sa = 0x7f7f7f7fu; fill(u); return true; } };

DI bf16x8 pack8(const f32x16& x, int sp) { u32x4 p; p.x = pk2(x[8 * sp], x[8 * sp + 1]); p.y = pk2(x[8 * sp + 2], x[8 * sp + 3]); p.z = pk2(x[8 * sp + 4], x[8 * sp + 5]); p.w = pk2(x[8 * sp + 6], x[8 * sp + 7]);
    return __builtin_bit_cast(bf16x8, p); }
DI bf16x8 read_perm(const LAS unsigned char* p) {
    const s16x4 lo = *(const LAS s16x4*)p, hi = *(const LAS s16x4*)(p + 16);
    bf16x8 v; v[0] = lo[0]; v[1] = lo[1]; v[2] = lo[2]; v[3] = lo[3]; v[4] = hi[0]; v[5] = hi[1]; v[6] = hi[2]; v[7] = hi[3]; return v; }
DI void store8_bf16(bf16_t* p, const f32x4& a, const f32x4& b) { u32x4 w; w.x = pk2(a[0], a[1]); w.y = pk2(a[2], a[3]); w.z = pk2(b[0], b[1]); w.w = pk2(b[2], b[3]); *(u32x4*)p = w; }

DI void attn_item(LAS unsigned char* lds, const float2* rt, const bf16_t* Qp, int h, bool rope, int tq0,
                  const bf16_t* kn0, const bf16_t* kr0, const bf16_t* vt0, int ldv0, int nt0,
                  const bf16_t* kn1, const bf16_t* kr1, const bf16_t* vt1, int ldv1, int nt1, unsigned char* Op) {
    int tid = threadIdx.x; asm volatile("" : "+v"(tid));
    const int wid = tid >> 6, lane = tid & 63, ql = lane & 31, hh = lane >> 5;
    const bool grpB = __builtin_amdgcn_readfirstlane(wid) >= 4;
    constexpr int KPITCH = 400, VPITCH = 136, VOFF = 64 * KPITCH, BUFB = VOFF + 128 * VPITCH;
    constexpr float SL = 0.10411755f;
    bf16x8 qf[12];
    { const bf16_t* qrow = Qp + (size_t)(wid * 32 + ql) * 1536 + h * 192;
#pragma unroll
      for (int ks = 0; ks < 12; ++ks) qf[ks] = *(const bf16x8*)(qrow + ks * 16 + hh * 8); }
    if (rope) {
        const int t = tq0 + wid * 32 + ql; const int rp = t >> 6, cp = t & 63;
#pragma unroll
        for (int j = 0; j < 8; ++j) {
            float2 cs = rt[rp * 16 + 8 * hh + j]; float c = cs.x, s = cs.y;
            { const float x1 = bf2f((bf16_t)qf[8][j]), x2 = bf2f((bf16_t)qf[9][j]); qf[8][j] = (short)f2bf(x1 * c - x2 * s); qf[9][j] = (short)f2bf(x1 * s + x2 * c); }
            cs = rt[cp * 16 + 8 * hh + j]; c = cs.x; s = cs.y;
            { const float x1 = bf2f((bf16_t)qf[10][j]), x2 = bf2f((bf16_t)qf[11][j]); qf[10][j] = (short)f2bf(x1 * c - x2 * s); qf[11][j] = (short)f2bf(x1 * s + x2 * c); }
        }
    }
    f32x16 oacc[4];
#pragma unroll
    for (int db = 0; db < 4; ++db)
#pragma unroll
        for (int r = 0; r < 16; ++r) oacc[db][r] = 0.f;
    float m_run = -1e30f, l_run = 0.f;
    const int ntile = nt0 + nt1;
    u32x4 kst[3], vst[2];
    auto issueK = [&](int j) {
        const bool s1 = j >= nt0; const int key0 = (s1 ? j - nt0 : j) * 64;
        const bf16_t* kn = s1 ? kn1 : kn0; const bf16_t* kr = s1 ? kr1 : kr0;
#pragma unroll
        for (int i = 0; i < 2; ++i) { const int id = tid + 512 * i, key = id >> 4, c = id & 15;
            kst[i] = *(const u32x4*)(kn + (size_t)(key0 + key) * 1024 + h * 128 + c * 8); }
        { const int key = tid >> 3, c = tid & 7;
            kst[2] = *(const u32x4*)(kr + (size_t)(key0 + key) * 64 + c * 8); } };
    auto issueV = [&](int j) {
        const bool s1 = j >= nt0; const int key0 = (s1 ? j - nt0 : j) * 64;
        const bf16_t* vt = s1 ? vt1 : vt0; const int ldv = s1 ? ldv1 : ldv0;
#pragma unroll
        for (int i = 0; i < 2; ++i) { const int id = tid + 512 * i, d = id >> 3, c = id & 7;
            vst[i] = *(const u32x4*)(vt + (size_t)(h * 128 + d) * ldv + key0 + c * 8); } };
    auto commitK = [&](int buf) {
        LAS unsigned char* base = lds + buf * BUFB;
#pragma unroll
        for (int i = 0; i < 2; ++i) { const int id = tid + 512 * i, key = id >> 4, c = id & 15; *(LAS u32x4*)(base + key * KPITCH + c * 16) = kst[i]; }
        { const int key = tid >> 3, c = tid & 7; *(LAS u32x4*)(base + key * KPITCH + (16 + c) * 16) = kst[2]; } };
    auto commitV = [&](int buf) {
        LAS unsigned char* base = lds + buf * BUFB + VOFF;
#pragma unroll
        for (int i = 0; i < 2; ++i) { const int id = tid + 512 * i, d = id >> 3, c = id & 7; LAS u32x2* p = (LAS u32x2*)(base + d * VPITCH + c * 16);
            u32x2 a; a.x = vst[i].x; a.y = vst[i].y; u32x2 b; b.x = vst[i].z; b.y = vst[i].w; p[0] = a; p[1] = b; } };
    auto wgbar = [&]() { asm volatile("s_waitcnt lgkmcnt(0)" ::: "memory"); __builtin_amdgcn_s_barrier(); asm volatile("" ::: "memory"); };
    f32x16 s0, s1;
    auto scores = [&](int j) {
        const LAS unsigned char* Kb = lds + (j & 1) * BUFB;
#pragma unroll
        for (int r = 0; r < 16; ++r) { s0[r] = 0.f; s1[r] = 0.f; }
        const LAS unsigned char* kp0 = Kb + ql * KPITCH + hh * 16; const LAS unsigned char* kp1 = Kb + (32 + ql) * KPITCH + hh * 16;
        bf16x8 k0c = *(const LAS bf16x8*)kp0, k1c = *(const LAS bf16x8*)kp1;
#pragma unroll
        for (int ks = 0; ks < 12; ++ks) {
            bf16x8 k0n = k0c, k1n = k1c;
            if (ks < 11) { k0n = *(const LAS bf16x8*)(kp0 + (ks + 1) * 32); k1n = *(const LAS bf16x8*)(kp1 + (ks + 1) * 32); }
            __builtin_amdgcn_sched_barrier(0);
            s0 = __builtin_amdgcn_mfma_f32_32x32x16_bf16(k0c, qf[ks], s0, 0, 0, 0);
            s1 = __builtin_amdgcn_mfma_f32_32x32x16_bf16(k1c, qf[ks], s1, 0, 0, 0);
            __builtin_amdgcn_sched_barrier(0);
            k0c = k0n; k1c = k1n;
        }
        float mx = s0[0];
#pragma unroll
        for (int r = 0; r < 16; ++r) { mx = fmaxf(mx, s0[r]); mx = fmaxf(mx, s1[r]); }
        mx = fmaxf(mx, shx(mx, 32, lane));
        const bool grow = (mx - m_run) * SL > 8.0f;
        if (__builtin_amdgcn_ballot_w64(grow) != 0ull) {
            const float m_new = grow ? mx : m_run; const float alpha = exp2f((m_run - m_new) * SL); m_run = m_new;
            l_run *= alpha;
#pragma unroll
            for (int db = 0; db < 4; ++db)
#pragma unroll
                for (int r = 0; r < 16; ++r) oacc[db][r] *= alpha;
        }
    };
    auto pv = [&](int j) {
        { float ps = 0.f; const float mb = m_run * SL;
#pragma unroll
          for (int r = 0; r < 16; ++r) { s0[r] = exp2f(s0[r] * SL - mb); s1[r] = exp2f(s1[r] * SL - mb); ps += s0[r] + s1[r]; }
          l_run += ps; }
        const LAS unsigned char* vbase = lds + (j & 1) * BUFB + VOFF + ql * VPITCH + hh * 8;
        bf16x8 vc = read_perm(vbase);
#pragma unroll
        for (int it = 0; it < 16; ++it) {
            const int kb = it >> 3, sp = (it >> 2) & 1, db = it & 3;
            bf16x8 vn = vc;
            if (it < 15) { const int kb2 = (it + 1) >> 3, sp2 = ((it + 1) >> 2) & 1, db2 = (it + 1) & 3; vn = read_perm(vbase + db2 * 32 * VPITCH + (32 * kb2 + 16 * sp2) * 2); }
            const bf16x8 pf = pack8(kb == 0 ? s0 : s1, sp);
            __builtin_amdgcn_sched_barrier(0);
            if (db == 0) oacc[0] = __builtin_amdgcn_mfma_f32_32x32x16_bf16(vc, pf, oacc[0], 0, 0, 0);
            if (db == 1) oacc[1] = __builtin_amdgcn_mfma_f32_32x32x16_bf16(vc, pf, oacc[1], 0, 0, 0);
            if (db == 2) oacc[2] = __builtin_amdgcn_mfma_f32_32x32x16_bf16(vc, pf, oacc[2], 0, 0, 0);
            if (db == 3) oacc[3] = __builtin_amdgcn_mfma_f32_32x32x16_bf16(vc, pf, oacc[3], 0, 0, 0);
            __builtin_amdgcn_sched_barrier(0);
            vc = vn;
        }
    };
    issueK(0); issueV(0); commitK(0); commitV(0); wgbar();
    if (!grpB) {
        for (int m = 0; m < ntile; ++m) {
            if (m >= 1) commitV(m & 1);
            if (m + 1 < ntile) issueK(m + 1);
            scores(m);
            wgbar();
            if (m + 1 < ntile) { commitK((m + 1) & 1); issueV(m + 1); }
            pv(m);
            wgbar();
        }
        wgbar();
    } else {
        if (1 < ntile) issueK(1);
        wgbar();
        for (int m = 0; m < ntile; ++m) {
            if (m + 1 < ntile) { commitK((m + 1) & 1); issueV(m + 1); }
            scores(m);
            wgbar();
            if (m + 1 < ntile) commitV((m + 1) & 1);
            if (m + 2 < ntile) issueK(m + 2);
            pv(m);
            wgbar();
        }
    }
    const float linv = 4.0f / (l_run + shx(l_run, 32, lane));
    unsigned char* orow = Op + (size_t)(wid * 32 + ql) * 1024 + h * 128;
#pragma unroll
    for (int db = 0; db < 4; ++db)
#pragma unroll
        for (int g = 0; g < 4; ++g) *(unsigned*)(orow + db * 32 + g * 8 + hh * 4) = pk4_fp8(oacc[db][4 * g] * linv, oacc[db][4 * g + 1] * linv, oacc[db][4 * g + 2] * linv, oacc[db][4 * g + 3] * linv);
    __syncthreads();
}

DI void gla_item(LAS unsigned char* lds, const bf16_t* Zseq, int len, int h, int dir, const float* gw, const float* gb,
                 const float* Sin, float* Sout, bf16_t* Oseq) {
    constexpr int QP = 272, KDP = 144, VP = 144;
    LAS unsigned char* QE = lds; LAS unsigned char* KE = lds + 17408; LAS unsigned char* KDT = lds + 34816; LAS unsigned char* VT = lds + 53248;
    LAS float* LR = (LAS float*)(lds + 90112); LAS float* SEG = (LAS float*)(lds + 94208); LAS float* DEC = (LAS float*)(lds + 96256);
    int tid = threadIdx.x; asm volatile("" : "+v"(tid));
    const int wid = tid >> 6, lane = tid & 63, ql = lane & 31, hh = lane >> 5, d = tid & 127, part = tid >> 7;
    float gwr[16];
#pragma unroll
    for (int j = 0; j < 16; ++j) gwr[j] = gw[j * 512 + h * 128 + d];
    const float gbr = gb[h * 128 + d];
    f32x16 S[4];
#pragma unroll
    for (int db = 0; db < 4; ++db)
#pragma unroll
        for (int r = 0; r < 16; ++r) S[db][r] = Sin ? Sin[(size_t)(32 * db + (r & 3) + 8 * (r >> 2) + 4 * hh) * 256 + 32 * wid + ql] : 0.f;
    const int lrcol = dir ? ZC_LRB : ZC_LRF;
    for (int n0 = 0; n0 < len; n0 += 64) {
#pragma unroll
        for (int i = 0; i < 2; ++i) { const int e = tid + 512 * i, row = e >> 4, j = e & 15; const int t = dir ? len - 1 - (n0 + row) : n0 + row;
            LR[e] = bf2f(Zseq[(size_t)t * ZLD + lrcol + j]); }
#pragma unroll
        for (int i = 0; i < 4; ++i) { const int cidx = tid + 512 * i, row = cidx & 63, c8 = cidx >> 6; const int t = dir ? len - 1 - (n0 + row) : n0 + row;
            const u32x4 v = *(const u32x4*)(Zseq + (size_t)t * ZLD + ZC_V + h * 256 + c8 * 8);
            LAS bf16_t* vp = (LAS bf16_t*)(VT + (c8 * 8) * VP + row * 2);
            const unsigned v0 = v.x, v1 = v.y, v2 = v.z, v3 = v.w;
            vp[0 * (VP / 2)] = (bf16_t)v0; vp[1 * (VP / 2)] = (bf16_t)(v0 >> 16); vp[2 * (VP / 2)] = (bf16_t)v1; vp[3 * (VP / 2)] = (bf16_t)(v1 >> 16);
            vp[4 * (VP / 2)] = (bf16_t)v2; vp[5 * (VP / 2)] = (bf16_t)(v2 >> 16); vp[6 * (VP / 2)] = (bf16_t)v3; vp[7 * (VP / 2)] = (bf16_t)(v3 >> 16); }
        bf16_t qraw[16], kraw[16];
#pragma unroll
        for (int ii = 0; ii < 16; ++ii) { const int row = part * 16 + ii; const int t = dir ? len - 1 - (n0 + row) : n0 + row;
            qraw[ii] = Zseq[(size_t)t * ZLD + ZC_Q + h * 128 + d]; kraw[ii] = Zseq[(size_t)t * ZLD + ZC_K + h * 128 + d]; }
        __syncthreads();
        float bl[16]; float run = 0.f;
#pragma unroll
        for (int ii = 0; ii < 16; ++ii) { float z = gbr;
#pragma unroll
            for (int j = 0; j < 16; ++j) z += LR[(part * 16 + ii) * 16 + j] * gwr[j];
            run += (fminf(z, 0.f) - __logf(1.0f + __expf(-fabsf(z)))) * 0.0625f; bl[ii] = run; }
        SEG[part * 128 + d] = run;
        __syncthreads();
        float off = 0.f, blast = 0.f;
#pragma unroll
        for (int pp = 0; pp < 4; ++pp) { const float sg = SEG[pp * 128 + d]; off += (pp < part) ? sg : 0.f; blast += sg; }
        if (part == 0) DEC[d] = __expf(blast);
        unsigned kdp[8];
#pragma unroll
        for (int ii = 0; ii < 16; ++ii) { const int row = part * 16 + ii; const float b = off + bl[ii];
            const float qv = bf2f(qraw[ii]), kv = bf2f(kraw[ii]);
            *(LAS bf16_t*)(QE + row * QP + d * 2) = f2bf(qv * __expf(b));
            *(LAS bf16_t*)(KE + row * QP + d * 2) = f2bf(kv * __expf(-b));
            const unsigned kd = f2bf(kv * __expf(blast - b));
            if (ii & 1) kdp[ii >> 1] |= kd << 16; else kdp[ii >> 1] = kd; }
        { u32x4 a; a.x = kdp[0]; a.y = kdp[1]; a.z = kdp[2]; a.w = kdp[3]; u32x4 b; b.x = kdp[4]; b.y = kdp[5]; b.z = kdp[6]; b.w = kdp[7];
          *(LAS u32x4*)(KDT + d * KDP + part * 32) = a; *(LAS u32x4*)(KDT + d * KDP + part * 32 + 16) = b; }
        __syncthreads();
        f32x16 att00, att01, att11, o0, o1;
#pragma unroll
        for (int r = 0; r < 16; ++r) { att00[r] = 0.f; att01[r] = 0.f; att11[r] = 0.f; o0[r] = 0.f; o1[r] = 0.f; }
#pragma unroll
        for (int ks = 0; ks < 8; ++ks) {
            const int co = (ks * 16 + hh * 8) * 2;
            const bf16x8 kf0 = *(const LAS bf16x8*)(KE + ql * QP + co), kf1 = *(const LAS bf16x8*)(KE + (32 + ql) * QP + co);
            const bf16x8 qf0 = *(const LAS bf16x8*)(QE + ql * QP + co), qf1 = *(const LAS bf16x8*)(QE + (32 + ql) * QP + co);
            att00 = __builtin_amdgcn_mfma_f32_32x32x16_bf16(kf0, qf0, att00, 0, 0, 0);
            att01 = __builtin_amdgcn_mfma_f32_32x32x16_bf16(kf0, qf1, att01, 0, 0, 0);
            att11 = __builtin_amdgcn_mfma_f32_32x32x16_bf16(kf1, qf1, att11, 0, 0, 0);
            if (ks & 1) __builtin_amdgcn_sched_barrier(0);
        }
#pragma unroll
        for (int r = 0; r < 16; ++r) { const int srow = (r & 3) + 8 * (r >> 2) + 4 * hh; if (srow > ql) { att00[r] = 0.f; att11[r] = 0.f; } }
        const LAS unsigned char* vrow = VT + (32 * wid + ql) * VP + hh * 8;
#pragma unroll
        for (int sp = 0; sp < 2; ++sp) {
            const bf16x8 va = read_perm(vrow + (16 * sp) * 2), vb = read_perm(vrow + (32 + 16 * sp) * 2);
            o0 = __builtin_amdgcn_mfma_f32_32x32x16_bf16(va, pack8(att00, sp), o0, 0, 0, 0);
            o1 = __builtin_amdgcn_mfma_f32_32x32x16_bf16(va, pack8(att01, sp), o1, 0, 0, 0);
            o1 = __builtin_amdgcn_mfma_f32_32x32x16_bf16(vb, pack8(att11, sp), o1, 0, 0, 0);
        }
#pragma unroll
        for (int db = 0; db < 4; ++db)
#pragma unroll
            for (int sp = 0; sp < 2; ++sp) {
                const bf16x8 sa = pack8(S[db], sp);
                const int co = (32 * db + 16 * sp + 4 * hh) * 2;
                const bf16x8 qb0 = read_perm(QE + ql * QP + co), qb1 = read_perm(QE + (32 + ql) * QP + co);
                o0 = __builtin_amdgcn_mfma_f32_32x32x16_bf16(sa, qb0, o0, 0, 0, 0);
                o1 = __builtin_amdgcn_mfma_f32_32x32x16_bf16(sa, qb1, o1, 0, 0, 0);
                if (sp) __builtin_amdgcn_sched_barrier(0);
            }
#pragma unroll
        for (int db = 0; db < 4; ++db) {
#pragma unroll
            for (int g4 = 0; g4 < 4; ++g4) { const f32x4 dc = *(const LAS f32x4*)(DEC + 32 * db + 8 * g4 + 4 * hh);
#pragma unroll
                for (int i = 0; i < 4; ++i) S[db][4 * g4 + i] *= dc[i]; }
#pragma unroll
            for (int ks = 0; ks < 4; ++ks) {
                const bf16x8 af = *(const LAS bf16x8*)(KDT + (32 * db + ql) * KDP + (16 * ks + 8 * hh) * 2);
                const bf16x8 bv = *(const LAS bf16x8*)(VT + (32 * wid + ql) * VP + (16 * ks + 8 * hh) * 2);
                S[db] = __builtin_amdgcn_mfma_f32_32x32x16_bf16(af, bv, S[db], 0, 0, 0);
            }
            __builtin_amdgcn_sched_barrier(0);
        }
#pragma unroll
        for (int tb = 0; tb < 2; ++tb) { const int row = 32 * tb + ql; const int t = dir ? len - 1 - (n0 + row) : n0 + row;
            bf16_t* op = Oseq + (size_t)t * 1024 + h * 256 + 32 * wid + 4 * hh;
#pragma unroll
            for (int g4 = 0; g4 < 4; ++g4) { u32x2 w2;
                if (tb == 0) { w2.x = pk2(o0[4 * g4], o0[4 * g4 + 1]); w2.y = pk2(o0[4 * g4 + 2], o0[4 * g4 + 3]); }
                else { w2.x = pk2(o1[4 * g4], o1[4 * g4 + 1]); w2.y = pk2(o1[4 * g4 + 2], o1[4 * g4 + 3]); }
                *(u32x2*)(op + 8 * g4) = w2; } }
        __syncthreads();
    }
    if (Sout) {
#pragma unroll
        for (int db = 0; db < 4; ++db)
#pragma unroll
            for (int r = 0; r < 16; ++r) Sout[(size_t)(32 * db + (r & 3) + 8 * (r >> 2) + 4 * hh) * 256 + 32 * wid + ql] = S[db][r]; }
}

DI void phase_glafin(const bf16_t* OF, const bf16_t* OB, const bf16_t* Z, const float* gg, int rows, bf16_t* GF) {
    const int tid_ = ltid(); const int lane = tid_ & 63, wid = tid_ >> 6;
    const float4 g4 = *(const float4*)(gg + lane * 4);
    for (int r = lbid() * 8 + wid; r < rows; r += lgdim() * 8) {
#pragma unroll
        for (int h = 0; h < 4; ++h) {
            const int c = h * 256 + lane * 4;
            const u32x2 a = *(const u32x2*)(OF + (size_t)r * 1024 + c), b = *(const u32x2*)(OB + (size_t)r * 1024 + c), rr = *(const u32x2*)(Z + (size_t)r * ZLD + ZC_R + c);
            const float s0 = lo2f(a.x) + lo2f(b.x), s1 = hi2f(a.x) + hi2f(b.x), s2 = lo2f(a.y) + lo2f(b.y), s3 = hi2f(a.y) + hi2f(b.y);
            const float ss = wave_sum(s0 * s0 + s1 * s1 + s2 * s2 + s3 * s3, lane);
            const float rstd = rsqrtf(ss * (1.0f / 256.0f) + 1e-6f);
            const float r0 = lo2f(rr.x), r1 = hi2f(rr.x), r2 = lo2f(rr.y), r3 = hi2f(rr.y);
            *(unsigned*)((unsigned char*)GF + (size_t)r * 1024 + c) = pk4_fp8(s0 * rstd * g4.x * (r0 * sigmoidf_(r0)), s1 * rstd * g4.y * (r1 * sigmoidf_(r1)), s2 * rstd * g4.z * (r2 * sigmoidf_(r2)), s3 * rstd * g4.w * (r3 * sigmoidf_(r3)));
        }
    }
}

DI unsigned fkey(float f) { const unsigned u = __float_as_uint(f); return u ^ ((unsigned)((int)u >> 31) | 0x80000000u); }
DI float unfkey(unsigned k) { return __uint_as_float((k & 0x80000000u) ? (k ^ 0x80000000u) : ~k); }
DI void key_insert(unsigned (&t)[16], unsigned k) {
#pragma unroll
    for (int j = 0; j < 16; ++j) { const unsigned hi = t[j] > k ? t[j] : k; const unsigned lo = t[j] > k ? k : t[j]; t[j] = hi; k = lo; }
}
DI void phase_select(const _Float16* SC, int rows, uint2* ROUTE, unsigned short* EID, LAS unsigned char* lds) {
    const int tid_ = ltid(); const int lane = tid_ & 63, wid = tid_ >> 6;
    LAS float* T = (LAS float*)lds + wid * (64 * 65);
    for (int pbase = (lbid() * 8 + wid) * 64; pbase < rows * 8; pbase += lgdim() * 8 * 64) {
        const int p = pbase + lane;
        unsigned k1[16], k2[16];
#pragma unroll
        for (int j = 0; j < 16; ++j) { k1[j] = 0u; k2[j] = 0u; }
#pragma unroll
        for (int pass = 0; pass < 4; ++pass) {
#pragma unroll
            for (int k = 0; k < 8; ++k) { const int pp = 8 * k + (lane >> 3), c8 = lane & 7;
                const h16x8 v = *(const h16x8*)(SC + (size_t)(pbase + pp) * 256 + pass * 32 + (c8 & 3) * 8 + (c8 >> 2) * 128);
                LAS float* tp = T + (8 * c8) * 65 + pp;
#pragma unroll
                for (int c = 0; c < 8; ++c) tp[c * 65] = (float)v[c]; }
            for (int f = 0; f < 32; ++f) { const float va = T[f * 65 + lane], vb = T[(32 + f) * 65 + lane]; const unsigned ix = (unsigned)(127 - (pass * 32 + f));
                key_insert(k1, (fkey(va) & ~127u) | ix); key_insert(k2, (fkey(vb) & ~127u) | ix); }
        }
        float t1[16], t2[16]; unsigned i1p[4] = {0u, 0u, 0u, 0u}, i2p[4] = {0u, 0u, 0u, 0u};
#pragma unroll
        for (int j = 0; j < 16; ++j) { t1[j] = unfkey(k1[j] & ~127u); t2[j] = unfkey(k2[j] & ~127u);
            i1p[j >> 2] |= (127u - (k1[j] & 127u)) << (8 * (j & 3)); i2p[j >> 2] |= (127u - (k2[j] & 127u)) << (8 * (j & 3)); }
        unsigned kc[16];
#pragma unroll
        for (int j = 0; j < 16; ++j) kc[j] = 0u;
#pragma unroll
        for (int a = 0; a < 16; ++a)
#pragma unroll
            for (int b = 0; b < 16; ++b)
                if ((a + 1) * (b + 1) <= 16) key_insert(kc, (fkey(t1[a] + t2[b]) & ~255u) | (unsigned)(a * 16 + b));
        float e[16]; unsigned ei[16]; float mx = -3.0e38f;
#pragma unroll
        for (int j = 0; j < 16; ++j) { const unsigned a = (kc[j] >> 4) & 15u, b = kc[j] & 15u;
            const unsigned wa = (a >> 2) == 0u ? i1p[0] : (a >> 2) == 1u ? i1p[1] : (a >> 2) == 2u ? i1p[2] : i1p[3];
            const unsigned wb = (b >> 2) == 0u ? i2p[0] : (b >> 2) == 1u ? i2p[1] : (b >> 2) == 2u ? i2p[2] : i2p[3];
            ei[j] = (((wa >> (8 * (a & 3u))) & 127u) << 7) | ((wb >> (8 * (b & 3u))) & 127u);
            e[j] = unfkey(kc[j] & ~255u); mx = fmaxf(mx, e[j]); }
        float sum = 0.f;
#pragma unroll
        for (int j = 0; j < 16; ++j) { e[j] = __expf(e[j] - mx); sum += e[j]; }
        const float inv = 1.0f / sum;
        uint2* dst = ROUTE + (size_t)p * 16; unsigned short* de = EID + (size_t)p * 16;
#pragma unroll
        for (int j = 0; j < 16; ++j) { dst[j] = make_uint2(ei[j], __float_as_uint(e[j] * inv)); de[j] = (unsigned short)ei[j]; }
    }
}

DI float dot2u(unsigned a, unsigned b, float acc) { return __builtin_amdgcn_fdot2_f32_bf16(__builtin_bit_cast(bf16x2_t, a), __builtin_bit_cast(bf16x2_t, b), acc, false); }
DI float dot8(const u32x4& a, const u32x4& b, float acc) {
    const unsigned a0 = a.x, a1 = a.y, a2 = a.z, a3 = a.w, b0 = b.x, b1 = b.y, b2 = b.z, b3 = b.w;
    acc = dot2u(a0, b0, acc); acc = dot2u(a1, b1, acc); acc = dot2u(a2, b2, acc); acc = dot2u(a3, b3, acc);
    return acc;
}
template <int CTRL> DI float dppf(float v) { return __builtin_bit_cast(float, __builtin_amdgcn_update_dpp(0, __builtin_bit_cast(int, v), CTRL, 0xF, 0xF, true)); }
typedef float f32x2_t __attribute__((ext_vector_type(2)));
DI void phase_peer_u(const bf16_t* H2, const unsigned short* EID, const unsigned char* PU, int rows, float* PART) {
    const int tid_ = ltid(); const int lane = tid_ & 63, wid = tid_ >> 6, g = lane >> 3, pc = lane & 7;
    const int x = lbid() & 7, gw = (lbid() >> 3) * 8 + wid, nw = (lgdim() >> 3) * 8;
    const unsigned lbase = (unsigned)(x * 128 + pc * 16);
    auto meta = [&](int r, unsigned (&e)[8], u32x4& h0, u32x4& h1) {
        const int rr = r < rows ? r : rows - 1;
        const u32x4* hp = (const u32x4*)(H2 + (unsigned)(rr * 1024 + x * 128 + pc * 16)); h0 = hp[0]; h1 = hp[1];
        const u32x4* ep = (const u32x4*)(EID + (unsigned)(rr * 128 + g * 16)); const u32x4 t0 = ep[0], t1 = ep[1];
        e[0] = t0.x; e[1] = t0.y; e[2] = t0.z; e[3] = t0.w; e[4] = t1.x; e[5] = t1.y; e[6] = t1.z; e[7] = t1.w; };
    auto finish = [&](int r, const u32x4 (&uv)[16], const u32x4& h0, const u32x4& h1) {
        float hf[16];
        { const unsigned a0 = h0.x, a1 = h0.y, a2 = h0.z, a3 = h0.w, b0 = h1.x, b1 = h1.y, b2 = h1.z, b3 = h1.w;
          hf[0] = lo2f(a0); hf[1] = hi2f(a0); hf[2] = lo2f(a1); hf[3] = hi2f(a1); hf[4] = lo2f(a2); hf[5] = hi2f(a2); hf[6] = lo2f(a3); hf[7] = hi2f(a3);
          hf[8] = lo2f(b0); hf[9] = hi2f(b0); hf[10] = lo2f(b1); hf[11] = hi2f(b1); hf[12] = lo2f(b2); hf[13] = hi2f(b2); hf[14] = lo2f(b3); hf[15] = hi2f(b3); }
        float v0 = 0.f, v1 = 0.f;
#pragma unroll
        for (int j = 0; j < 16; ++j) {
            const unsigned w0 = uv[j].x, w1 = uv[j].y, w2 = uv[j].z, w3 = uv[j].w;
            float a = 0.f;
            { const f32x2_t l = __builtin_amdgcn_cvt_pk_f32_fp8((int)w0, false), hh2 = __builtin_amdgcn_cvt_pk_f32_fp8((int)w0, true); a += l[0] * hf[0] + l[1] * hf[1] + hh2[0] * hf[2] + hh2[1] * hf[3]; }
            { const f32x2_t l = __builtin_amdgcn_cvt_pk_f32_fp8((int)w1, false), hh2 = __builtin_amdgcn_cvt_pk_f32_fp8((int)w1, true); a += l[0] * hf[4] + l[1] * hf[5] + hh2[0] * hf[6] + hh2[1] * hf[7]; }
            { const f32x2_t l = __builtin_amdgcn_cvt_pk_f32_fp8((int)w2, false), hh2 = __builtin_amdgcn_cvt_pk_f32_fp8((int)w2, true); a += l[0] * hf[8] + l[1] * hf[9] + hh2[0] * hf[10] + hh2[1] * hf[11]; }
            { const f32x2_t l = __builtin_amdgcn_cvt_pk_f32_fp8((int)w3, false), hh2 = __builtin_amdgcn_cvt_pk_f32_fp8((int)w3, true); a += l[0] * hf[12] + l[1] * hf[13] + hh2[0] * hf[14] + hh2[1] * hf[15]; }
            a += dppf<0xB1>(a); a += dppf<0x4E>(a); a += dppf<0x141>(a);
            v0 = (j < 8 && pc == (j & 7)) ? a : v0; v1 = (j >= 8 && pc == (j & 7)) ? a : v1;
        }
        if (r < rows) { float* pp = PART + (unsigned)((r * 8 + x) * 128 + g * 16 + pc); pp[0] = v0 * 0.03125f; pp[8] = v1 * 0.03125f; } };
    unsigned eA[8], eB[8]; u32x4 hA0, hA1, hB0, hB1;
    meta(gw, eA, hA0, hA1); meta(gw + nw, eB, hB0, hB1);
    for (int r = gw; r < rows; r += 2 * nw) {
        u32x4 uA[16], uB[16];
#pragma unroll
        for (int j = 0; j < 16; ++j) uA[j] = *(const u32x4*)(PU + ((((j & 1) ? (eA[j >> 1] >> 16) : (eA[j >> 1] & 0xffffu)) << 10) + lbase));
#pragma unroll
        for (int j = 0; j < 16; ++j) uB[j] = *(const u32x4*)(PU + ((((j & 1) ? (eB[j >> 1] >> 16) : (eB[j >> 1] & 0xffffu)) << 10) + lbase));
        const u32x4 cA0 = hA0, cA1 = hA1, cB0 = hB0, cB1 = hB1;
        meta(r + 2 * nw, eA, hA0, hA1); meta(r + 3 * nw, eB, hB0, hB1);
        finish(r, uA, cA0, cA1); finish(r + nw, uB, cB0, cB1);
    }
}
DI void phase_peer_w(const float* PART, const uint2* ROUTE, int rows, bf16_t* WG) {
    const int tid_ = ltid(); const int lane = tid_ & 63, wid = tid_ >> 6;
    for (int r = lbid() * 8 + wid; r < rows; r += lgdim() * 8) {
        float a0 = 0.f, a1 = 0.f;
#pragma unroll
        for (int x = 0; x < 8; ++x) { const float* pp = PART + ((size_t)r * 8 + x) * 128; a0 += pp[lane]; a1 += pp[64 + lane]; }
        const float g0 = __uint_as_float(ROUTE[(size_t)r * 128 + lane].y), g1 = __uint_as_float(ROUTE[(size_t)r * 128 + 64 + lane].y);
        WG[(size_t)r * 128 + lane] = f2bf(g0 * 0.5f * a0 * (1.0f + erff(a0 * 0.70710678118654752f)));
        WG[(size_t)r * 128 + 64 + lane] = f2bf(g1 * 0.5f * a1 * (1.0f + erff(a1 * 0.70710678118654752f)));
    }
}
DI void phase_peer_v(const bf16_t* WG, const unsigned short* EID, const unsigned char* PV, const float* mod, int is_ctx, int b0, int rows, bf16_t* X, bool dry) {
    const int tid_ = ltid(); const int lane = tid_ & 63, wid = tid_ >> 6, g = lane >> 3, pc = lane & 7;
    const int x = lbid() & 7, gw = (lbid() >> 3) * 8 + wid, nw = (lgdim() >> 3) * 8;
    const unsigned lbase = (unsigned)(x * 128 + pc * 16);
    const int mydim = x * 128 + pc * 16 + 8 * ((lane >> 5) & 1) + 4 * ((lane >> 4) & 1) + 2 * ((lane >> 3) & 1);
    auto meta = [&](int r, unsigned (&e)[8]) {
        const int rr = r < rows ? r : rows - 1;
        const u32x4* ep = (const u32x4*)(EID + (unsigned)(rr * 128 + g * 16)); const u32x4 t0 = ep[0], t1 = ep[1];
        e[0] = t0.x; e[1] = t0.y; e[2] = t0.z; e[3] = t0.w; e[4] = t1.x; e[5] = t1.y; e[6] = t1.z; e[7] = t1.w; };
    auto wload = [&](int r, unsigned (&w)[8]) {
        const int rr = r < rows ? r : rows - 1;
        const u32x4* wp = (const u32x4*)(WG + (unsigned)(rr * 128 + g * 16)); const u32x4 t0 = wp[0], t1 = wp[1];
        w[0] = t0.x; w[1] = t0.y; w[2] = t0.z; w[3] = t0.w; w[4] = t1.x; w[5] = t1.y; w[6] = t1.z; w[7] = t1.w; };
    auto finish = [&](int r, const u32x4 (&vv)[16], const unsigned (&w)[8]) {
        float o[16];
#pragma unroll
        for (int i = 0; i < 16; ++i) o[i] = 0.f;
#pragma unroll
        for (int j = 0; j < 16; ++j) { const unsigned w0 = vv[j].x, w1 = vv[j].y, w2 = vv[j].z, w3 = vv[j].w; const float wj = (j & 1) ? hi2f(w[j >> 1]) : lo2f(w[j >> 1]);
            { const f32x2_t l = __builtin_amdgcn_cvt_pk_f32_fp8((int)w0, false), h2 = __builtin_amdgcn_cvt_pk_f32_fp8((int)w0, true); o[0] += wj * l[0]; o[1] += wj * l[1]; o[2] += wj * h2[0]; o[3] += wj * h2[1]; }
            { const f32x2_t l = __builtin_amdgcn_cvt_pk_f32_fp8((int)w1, false), h2 = __builtin_amdgcn_cvt_pk_f32_fp8((int)w1, true); o[4] += wj * l[0]; o[5] += wj * l[1]; o[6] += wj * h2[0]; o[7] += wj * h2[1]; }
            { const f32x2_t l = __builtin_amdgcn_cvt_pk_f32_fp8((int)w2, false), h2 = __builtin_amdgcn_cvt_pk_f32_fp8((int)w2, true); o[8] += wj * l[0]; o[9] += wj * l[1]; o[10] += wj * h2[0]; o[11] += wj * h2[1]; }
            { const f32x2_t l = __builtin_amdgcn_cvt_pk_f32_fp8((int)w3, false), h2 = __builtin_amdgcn_cvt_pk_f32_fp8((int)w3, true); o[12] += wj * l[0]; o[13] += wj * l[1]; o[14] += wj * h2[0]; o[15] += wj * h2[1]; } }
        float k8[8], k4[4], k2[2];
#pragma unroll
        for (int i = 0; i < 8; ++i) { const bool up = (lane & 32) != 0; const float send = up ? o[i] : o[i + 8]; k8[i] = (up ? o[i + 8] : o[i]) + shx(send, 32, lane); }
#pragma unroll
        for (int i = 0; i < 4; ++i) { const bool up = (lane & 16) != 0; const float send = up ? k8[i] : k8[i + 4]; k4[i] = (up ? k8[i + 4] : k8[i]) + shx(send, 16, lane); }
#pragma unroll
        for (int i = 0; i < 2; ++i) { const bool up = (lane & 8) != 0; const float send = up ? k4[i] : k4[i + 2]; k2[i] = (up ? k4[i + 2] : k4[i]) + dppf<0x128>(send); }
        if (dry && k2[0] != 12345.678f) return;
        if (r < rows) {
            const int bi = is_ctx ? 32 : b0 + (r >> 11);
            const float2 m = *(const float2*)(mod + (unsigned)(bi * 6144 + 5 * 1024 + mydim));
            unsigned* xr = (unsigned*)(X + (unsigned)(r * 1024 + mydim)); const unsigned xw = *xr; *xr = pk2(lo2f(xw) + m.x * k2[0], hi2f(xw) + m.y * k2[1]);
        } };
    unsigned eA[8];
    meta(gw, eA);
    for (int r = gw; r < rows; r += nw) {
        u32x4 vA[16]; unsigned wA[8];
#pragma unroll
        for (int j = 0; j < 16; ++j) vA[j] = *(const u32x4*)(PV + ((((j & 1) ? (eA[j >> 1] >> 16) : (eA[j >> 1] & 0xffffu)) << 10) + lbase));
        wload(r, wA);
        meta(r + nw, eA);
        finish(r, vA, wA);
    }
}

DI void phase_final(const bf16_t* xb, float* out, const float* gain, int rows) {
    const int tid_ = ltid(); const int lane = tid_ & 63, wid = tid_ >> 6;
    for (int r = lbid() * 8 + wid; r < rows; r += lgdim() * 8) {
        float4 v[4]; float ss = 0.f;
#pragma unroll
        for (int j = 0; j < 4; ++j) { const u32x2 w = ((const u32x2*)(xb + (size_t)r * 1024))[lane + 64 * j]; v[j] = make_float4(lo2f(w.x), hi2f(w.x), lo2f(w.y), hi2f(w.y));
            ss += v[j].x * v[j].x + v[j].y * v[j].y + v[j].z * v[j].z + v[j].w * v[j].w; }
        ss = wave_sum(ss, lane);
        const float rstd = rsqrtf(ss * (1.0f / 1024.0f) + 1e-6f);
        float4* orow = (float4*)(out + (size_t)r * 1024);
#pragma unroll
        for (int j = 0; j < 4; ++j) { const float4 g = *(const float4*)(gain + (lane + 64 * j) * 4);
            float4 o; o.x = v[j].x * rstd * g.x; o.y = v[j].y * rstd * g.y; o.z = v[j].z * rstd * g.z; o.w = v[j].w * rstd * g.w; orow[lane + 64 * j] = o; }
    }
}

enum { PH_NORM1 = 0, PH_INPROJ, PH_PREP, PH_UPPROJ, PH_MIX, PH_INPROJ2, PH_GLAFIN, PH_BRANCH, PH_WOUT, PH_NORM2, PH_WQ, PH_SELECT, PH_PEERU, PH_PEERW, PH_PEERV, PH_COUNT };

struct RunArgs { int mode;
                 int layer, chunk, phase; };

struct Bufs { bf16_t *H, *Z, *QB, *KN, *VT, *KR, *OF, *OB, *MLA, *PD, *PO, *GF, *MMB, *PQ; float *RS, *MMF, *CST, *PART; _Float16* SC; bf16_t* WG; unsigned short* EID; uint2* ROUTE; const bf16_t* W; const float* mod; unsigned* ctl; };
DI Bufs make_bufs(const Params& P, int is_ctx, int layer) {
    __attribute__((address_space(1))) unsigned char* gws = (__attribute__((address_space(1))) unsigned char*)P.ws; asm volatile("" : "+s"(gws));
    unsigned char* ws = (unsigned char*)gws; asm volatile("" : "+s"(layer));
    Bufs B;
    B.H = (bf16_t*)(ws + WS_H); B.Z = (bf16_t*)(ws + WS_Z); B.QB = (bf16_t*)(ws + WS_QB);
    B.KN = (bf16_t*)(ws + (is_ctx ? WS_CKN : WS_KN)); B.VT = (bf16_t*)(ws + (is_ctx ? WS_CVT : WS_VT)); B.KR = (bf16_t*)(ws + (is_ctx ? WS_CKR : WS_KR));
    B.RS = (float*)(ws + WS_RS); B.OF = (bf16_t*)(ws + WS_OF); B.OB = (bf16_t*)(ws + WS_OB); B.MLA = (bf16_t*)(ws + WS_MLA);
    B.PD = (bf16_t*)(ws + WS_PD); B.PO = (bf16_t*)(ws + WS_PO); B.GF = B.PO; B.MMF = (float*)(ws + WS_OF); B.MMB = (bf16_t*)(ws + WS_VT);
    B.PQ = B.QB; B.SC = (_Float16*)(ws + WS_Z); B.ROUTE = (uint2*)(ws + WS_ROUTE); B.PART = (float*)(ws + WS_Z + 128 * MiB); B.WG = (bf16_t*)(ws + WS_Z + 192 * MiB); B.EID = (unsigned short*)(ws + WS_Z + 200 * MiB); B.CST = (float*)(ws + WS_CST);
    B.W = (const bf16_t*)(ws + WS_W) + (size_t)layer * W_LAYER; B.mod = (const float*)(ws + WS_MOD) + (size_t)layer * 33 * 6144; B.ctl = (unsigned*)(ws + WS_CTL);
    return B;
}

DI Params kparams() {
    Params P;
#if defined(__HIP_DEVICE_COMPILE__)
    typedef const void* cvp; typedef const __attribute__((address_space(1))) void* gvp;
    const __attribute__((address_space(4))) gvp* q = (const __attribute__((address_space(4))) gvp*)__builtin_amdgcn_kernarg_segment_ptr();
    asm volatile("" : "+s"(q));
#pragma unroll
    for (int i = 0; i < (int)(sizeof(Params) / sizeof(void*)); ++i) ((cvp*)&P)[i] = (cvp)q[i];
#endif
    return P;
}

__global__ void __launch_bounds__(NTHR, 2) fwd_kernel(Params Pk, RunArgs R) {
    extern __shared__ __attribute__((aligned(16))) unsigned char smem[];
    LAS unsigned char* lds = (LAS unsigned char*)smem;
    LAS unsigned* ctlw = (LAS unsigned*)(lds + LDS_BYTES - 64);
    unsigned* ctl = (unsigned*)(Pk.ws + WS_CTL);
    if (threadIdx.x == 0) { ctlw[0] = 0u; ctlw[1] = 0u; ctlw[2] = 0u; ctlw[3] = 0u; }
    __syncthreads();
    XcdBarrier bar; bar.bar = ctl; bar.x = 0; bar.st = (volatile LAS unsigned*)ctlw;
    const bool single = (R.mode == 0);
    if (single) bar = xcd_barrier_post(ctl, (volatile LAS unsigned*)ctlw);
#define GRID_SYNC() do { if (single) xcd_barrier(bar); } while (0)

    if (R.mode == 0 || R.mode == 1) for (int rep_ = 0; rep_ < ((REP_PHASE) == 100 ? 2 : 1); ++rep_) { const Params P = kparams(); phase_convert(P, lds); phase_mod(P, lds); __syncthreads(); }
    GRID_SYNC();

    if (R.mode == 0 || R.mode == 2) {
    const int l_lo = single ? 0 : R.layer, l_hi = single ? NLAYER : R.layer + 1;
    const int c_lo = single ? 0 : R.chunk, c_hi = single ? 5 : R.chunk + 1;
    for (int layer = l_lo; layer < l_hi; ++layer)
    for (int ci = c_lo; ci < c_hi; ++ci) {
        const bool is_ctx = (ci == 0);
        const bool ctx_kv_only = is_ctx && layer == NLAYER - 1;
#define RUN(ph) (single || lnd(R.phase) == (ph))
#define REP(ph) for (int rep_ = 0; rep_ < (((REP_PHASE) == (ph) || (REP_PHASE) == 999) ? 2 : 1); ++rep_)
#define PHASE_LOCALS const Params P = kparams(); const Chunk ck = make_chunk(P, layer, ci); const Bufs B = make_bufs(P, ck.is_ctx, layer); const int rows = ck.rows, np = ck.np; (void)rows; (void)np;

        if ((REP_PHASE) == 200) { for (int xb = 0; xb < 10; ++xb) GRID_SYNC(); }
        if (RUN(PH_NORM1)) REP(PH_NORM1) { PHASE_LOCALS if (layer == 0) phase_norm<true, true>(ck.x32, rows, P.norm1_g + layer * 1024, B.mod, ck.is_ctx, ck.b0, 0, B.H); else phase_norm<false, true>(ck.xb, rows, P.norm1_g + layer * 1024, B.mod, ck.is_ctx, ck.b0, 0, B.H); }
        GRID_SYNC();
        if (RUN(PH_INPROJ)) REP(PH_INPROJ) { PHASE_LOCALS
            const bf16_t* H = B.H; const bf16_t* W = B.W; bf16_t* Z = B.Z;
            auto S = make_sched(np, 15, [=](Unit& u) { u.pn = (u.pn < 12) ? u.pn : u.pn + 16;
                u.A = (const char*)H + (size_t)u.pm * 256 * 1024; u.B = (const char*)(W + WO_IN) + (size_t)u.pn * 256 * 1024; });
            pg8::gemm_phase<1>(lds, 1024, 1024, 1024, S, [=](const f32x4 (&acc)[2][2][4][2], const Unit& u, int wr, int wc, int fr, int fq) {
                const bool is_gate = false;
                pg8::epi8(acc, wr, wc, fr, fq, [&](int row, int col, const f32x4& a, const f32x4& b) {
                    f32x4 a2 = a, b2 = b;
                    if (is_gate) {
#pragma unroll
                        for (int j = 0; j < 4; ++j) { a2[j] = sigmoidf_(a[j]); b2[j] = sigmoidf_(b[j]); } }
                    store8_bf16(Z + (size_t)(u.pm * 256 + row) * ZLD + u.pn * 256 + col, a2, b2); }); });
        }
        GRID_SYNC();
        if (RUN(PH_PREP)) REP(PH_PREP) { PHASE_LOCALS phase_prep(B.Z, rows, ck.is_ctx, B.RS, B.KR, B.PD, !ctx_kv_only, (const float2*)(P.ws + WS_ROPE)); }
        GRID_SYNC();
        if (RUN(PH_UPPROJ)) REP(PH_UPPROJ) {
            if (!ctx_kv_only) { PHASE_LOCALS
                const bf16_t* Z = B.Z; const bf16_t* W = B.W; bf16_t* QB = B.QB; const float* RS = B.RS;
                auto S = make_sched(np, 6, [=](Unit& u) { u.A = (const char*)(Z + (size_t)u.pm * 256 * ZLD + ZC_QDN); u.B = (const char*)(W + WO_UQ + (size_t)u.pn * 256 * 384); });
                pg8::gemm_phase<2>(lds, ZLD, 384, 384, S, [=](const f32x4 (&acc)[2][2][4][2], const Unit& u, int wr, int wc, int fr, int fq) {
                    pg8::epi8(acc, wr, wc, fr, fq, [&](int row, int col, const f32x4& a, const f32x4& b) { const int gr = u.pm * 256 + row; const float s = RS[gr];
                        store8_bf16(QB + (size_t)gr * 1536 + u.pn * 256 + col, a * s, b * s); }); });
            }
            { PHASE_LOCALS
                const bf16_t* Z = B.Z; const bf16_t* W = B.W; bf16_t* KN = B.KN; const float* RS = B.RS;
                auto S = make_sched(np, 4, [=](Unit& u) { u.A = (const char*)(Z + (size_t)u.pm * 256 * ZLD + ZC_KVDN); u.B = (const char*)(W + WO_KN + (size_t)u.pn * 256 * 256); });
                pg8::gemm_phase<2>(lds, ZLD, 256, 256, S, [=](const f32x4 (&acc)[2][2][4][2], const Unit& u, int wr, int wc, int fr, int fq) {
                    pg8::epi8(acc, wr, wc, fr, fq, [&](int row, int col, const f32x4& a, const f32x4& b) { const int gr = u.pm * 256 + row; const float s = RS[16384 + gr];
                        store8_bf16(KN + (size_t)gr * 1024 + u.pn * 256 + col, a * s, b * s); }); });
            }
            { PHASE_LOCALS
                const bf16_t* Z = B.Z; const bf16_t* W = B.W; bf16_t* VT = B.VT; const float* RS = B.RS;
                auto S = make_sched(4, np, [=](Unit& u) { u.A = (const char*)(W + WO_V + (size_t)u.pm * 256 * 256); u.B = (const char*)(Z + (size_t)u.pn * 256 * ZLD + ZC_KVDN); });
                pg8::gemm_phase<2>(lds, 256, ZLD, 256, S, [=](const f32x4 (&acc)[2][2][4][2], const Unit& u, int wr, int wc, int fr, int fq) {
                    pg8::epi8(acc, wr, wc, fr, fq, [&](int row, int col, const f32x4& a, const f32x4& b) { const int tk = u.pn * 256 + col;
                        const f32x4 r0 = *(const f32x4*)(RS + 16384 + tk), r1 = *(const f32x4*)(RS + 16384 + tk + 4);
                        store8_bf16(VT + (size_t)(u.pm * 256 + row) * rows + tk, a * r0, b * r1); }); });
            }
        }
        GRID_SYNC();
        if (RUN(PH_MIX)) for (int rep_ = 0; rep_ < (((REP_PHASE) == PH_MIX || (REP_PHASE) == 201 || (REP_PHASE) == 202 || (REP_PHASE) == 999) ? 2 : 1); ++rep_) { PHASE_LOCALS
            const int nbat = ck.is_ctx ? NB : 8;
            const int nG = (rep_ != 0 && (REP_PHASE) == 202) ? 0 : nbat * 8;
            const int nA = (rep_ != 0 && (REP_PHASE) == 201) ? 0 : (ck.is_ctx ? (layer == 0 ? NB * 8 : 0) : 8 * 8 * 8);
            unsigned* ctr = B.ctl + CTL_WORKQ + 64 * (layer * 5 + ci) + 64 * 16 * rep_;
            const int seqlen = ck.is_ctx ? TC : TL;
            for (;;) {
                if (ltid() == 0) ctlw[4] = xb_add(ctr, 1u);
                __syncthreads();
                const int item = (int)ctlw[4];
                __syncthreads();
                if (item >= nG + nA) break;
                if (item < nG) {
                    const int dir = item & 1, h = (item >> 1) & 3, bl = item >> 3;
                    const int b = ck.b0 + bl;
                    float* st = B.CST + (size_t)((b * 4 + h) * 2 + dir) * 128 * 256;
                    gla_item(lds, B.Z + (size_t)bl * seqlen * ZLD, seqlen, h, dir, P.gla_gate_w + ((size_t)layer * 2 + dir) * 16 * 512, P.gla_gate_b + ((size_t)layer * 2 + dir) * 512,
                             ck.is_ctx ? nullptr : st, ck.is_ctx ? st : nullptr, (dir ? B.OB : B.OF) + (size_t)bl * seqlen * 1024);
                } else {
                    const int a = item - nG;
                    int h, nt0, nt1, ldv0, tq0; bool rope; const bf16_t *Qp, *kn0, *kr0, *vt0, *kn1, *kr1, *vt1; unsigned char* Op;
                    if (ck.is_ctx) {
                        h = a & 7; const int bl = a >> 3; rope = false; tq0 = 0;
                        Qp = B.QB + (size_t)bl * TC * 1536; kn0 = B.KN + (size_t)bl * TC * 1024; kr0 = B.KR + (size_t)bl * TC * 64; vt0 = B.VT + (size_t)bl * TC; ldv0 = rows; nt0 = TC / 64;
                        kn1 = kn0; kr1 = kr0; vt1 = vt0; nt1 = 0; Op = (unsigned char*)B.MLA + (size_t)bl * TC * 1024;
                    } else {
                        const int qb = a & 7; h = (a >> 3) & 7; const int bl = a >> 6; const int b = ck.b0 + bl; rope = true; tq0 = qb * 256;
                        const bf16_t* CKN = (const bf16_t*)(P.ws + WS_CKN); const bf16_t* CKR = (const bf16_t*)(P.ws + WS_CKR); const bf16_t* CVT = (const bf16_t*)(P.ws + WS_CVT);
                        Qp = B.QB + (size_t)(bl * TL + qb * 256) * 1536; kn0 = CKN + (size_t)b * TC * 1024; kr0 = CKR + (size_t)b * TC * 64; vt0 = CVT + (size_t)b * TC; ldv0 = NB * TC; nt0 = TC / 64;
                        kn1 = B.KN + (size_t)bl * TL * 1024; kr1 = B.KR + (size_t)bl * TL * 64; vt1 = B.VT + (size_t)bl * TL; nt1 = TL / 64; Op = (unsigned char*)B.MLA + (size_t)(bl * TL + qb * 256) * 1024;
                    }
                    attn_item(lds, (const float2*)(P.ws + WS_ROPE), Qp, h, rope, tq0, kn0, kr0, vt0, ldv0, nt0, kn1, kr1, vt1, rows, nt1, Op);
                }
            }
        }
        GRID_SYNC();
        if (!ctx_kv_only) {
        if (RUN(PH_INPROJ2)) REP(PH_INPROJ2) { PHASE_LOCALS
            const bf16_t* H = B.H; const bf16_t* W = B.W; bf16_t* Z = B.Z;
            auto S = make_sched(np, 16, [=](Unit& u) { u.pn += 12; u.A = (const char*)H + (size_t)u.pm * 256 * 1024; u.B = (const char*)(W + WO_IN) + (size_t)u.pn * 256 * 1024; });
            pg8::gemm_phase<1>(lds, 1024, 1024, 1024, S, [=](const f32x4 (&acc)[2][2][4][2], const Unit& u, int wr, int wc, int fr, int fq) {
                const bool is_gate = (u.pn >= ZC_GZ / 256);
                pg8::epi8(acc, wr, wc, fr, fq, [&](int row, int col, const f32x4& a, const f32x4& b) {
                    f32x4 a2 = a, b2 = b;
                    if (is_gate) {
#pragma unroll
                        for (int j = 0; j < 4; ++j) { a2[j] = sigmoidf_(a[j]); b2[j] = sigmoidf_(b[j]); } }
                    store8_bf16(Z + (size_t)(u.pm * 256 + row) * ZLD + u.pn * 256 + col, a2, b2); }); });
        }
        GRID_SYNC();
        if (RUN(PH_GLAFIN)) REP(PH_GLAFIN) { PHASE_LOCALS phase_glafin(B.OF, B.OB, B.Z, P.gla_norm_g + layer * 256, rows, B.GF); }
        GRID_SYNC();
        if (RUN(PH_BRANCH)) REP(PH_BRANCH) { PHASE_LOCALS
            const bf16_t* PO = B.PD; const bf16_t* GF = B.GF; const bf16_t* MLA = B.MLA; const bf16_t* W = B.W; const bf16_t* Z = B.Z; bf16_t* MMS = (bf16_t*)B.MMF; bf16_t* MMB = B.MMB;
            auto fill = [=](Unit& u) { const bf16_t* a = (u.z == 0) ? PO : (u.z == 1) ? GF : MLA;   u.A = (const char*)a + (size_t)u.pm * 256 * 1024;
                                       u.B = (const char*)(W + WO_BR) + (size_t)u.z * 1048576 + (size_t)u.pn * 256 * 1024; u.sa = (u.z == 2) ? 0x7d7d7d7du : 0x7f7f7f7fu; };
            TripleSched<decltype(fill)> S{np, 4, lgdim(), lbid(), fill};
            pg8::gemm_phase<1>(lds, 1024, 1024, 1024, S, [=](const f32x4 (&acc)[2][2][4][2], const Unit& u, int wr, int wc, int fr, int fq) {
                pg8::epi8(acc, wr, wc, fr, fq, [&](int row, int col, const f32x4& a, const f32x4& b) {
                    const int gr = u.pm * 256 + row, c = u.pn * 256 + col;
                    const u32x4 gz = *(const u32x4*)(Z + (size_t)gr * ZLD + ZC_GZ + u.z * 1024 + c);
                    f32x4 va, vb;
                    va[0] = a[0] * lo2f(gz.x); va[1] = a[1] * hi2f(gz.x); va[2] = a[2] * lo2f(gz.y); va[3] = a[3] * hi2f(gz.y);
                    vb[0] = b[0] * lo2f(gz.z); vb[1] = b[1] * hi2f(gz.z); vb[2] = b[2] * lo2f(gz.w); vb[3] = b[3] * hi2f(gz.w);
                    bf16_t* mp = MMS + (size_t)gr * 1024 + c;
                    if (u.z != 0) { const u32x4 pm = *(const u32x4*)mp;
                        va[0] += lo2f(pm.x); va[1] += hi2f(pm.x); va[2] += lo2f(pm.y); va[3] += hi2f(pm.y); vb[0] += lo2f(pm.z); vb[1] += hi2f(pm.z); vb[2] += lo2f(pm.w); vb[3] += hi2f(pm.w); }
                    if (u.z == 2) { u32x2 w8; w8.x = pk4_fp8(va[0], va[1], va[2], va[3]); w8.y = pk4_fp8(vb[0], vb[1], vb[2], vb[3]); *(u32x2*)((unsigned char*)MMB + (size_t)gr * 1024 + c) = w8; }
                    else store8_bf16(mp, va, vb); }); });
        }
        GRID_SYNC();
        if (RUN(PH_WOUT)) for (int rep_ = 0; rep_ < (((REP_PHASE) == PH_WOUT || (REP_PHASE) == 999) && layer == 0 ? 2 : 1); ++rep_) { PHASE_LOCALS
            const bf16_t* MMB = B.MMB; const bf16_t* W = B.W; const float* mod = B.mod;
            auto S = make_sched(np, 4, [=](Unit& u) { u.A = (const char*)MMB + (size_t)u.pm * 256 * 1024; u.B = (const char*)(W + WO_OUT) + (size_t)u.pn * 256 * 1024; });
            const float* x32 = ck.x32; bf16_t* xb = ck.xb; const int isc = ck.is_ctx, b0 = ck.b0;
            pg8::gemm_phase<1>(lds, 1024, 1024, 1024, S, [=](const f32x4 (&acc)[2][2][4][2], const Unit& u, int wr, int wc, int fr, int fq) {
                const int bi = isc ? 32 : b0 + (u.pm >> 3);
                const float* g1 = mod + (size_t)bi * 6144 + 2 * 1024;
                pg8::epi8(acc, wr, wc, fr, fq, [&](int row, int col, const f32x4& a, const f32x4& b) {
                    const int c = u.pn * 256 + col; const size_t o = (size_t)(u.pm * 256 + row) * 1024 + c;
                    const f32x4 ga = *(const f32x4*)(g1 + c), gb = *(const f32x4*)(g1 + c + 4);
                    f32x4 xa, xv;
                    if (x32) { xa = *(const f32x4*)(x32 + o); xv = *(const f32x4*)(x32 + o + 4); }
                    else { const u32x4 w = *(const u32x4*)(xb + o); xa[0] = lo2f(w.x); xa[1] = hi2f(w.x); xa[2] = lo2f(w.y); xa[3] = hi2f(w.y); xv[0] = lo2f(w.z); xv[1] = hi2f(w.z); xv[2] = lo2f(w.w); xv[3] = hi2f(w.w); }
                    store8_bf16(xb + o, xa + ga * a, xv + gb * b); }); });
        }
        GRID_SYNC();
        if (RUN(PH_NORM2)) REP(PH_NORM2) { PHASE_LOCALS phase_norm<false, false>(ck.xb, rows, P.norm2_g + layer * 1024, B.mod, ck.is_ctx, ck.b0, 3, B.H); }
        GRID_SYNC();
        if (RUN(PH_WQ)) REP(PH_WQ) { PHASE_LOCALS
            const bf16_t* H = B.H; const bf16_t* W = B.W; _Float16* SC = B.SC;
            auto S = make_sched(np, 8, [=](Unit& u) { u.A = (const char*)(H + (size_t)u.pm * 256 * 1024); u.B = (const char*)(W + WO_Q + (size_t)u.pn * 256 * 1024); });
            pg8::gemm_phase<2>(lds, 1024, 1024, 1024, S, [=](const f32x4 (&acc)[2][2][4][2], const Unit& u, int wr, int wc, int fr, int fq) {
                pg8::epi8(acc, wr, wc, fr, fq, [&](int row, int col, const f32x4& a, const f32x4& b) {
                    h16x8 hv; hv[0] = (_Float16)a[0]; hv[1] = (_Float16)a[1]; hv[2] = (_Float16)a[2]; hv[3] = (_Float16)a[3]; hv[4] = (_Float16)b[0]; hv[5] = (_Float16)b[1]; hv[6] = (_Float16)b[2]; hv[7] = (_Float16)b[3];
                    *(h16x8*)(SC + (size_t)(u.pm * 256 + row) * 2048 + u.pn * 256 + col) = hv; }); });
        }
        GRID_SYNC();
        if (RUN(PH_SELECT)) REP(PH_SELECT) { PHASE_LOCALS phase_select(B.SC, rows, B.ROUTE, B.EID, lds); }
        GRID_SYNC();
        if (RUN(PH_PEERU)) REP(PH_PEERU) { PHASE_LOCALS phase_peer_u(B.H, B.EID, (const unsigned char*)(B.W + WO_PU), rows, B.PART); }
        GRID_SYNC();
        if (RUN(PH_PEERW)) REP(PH_PEERW) { PHASE_LOCALS phase_peer_w(B.PART, B.ROUTE, rows, B.WG); }
        GRID_SYNC();
        if (RUN(PH_PEERV)) REP(PH_PEERV) { PHASE_LOCALS phase_peer_v(B.WG, B.EID, (const unsigned char*)(B.W + WO_PV), B.mod, ck.is_ctx, ck.b0, rows, ck.xb, rep_ != 0); }
        GRID_SYNC();
        }
    }
    }
    if (R.mode == 0 || R.mode == 3) { const Params P = kparams(); phase_final((const bf16_t*)(P.ws + WS_XL), P.out, P.final_norm_g, NB * TL); }
#undef RUN
#undef GRID_SYNC
#undef PHASE_LOCALS
}

extern "C" void kernel_launch(void* const* d_in, const int* in_sizes, int n_in, void* d_out, int out_size, void* d_ws, size_t ws_size, hipStream_t stream) {
    static int grid = 0;
    if (grid == 0) {
        if (n_in != 25 || ws_size < WS_END) { fprintf(stderr, "kernel_launch: need 25 inputs and %zu bytes of workspace (got %d, %zu)\n", (size_t)WS_END, n_in, ws_size); grid = -1; return; }
        int dev = 0, cus = 0, per_cu = 0;
        if (hipGetDevice(&dev) != hipSuccess || hipDeviceGetAttribute(&cus, hipDeviceAttributeMultiprocessorCount, dev) != hipSuccess) { grid = -1; return; }
        if (hipFuncSetAttribute((const void*)fwd_kernel, hipFuncAttributeMaxDynamicSharedMemorySize, LDS_BYTES) != hipSuccess) { fprintf(stderr, "kernel_launch: hipFuncSetAttribute failed\n"); grid = -1; return; }
        if (hipOccupancyMaxActiveBlocksPerMultiprocessor(&per_cu, (const void*)fwd_kernel, NTHR, LDS_BYTES) != hipSuccess || per_cu < 1) { fprintf(stderr, "kernel_launch: occupancy query says %d\n", per_cu); grid = -1; return; }
        grid = cus;
    }
    if (grid <= 0) return;
    (void)hipMemsetAsync((char*)d_ws + WS_CTL, 0, CTL_BYTES, stream);
    Params P{};
    const float* const* in = (const float* const*)d_in;
    P.x = in[0]; P.c = in[1]; P.ctx = in[2]; P.c_ctx = in[3]; P.ada_w = in[4]; P.ada_b = in[5]; P.norm1_g = in[6]; P.norm2_g = in[7]; P.w_in = in[8]; P.pool_w = in[9];
    P.pool_scale = in[10]; P.gla_gate_w = in[11]; P.gla_gate_b = in[12]; P.gla_norm_g = in[13]; P.mla_q_norm_g = in[14]; P.mla_kv_norm_g = in[15]; P.mla_w_uq = in[16];
    P.mla_w_ukv = in[17]; P.branch_w = in[18]; P.w_out = in[19]; P.peer_wq = in[20]; P.peer_keys = in[21]; P.peer_u = in[22]; P.peer_v = in[23]; P.final_norm_g = in[24];
    P.out = (float*)d_out; P.ws = (unsigned char*)d_ws;
#if MK_SINGLE
    RunArgs R{0, 0, 0, 0};
    hipLaunchKernelGGL(fwd_kernel, dim3(grid), dim3(NTHR), LDS_BYTES, stream, P, R);
#else
    { RunArgs R{1, 0, 0, 0}; hipLaunchKernelGGL(fwd_kernel, dim3(grid), dim3(NTHR), LDS_BYTES, stream, P, R); }
    for (int layer = 0; layer < NLAYER; ++layer)
        for (int ci = 0; ci < 5; ++ci)
            for (int ph = 0; ph < PH_COUNT; ++ph) {
                if (ci == 0 && layer == NLAYER - 1 && ph >= PH_INPROJ2) continue;
                RunArgs R{2, layer, ci, ph}; hipLaunchKernelGGL(fwd_kernel, dim3(grid), dim3(NTHR), LDS_BYTES, stream, P, R); }
    { RunArgs R{3, 0, 0, 0}; hipLaunchKernelGGL(fwd_kernel, dim3(grid), dim3(NTHR), LDS_BYTES, stream, P, R); }
#endif
}
```

```cpp
#include <hip/hip_runtime.h>
#include <stdint.h>
#include <stdio.h>

#ifndef REP_PHASE
#define REP_PHASE -1
#endif
#ifndef MK_SINGLE
#define MK_SINGLE 1
#endif

#define DI __device__ __forceinline__
#define LAS __attribute__((address_space(3)))

typedef unsigned short bf16_t;
typedef short bf16x8 __attribute__((ext_vector_type(8)));
typedef short s16x4 __attribute__((ext_vector_type(4)));
typedef float f32x4 __attribute__((ext_vector_type(4)));
typedef float f32x16 __attribute__((ext_vector_type(16)));
typedef unsigned u32x4 __attribute__((ext_vector_type(4)));
typedef unsigned u32x2 __attribute__((ext_vector_type(2)));
typedef __bf16 bf16x2_t __attribute__((ext_vector_type(2)));
typedef _Float16 h16x8 __attribute__((ext_vector_type(8)));
typedef int i32x4 __attribute__((ext_vector_type(4)));
typedef int i32x8 __attribute__((ext_vector_type(8)));

constexpr int D = 1024, NB = 32, TL = 2048, TC = 256, NLAYER = 2;
constexpr int ZLD = 7936;
constexpr int ZC_P = 0, ZC_Q = 1024, ZC_K = 1536, ZC_V = 2048, ZC_R = 3072, ZC_GZ = 4096, ZC_QDN = 7168, ZC_KVDN = 7552,
              ZC_KROPE = 7808, ZC_LRF = 7872, ZC_LRB = 7888;
constexpr int NEXP = 16384;
constexpr int NWG = 256, NTHR = 512;
constexpr int LDS_BYTES = 147456;

constexpr size_t WO_IN = 0, WO_POOL = WO_IN + (size_t)ZLD * 1024, WO_UQ = WO_POOL + 4 * 256 * 256, WO_KN = WO_UQ + 1536 * 384,
                 WO_V = WO_KN + 1024 * 256, WO_BR = WO_V + 1024 * 256, WO_OUT = WO_BR + 3 * 1024 * 1024, WO_Q = WO_OUT + 1024 * 1024,
                 WO_KEYS = WO_Q + 2048 * 1024, WO_PU = WO_KEYS + 8 * 256 * 256, WO_PV = WO_PU + (size_t)NEXP * 512,
                 W_LAYER = WO_PV + (size_t)NEXP * 512;

constexpr size_t MiB = 1048576;
constexpr size_t WS_CTL = 0;
constexpr size_t CTL_BYTES = 65536;
constexpr size_t WS_MOD = WS_CTL + CTL_BYTES;
constexpr size_t WS_ROPE = WS_MOD + 1792 * 1024;
constexpr size_t WS_W = WS_MOD + 2 * MiB;
constexpr size_t WS_H = WS_W + ((2 * W_LAYER * 2 + 255) / 256) * 256;
constexpr size_t WS_Z = WS_H + 32 * MiB;
constexpr size_t WS_QB = WS_Z + 248 * MiB;
constexpr size_t WS_KN = WS_QB + 48 * MiB;
constexpr size_t WS_VT = WS_KN + 32 * MiB;
constexpr size_t WS_KR = WS_VT + 32 * MiB;
constexpr size_t WS_CKN = WS_KR + 2 * MiB;
constexpr size_t WS_CVT = WS_CKN + 16 * MiB;
constexpr size_t WS_CKR = WS_CVT + 16 * MiB;
constexpr size_t WS_CST = WS_CKR + 1 * MiB;
constexpr size_t WS_RS = WS_CST + 32 * MiB;
constexpr size_t WS_OF = WS_RS + 1 * MiB;
constexpr size_t WS_OB = WS_OF + 32 * MiB;
constexpr size_t WS_MLA = WS_OB + 32 * MiB;
constexpr size_t WS_PD = WS_MLA + 32 * MiB;
constexpr size_t WS_PO = WS_PD + 32 * MiB;
constexpr size_t WS_ROUTE = WS_PO + 32 * MiB;
constexpr size_t WS_XCTX = WS_ROUTE + 16 * MiB;
constexpr size_t WS_XL = WS_XCTX + 16 * MiB;
constexpr size_t WS_END = WS_XL + 128 * MiB;

DI float bf2f(bf16_t b) { return __uint_as_float((unsigned)b << 16); }
DI bf16_t f2bf(float f) { return __builtin_bit_cast(bf16_t, (__bf16)f); }
DI unsigned pk2(float lo, float hi) { bf16x2_t v; v[0] = (__bf16)lo; v[1] = (__bf16)hi; return __builtin_bit_cast(unsigned, v); }
DI unsigned pk4_fp8(float a, float b, float c, float d) { int w = 0; w = __builtin_amdgcn_cvt_pk_fp8_f32(a, b, w, false); w = __builtin_amdgcn_cvt_pk_fp8_f32(c, d, w, true); return (unsigned)w; }
DI unsigned char f2fp8(float a) { return (unsigned char)(__builtin_amdgcn_cvt_pk_fp8_f32(a, a, 0, false) & 0xff); }
DI float lo2f(unsigned w) { return __uint_as_float(w << 16); }
DI float hi2f(unsigned w) { return __uint_as_float(w & 0xffff0000u); }
DI float shx(float v, int m, int lane) { return __builtin_bit_cast(float, __builtin_amdgcn_ds_bpermute((lane ^ m) << 2, __builtin_bit_cast(int, v))); }
DI float shl(float v, int src) { return __builtin_bit_cast(float, __builtin_amdgcn_ds_bpermute(src << 2, __builtin_bit_cast(int, v))); }
DI float wave_sum(float v, int lane) {
#pragma unroll
    for (int o = 32; o >= 1; o >>= 1) v += shx(v, o, lane);
    return v;
}
DI int ltid() { int t = threadIdx.x; asm volatile("" : "+v"(t)); return t; }
DI int lnd(int x) { asm volatile("" : "+s"(x)); return x; }
DI int lbid() { return lnd((int)blockIdx.x); }
DI int lgdim() { return lnd((int)gridDim.x); }
DI float sigmoidf_(float x) { return 1.0f / (1.0f + __expf(-x)); }

#define XB_TMO      128
#define XB_XCNT(j)  (256  + 64 * (j))
#define XB_XSUB(j)  (1280 + 64 * (j))
#define XB_XGEN(j)  (2304 + 64 * (j))
#define XB_TOP      3328
#define XB_TOPGEN   3392
#define XCD_BAR_WORDS 3456
#define XB_SPIN_CAP (1u << 23)
#define CTL_WORKQ   4096

DI unsigned xb_ld(unsigned* p)              { return __hip_atomic_load(p, __ATOMIC_RELAXED, __HIP_MEMORY_SCOPE_AGENT); }
DI unsigned xb_add(unsigned* p, unsigned v) { return __hip_atomic_fetch_add(p, v, __ATOMIC_RELAXED, __HIP_MEMORY_SCOPE_AGENT); }
DI unsigned xb_xcc_id() { return (unsigned)__builtin_amdgcn_s_getreg((3 << 11) | 20) & 0xFu; }
#define XB_SPIN(cond, bar) do { unsigned _sp = 0; while (cond) { __builtin_amdgcn_s_sleep(1); \
    if ((++_sp & 255u) == 0u) { if (xb_ld(&(bar)[XB_TMO])) break; if (_sp > XB_SPIN_CAP) { atomicAdd(&(bar)[XB_TMO], 1u); break; } } } } while (0)

struct XcdBarrier { unsigned* bar; unsigned x; volatile LAS unsigned* st; };

DI XcdBarrier xcd_barrier_post(unsigned* bar, volatile LAS unsigned* st) {
    XcdBarrier b; b.bar = bar; b.x = xb_xcc_id(); b.st = st;
    if (threadIdx.x == 0) (void)xb_add(&bar[XB_XCNT(b.x)], 1u);
    return b;
}
DI void xcd_barrier_complete(unsigned* bar, unsigned x, unsigned& nloc, unsigned& nx) {
    const unsigned G = gridDim.x * gridDim.y * gridDim.z;
    unsigned sum, cnt, mine, sp = 0u;
    for (;;) {
        sum = 0u; cnt = 0u; mine = 0u;
#pragma unroll
        for (unsigned j = 0; j < 16; ++j) { const unsigned c = xb_ld(&bar[XB_XCNT(j)]); sum += c; cnt += (c > 0u) ? 1u : 0u; mine = (j == x) ? c : mine; }
        if (sum == G) break;
        __builtin_amdgcn_s_sleep(1);
        if ((++sp & 255u) == 0u) { if (xb_ld(&bar[XB_TMO])) break; if (sp > XB_SPIN_CAP) { atomicAdd(&bar[XB_TMO], 1u); break; } }
    }
    nloc = mine > 0u ? mine : 1u; nx = cnt > 0u ? cnt : 1u;
}
DI void xcd_barrier(const XcdBarrier& b) {
    asm volatile("s_waitcnt vmcnt(0)" ::: "memory");
    __syncthreads();
    if (threadIdx.x == 0) {
        __attribute__((address_space(1))) unsigned* gbar = (__attribute__((address_space(1))) unsigned*)b.bar; asm volatile("" : "+s"(gbar)); unsigned* bar = (unsigned*)gbar;
        unsigned bx = b.x; asm volatile("" : "+s"(bx));
        __builtin_amdgcn_s_waitcnt(0);
        unsigned nloc = b.st[0], nx = b.st[1];
        if (nloc == 0u) { xcd_barrier_complete(bar, bx, nloc, nx); b.st[0] = nloc; b.st[1] = nx; }
        const unsigned old = xb_add(&bar[XB_XSUB(bx)], 1u);
        const unsigned gen = old / nloc;
        if (old + 1u == (gen + 1u) * nloc) {
            __builtin_amdgcn_fence(__ATOMIC_RELEASE, "agent");
            asm volatile("s_waitcnt vmcnt(0)" ::: "memory");
            const unsigned og = xb_add(&bar[XB_TOP], 1u);
            const unsigned tg = og / nx;
            if (og + 1u == (tg + 1u) * nx) xb_add(&bar[XB_TOPGEN], 1u);
            else XB_SPIN(xb_ld(&bar[XB_TOPGEN]) == tg, bar);
            __builtin_amdgcn_fence(__ATOMIC_ACQUIRE, "agent");
            xb_add(&bar[XB_XGEN(bx)], 1u);
            asm volatile("s_waitcnt vmcnt(0)" ::: "memory");
        } else {
            XB_SPIN(xb_ld(&bar[XB_XGEN(bx)]) == gen, bar);
            __builtin_amdgcn_fence(__ATOMIC_ACQUIRE, "agent");
            asm volatile("s_waitcnt vmcnt(0)" ::: "memory");
        }
    }
    __syncthreads();
}

namespace pg8 {
constexpr int BM = 256, BK = 64, HALF = 128, HTB = HALF * BK * 2, STAGE_BYTES = 8 * HTB, NXCD = 8, WGM = 8;
DI int lds_byte(int r, int c) { const int st = (r >> 4) * 2 + (c >> 5), rr = r & 15, cc = c & 31, ob = rr * 64 + cc * 2; return st * 1024 + (ob ^ (((ob >> 9) & 1) << 5)); }
DI void stage_rc(int b, int& R, int& C) { const int st = b / 1024, sb = b % 1024, swz = sb ^ (((sb >> 9) & 1) << 5); R = (st >> 1) * 16 + swz / 64; C = (st & 1) * 32 + (swz % 64) / 2; }
DI int perm32(int rho) { const int n = rho >> 4, i = rho & 15; return 8 * (i >> 2) + 4 * n + (i & 3); }

struct Unit { const char* A; const char* B; int pm, pn, z; unsigned sa; };

DI void tile_of(int L, int nM, int nN, int& pm, int& pn) {
    const int nwg = nM * nN; int wgid = L;
    { const int q = nwg / NXCD, r = nwg % NXCD, xcd = wgid % NXCD, off = wgid / NXCD; wgid = (xcd < r ? xcd * (q + 1) : r * (q + 1) + (xcd - r) * q) + off; }
    const int nig = WGM * nN, gid = wgid / nig, fm = gid * WGM, gsz = (nM - fm) < WGM ? (nM - fm) : WGM;
    pm = fm + ((wgid % nig) % gsz); pn = (wgid % nig) / gsz;
}

template <class F> DI void epi8(const f32x4 (&acc)[2][2][4][2], int wr, int wc, int fr, int fq, F f) {
#pragma unroll
    for (int ai = 0; ai < 2; ++ai)
#pragma unroll
        for (int m = 0; m < 4; ++m) {
            const int row = ai * HALF + wr * 64 + m * 16 + fr;
#pragma unroll
            for (int bj = 0; bj < 2; ++bj) f(row, bj * HALF + wc * 32 + 8 * fq, acc[ai][bj][m][0], acc[ai][bj][m][1]);
        }
}

template <int ES, class Epi, class Sched>
DI void gemm_phase(LAS unsigned char* lds, const int lda, const int ldb, const int K, const Sched& S, const Epi& E) {
    int tid = threadIdx.x; asm volatile("" : "+v"(tid));
    const int wid = __builtin_amdgcn_readfirstlane(tid >> 6), lane = tid & 63, wr = wid >> 2, wc = wid & 3, fr = lane & 15, fq = lane >> 4;
    const int nt = K * ES / (BK * 2);
    unsigned voffA[2], voffB[2];
#pragma unroll
    for (int i = 0; i < 2; ++i) { int R, C; stage_rc(tid * 16 + i * 8192, R, C); const int Rb = (R & ~31) + perm32(R & 31);
        voffA[i] = (unsigned)(R * lda * ES + C * 2); voffB[i] = (unsigned)(Rb * ldb * ES + C * 2); }
    const size_t kstep = (size_t)(BK * 2);
    const size_t hstepA = (size_t)HALF * lda * ES, hstepB = (size_t)HALF * ldb * ES;
    const unsigned ldsw = (unsigned)wid * 1024u;
    LAS unsigned char* ldsA = lds + lds_byte(wr * 64 + fr, fq * 8); LAS unsigned char* ldsB = lds + 4 * HTB + lds_byte(wc * 32 + fr, fq * 8);
    asm volatile("" : "+v"(ldsA), "+v"(ldsB));
#define PG8_SA(b, h) (((b) * 2 + (h)) * HTB)
#define PG8_SB(b, h) ((4 + (b) * 2 + (h)) * HTB)
#define PG8_STAGE(bufoff, gbase, voff) do { const char* _g = (const char*)(gbase); asm volatile("" : "+s"(_g)); _Pragma("unroll") for (int _i = 0; _i < 2; ++_i) \
        __builtin_amdgcn_global_load_lds((const unsigned*)(_g + (voff)[_i]), (LAS unsigned*)(lds + (bufoff) + ldsw + _i * 8192), 16, 0, 0); } while (0)
#define PG8_LD16(p) (*(const LAS i32x4*)(p))
#define PG8_LDA(dst, b, h) do { _Pragma("unroll") for (int m = 0; m < 4; ++m) { \
        if constexpr (ES == 2) { _Pragma("unroll") for (int k = 0; k < 2; ++k) dst[m][k] = *(const LAS bf16x8*)(ldsA + PG8_SA(b, h) + m * 2048 + k * 1024); } \
        else dst##8[m] = __builtin_shufflevector(PG8_LD16(ldsA + PG8_SA(b, h) + m * 2048), PG8_LD16(ldsA + PG8_SA(b, h) + m * 2048 + 1024), 0, 1, 2, 3, 4, 5, 6, 7); } } while (0)
#define PG8_LDB(dst, b, h) do { _Pragma("unroll") for (int n = 0; n < 2; ++n) { \
        if constexpr (ES == 2) { _Pragma("unroll") for (int k = 0; k < 2; ++k) dst[n][k] = *(const LAS bf16x8*)(ldsB + PG8_SA(b, h) + n * 2048 + k * 1024); } \
        else dst##8[n] = __builtin_shufflevector(PG8_LD16(ldsB + PG8_SA(b, h) + n * 2048), PG8_LD16(ldsB + PG8_SA(b, h) + n * 2048 + 1024), 0, 1, 2, 3, 4, 5, 6, 7); } } while (0)
#define PG8_MMA(ai, bj, At, Bt) do { __builtin_amdgcn_s_setprio(1); _Pragma("unroll") for (int m = 0; m < 4; ++m) _Pragma("unroll") for (int n = 0; n < 2; ++n) { \
        if constexpr (ES == 2) { _Pragma("unroll") for (int k = 0; k < 2; ++k) acc[ai][bj][m][n] = __builtin_amdgcn_mfma_f32_16x16x32_bf16(Bt[n][k], At[m][k], acc[ai][bj][m][n], 0, 0, 0); } \
        else asm volatile("v_mfma_scale_f32_16x16x128_f8f6f4 %0, %1, %2, %0, %3, %4 op_sel_hi:[0,0,0]" : "+v"(acc[ai][bj][m][n]) : "v"(Bt##8[n]), "v"(At##8[m]), "v"(0x7a7a7a7a), "v"(cur.sa)); } \
        __builtin_amdgcn_s_setprio(0); if constexpr (ES == 1) __builtin_amdgcn_sched_barrier(0); } while (0)
#define PG8_WAIT_V(n) asm volatile("s_waitcnt vmcnt(" #n ")" ::: "memory")
#define PG8_WAIT_L(n) asm volatile("s_waitcnt lgkmcnt(" #n ")" ::: "memory")
#define PG8_BAR __builtin_amdgcn_s_barrier()
#define PG8_SCHED __builtin_amdgcn_sched_barrier(0)
    Unit cur, nxt; int ui = 0;
    if (!S.next(0, cur)) return;
    f32x4 acc[2][2][4][2];
#pragma unroll
    for (int a = 0; a < 2; ++a)
#pragma unroll
        for (int b = 0; b < 2; ++b)
#pragma unroll
            for (int m = 0; m < 4; ++m)
#pragma unroll
                for (int n = 0; n < 2; ++n) acc[a][b][m][n] = (f32x4){0.f, 0.f, 0.f, 0.f};
    bf16x8 At[4][2], B0[2][2], B1[2][2];
    i32x8 At8[4], B08[2], B18[2];
    const char* cA = cur.A; const char* cB = cur.B;
    PG8_STAGE(PG8_SB(0, 0), cB, voffB); PG8_STAGE(PG8_SA(0, 0), cA, voffA); PG8_STAGE(PG8_SB(0, 1), cB + hstepB, voffB); PG8_STAGE(PG8_SA(0, 1), cA + hstepA, voffA);
    if (wr == 1) PG8_BAR;
    PG8_WAIT_V(4); PG8_BAR;
    PG8_STAGE(PG8_SB(1, 0), cB + kstep, voffB); PG8_STAGE(PG8_SA(1, 0), cA + kstep, voffA); PG8_STAGE(PG8_SB(1, 1), cB + hstepB + kstep, voffB);
    PG8_WAIT_V(6); PG8_BAR;
    for (;;) {
        const bool has_next = S.next(ui + 1, nxt);
        const char* nA = has_next ? nxt.A : cA; const char* nB = has_next ? nxt.B : cB;
#pragma nounroll
        for (int t = 0; t < nt; t += 2) {
            const bool last = (t == nt - 2);
            const char* a1 = cA + (size_t)(t + 1) * kstep;
            const char* a2 = last ? nA : cA + (size_t)(t + 2) * kstep; const char* b2 = last ? nB : cB + (size_t)(t + 2) * kstep;
            const char* a3 = a2 + kstep; const char* b3 = b2 + kstep;
            PG8_LDB(B0, 0, 0); PG8_SCHED; PG8_LDA(At, 0, 0); PG8_STAGE(PG8_SA(1, 1), a1 + hstepA, voffA);
            PG8_WAIT_L(8); PG8_BAR; PG8_WAIT_L(0); PG8_MMA(0, 0, At, B0); PG8_BAR; PG8_SCHED;
            PG8_LDB(B1, 0, 1); PG8_STAGE(PG8_SB(0, 0), b2, voffB);
            PG8_BAR; PG8_WAIT_L(0); PG8_MMA(0, 1, At, B1); PG8_BAR;
            PG8_LDA(At, 0, 1); PG8_STAGE(PG8_SA(0, 0), a2, voffA);
            PG8_BAR; PG8_WAIT_L(0); PG8_MMA(1, 0, At, B0); PG8_BAR; PG8_SCHED;
            PG8_STAGE(PG8_SB(0, 1), b2 + hstepB, voffB);
            PG8_WAIT_V(6); PG8_BAR; PG8_MMA(1, 1, At, B1); PG8_BAR;
            PG8_LDB(B0, 1, 0); PG8_SCHED; PG8_LDA(At, 1, 0); PG8_STAGE(PG8_SA(0, 1), a2 + hstepA, voffA);
            PG8_WAIT_L(8); PG8_BAR; PG8_WAIT_L(0); PG8_MMA(0, 0, At, B0); PG8_BAR; PG8_SCHED;
            PG8_LDB(B1, 1, 1); PG8_STAGE(PG8_SB(1, 0), b3, voffB);
            PG8_BAR; PG8_WAIT_L(0); PG8_MMA(0, 1, At, B1); PG8_BAR;
            PG8_LDA(At, 1, 1); PG8_STAGE(PG8_SA(1, 0), a3, voffA);
            PG8_BAR; PG8_WAIT_L(0); PG8_MMA(1, 0, At, B0); PG8_BAR; PG8_SCHED;
            PG8_STAGE(PG8_SB(1, 1), b3 + hstepB, voffB);
            PG8_WAIT_V(6); PG8_BAR; PG8_MMA(1, 1, At, B1); PG8_BAR;
        }
        if constexpr (ES == 1) asm volatile("s_nop 15\n\ts_nop 15" ::: "memory");
        E(acc, cur, wr, wc, fr, fq);
        if (!has_next) break;
#pragma unroll
        for (int a = 0; a < 2; ++a)
#pragma unroll
            for (int b = 0; b < 2; ++b)
#pragma unroll
                for (int m = 0; m < 4; ++m)
#pragma unroll
                    for (int n = 0; n < 2; ++n) acc[a][b][m][n] = (f32x4){0.f, 0.f, 0.f, 0.f};
        cur = nxt; cA = nA; cB = nB; ++ui;
    }
    PG8_WAIT_V(0);
    if (wr == 0) PG8_BAR;
    PG8_BAR;
#undef PG8_SA
#undef PG8_SB
#undef PG8_STAGE
#undef PG8_LDA
#undef PG8_LDB
#undef PG8_MMA
#undef PG8_WAIT_V
#undef PG8_WAIT_L
#undef PG8_BAR
#undef PG8_SCHED
}
}
using pg8::Unit;

struct Params {
    const float *x, *c, *ctx, *c_ctx, *ada_w, *ada_b, *norm1_g, *norm2_g, *w_in, *pool_w, *pool_scale, *gla_gate_w, *gla_gate_b, *gla_norm_g,
                *mla_q_norm_g, *mla_kv_norm_g, *mla_w_uq, *mla_w_ukv, *branch_w, *w_out, *peer_wq, *peer_keys, *peer_u, *peer_v, *final_norm_g;
    float* out; unsigned char* ws;
};
struct Chunk { int is_ctx, rows, b0, np; const float* x32; bf16_t* xb; };

DI Chunk make_chunk(const Params& P, int layer, int ci) {
    Chunk c; c.is_ctx = (ci == 0); c.rows = c.is_ctx ? NB * TC : 8 * TL; c.b0 = c.is_ctx ? 0 : 8 * (ci - 1); c.np = c.rows / 256;
    c.xb = c.is_ctx ? (bf16_t*)(P.ws + WS_XCTX) : (bf16_t*)(P.ws + WS_XL) + (size_t)c.b0 * TL * D;
    c.x32 = (layer == 0) ? (c.is_ctx ? P.ctx : P.x + (size_t)c.b0 * TL * D) : nullptr;
    return c;
}
DI const bf16_t* wlayer(const Params& P, int l) { return (const bf16_t*)(P.ws + WS_W) + (size_t)l * W_LAYER; }
DI const float* modlayer(const Params& P, int l) { return (const float*)(P.ws + WS_MOD) + (size_t)l * 33 * 6144; }

template <bool FP8 = false, class SrcF> DI void tconv_tiles(LAS float* tile, bf16_t* dst, int K, int N, SrcF src, int rot) {
    const int tid = ltid(), ntk = K / 64, ntn = N / 64, nwg = lgdim();
    const int wg = (int)(((unsigned)lbid() + (unsigned)rot) % (unsigned)nwg);
    for (int t = wg; t < ntk * ntn; t += nwg) {
        const int kt = t % ntk, nt_ = t / ntk;
#pragma unroll
        for (int rr = 0; rr < 8; ++rr) { const int i = (tid >> 6) + 8 * rr, j = tid & 63; tile[i * 65 + j] = src(kt * 64 + i, nt_ * 64 + j); }
        __syncthreads();
#pragma unroll
        for (int rr = 0; rr < 8; ++rr) { const int jj = (tid >> 6) + 8 * rr, ii = tid & 63; const size_t o = (size_t)(nt_ * 64 + jj) * K + kt * 64 + ii;
            if (FP8) ((unsigned char*)dst)[o] = f2fp8(tile[ii * 65 + jj] * 32.0f); else dst[o] = f2bf(tile[ii * 65 + jj]); }
        __syncthreads();
    }
}
DI void conv_direct(const float* src, bf16_t* dst, size_t n) {
    const size_t stride = (size_t)lgdim() * NTHR;
    const int tid_ = ltid();
    for (size_t i = (size_t)lbid() * NTHR + tid_; i < n / 4; i += stride) {
        const float4 v = ((const float4*)src)[i]; u32x2 w; w.x = pk2(v.x, v.y); w.y = pk2(v.z, v.w); ((u32x2*)dst)[i] = w; }
}
DI void conv_fp8(const float* src, unsigned* dst, size_t n, float scale) {
    const size_t stride = (size_t)lgdim() * NTHR;
    const int tid_ = ltid();
    for (size_t i = (size_t)lbid() * NTHR + tid_; i < n / 4; i += stride) {
        const float4 v = ((const float4*)src)[i]; int w = 0;
        w = __builtin_amdgcn_cvt_pk_fp8_f32(v.x * scale, v.y * scale, w, false); w = __builtin_amdgcn_cvt_pk_fp8_f32(v.z * scale, v.w * scale, w, true);
        const size_t e = i >> 8, d4 = i & 255;
        dst[((d4 >> 5) * (size_t)NEXP + e) * 32 + (d4 & 31)] = (unsigned)w; }
}
DI void phase_convert(const Params& P, LAS unsigned char* lds) {
    LAS float* tile = (LAS float*)lds;
    for (int l = 0; l < NLAYER; ++l) {
        bf16_t* W = (bf16_t*)(P.ws + WS_W) + (size_t)l * W_LAYER;
        { const float* w = P.w_in + (size_t)l * 1024 * 7904;
          tconv_tiles<true>(tile, W + WO_IN, 1024, ZLD, [=](int k, int n) -> float {
              int sc; float s = 1.0f;
              if (n < 4096) { sc = n; if (n >= 1024 && n < 1536) s = 0.08838834764831845f; }
              else if (n < 7168) sc = n - 4096 + 4832;
              else if (n < 7552) sc = n - 7168 + 4128;
              else if (n < 7808) sc = n - 7552 + 4512;
              else if (n < 7872) sc = n - 7808 + 4768;
              else if (n < 7888) sc = n - 7872 + 4096;
              else if (n < 7904) sc = n - 7888 + 4112;
              else return 0.0f;
              return w[(size_t)k * 7904 + sc] * s; }, 0); }
        { const float* w = P.mla_w_uq + (size_t)l * 384 * 1536; const float* g = P.mla_q_norm_g + l * 384;
          tconv_tiles(tile, W + WO_UQ, 384, 1536, [=](int k, int n) -> float { return g[k] * w[k * 1536 + n]; }, 81); }
        { const float* w = P.mla_w_ukv + (size_t)l * 256 * 2048; const float* g = P.mla_kv_norm_g + l * 256;
          tconv_tiles(tile, W + WO_KN, 256, 1024, [=](int k, int n) -> float { return g[k] * w[k * 2048 + (n >> 7) * 256 + (n & 127)]; }, 120);
          tconv_tiles(tile, W + WO_V, 256, 1024, [=](int k, int n) -> float { return g[k] * w[k * 2048 + (n >> 7) * 256 + 128 + (n & 127)]; }, 184); }
        for (int i = 1; i < 3; ++i) { const float* w = P.branch_w + ((size_t)l * 3 + i) * 1048576;
          tconv_tiles<true>(tile, (bf16_t*)((unsigned char*)(W + WO_BR) + (size_t)i * 1048576), 1024, 1024, [=](int k, int n) -> float { return w[k * 1024 + n]; }, 0); }
        {
            const float* pw = P.pool_w + (size_t)l * 4 * 65536; const float* ps = P.pool_scale + l * 1024; const float* bw = P.branch_w + (size_t)l * 3 * 1048576; unsigned char* dst = (unsigned char*)(W + WO_BR);
            LAS float* AS = (LAS float*)lds; LAS float* BS = AS + 64 * 257;
            const int tid = ltid();
            for (int t = lbid(); t < 256; t += lgdim()) {
                const int g = t >> 6, nb = (t >> 2) & 15, kb = t & 3;
                __syncthreads();
                for (int i = tid; i < 64 * 256; i += NTHR) { const int r = i >> 8, j = i & 255; AS[r * 257 + j] = pw[(size_t)g * 65536 + (kb * 64 + r) * 256 + j] * ps[g * 256 + j]; }
                for (int i = tid; i < 256 * 64; i += NTHR) { const int j = i >> 6, n = i & 63; BS[j * 65 + n] = bw[(size_t)(g * 256 + j) * 1024 + nb * 64 + n]; }
                __syncthreads();
                const int kq = tid & 63, n0 = (tid >> 6) * 8;
                float acc[8];
#pragma unroll
                for (int j = 0; j < 8; ++j) acc[j] = 0.f;
                for (int j = 0; j < 256; ++j) { const float a = AS[kq * 257 + j];
#pragma unroll
                    for (int q = 0; q < 8; ++q) acc[q] += a * BS[j * 65 + n0 + q]; }
#pragma unroll
                for (int q = 0; q < 8; ++q) dst[(size_t)(nb * 64 + n0 + q) * 1024 + g * 256 + kb * 64 + kq] = f2fp8(acc[q] * 32.0f);
            }
            __syncthreads();
        }
        { const float* w = P.w_out + (size_t)l * 1048576;
          tconv_tiles<true>(tile, W + WO_OUT, 1024, 1024, [=](int k, int n) -> float { return w[k * 1024 + n]; }, 0); }
        {
            const float* wq = P.peer_wq + (size_t)l * 1024 * 2048; const float* kk = P.peer_keys + (size_t)l * 2 * 8 * 128 * 128; bf16_t* dst = W + WO_Q;
            LAS float* KY = (LAS float*)lds; LAS float* WQS = KY + 128 * 129;
            const int tid = ltid();
            for (int t = lbid(); t < 256; t += lgdim()) {
                const int hs = t >> 4, k0 = (t & 15) * 64, h = hs >> 1, half = hs & 1;
                __syncthreads();
                for (int i = tid; i < 128 * 128; i += NTHR) { const int key = i >> 7, d = i & 127; KY[key * 129 + d] = kk[((size_t)(half * 8 + h) * 128 + key) * 128 + d]; }
                for (int i = tid; i < 64 * 128; i += NTHR) { const int r = i >> 7, d = i & 127; WQS[r * 129 + d] = wq[(size_t)(k0 + r) * 2048 + h * 256 + half * 128 + d]; }
                __syncthreads();
                const int kq = tid & 63, key0 = (tid >> 6) * 16;
                float acc[16];
#pragma unroll
                for (int j = 0; j < 16; ++j) acc[j] = 0.f;
                for (int d = 0; d < 128; ++d) { const float a = WQS[kq * 129 + d];
#pragma unroll
                    for (int j = 0; j < 16; ++j) acc[j] += a * KY[(key0 + j) * 129 + d]; }
#pragma unroll
                for (int j = 0; j < 16; ++j) dst[(size_t)(h * 256 + half * 128 + key0 + j) * 1024 + k0 + kq] = f2bf(acc[j]);
            }
            __syncthreads();
        }
        conv_fp8(P.peer_u + (size_t)l * NEXP * 1024, (unsigned*)(W + WO_PU), (size_t)NEXP * 1024, 32.0f);
        conv_fp8(P.peer_v + (size_t)l * NEXP * 1024, (unsigned*)(W + WO_PV), (size_t)NEXP * 1024, 1.0f);
    }
    if (lbid() == 0) {
        float2* rt = (float2*)(P.ws + WS_ROPE);
        for (int i = ltid(); i < 64 * 16; i += NTHR) { const float inv = exp2f(-(float)(i & 15) * 0.8304820237218406f); float sn, cs; sincosf((float)(i >> 4) * inv, &sn, &cs); rt[i] = make_float2(cs, sn); }
    }
}
DI void phase_mod(const Params& P, LAS unsigned char* lds) {
    LAS float* SC = (LAS float*)lds;
    LAS float* ACC = SC + 33 * 1024;
    const int tid = ltid(), wid = tid >> 6;
    if (lbid() >= 192) return;
    for (int i = tid; i < 33 * 1024; i += NTHR) { const int b = i >> 10, k = i & 1023; const float v = b < 32 ? P.c[b * 1024 + k] : P.c_ctx[k]; SC[i] = v / (1.0f + __expf(-v)); }
    float* MOD = (float*)(P.ws + WS_MOD);
    for (int grp = lbid(); grp < 192; grp += lgdim()) {
        const int l = grp / 96, n0 = (grp % 96) * 64;
        for (int i = tid; i < 33 * 64; i += NTHR) ACC[i] = 0.f;
        __syncthreads();
        const int j = tid & 63, ks = tid >> 6;
        float acc[33];
#pragma unroll
        for (int b = 0; b < 33; ++b) acc[b] = 0.f;
        const float* w = P.ada_w + (size_t)l * 1024 * 6144 + n0 + j;
        for (int k = ks * 128; k < ks * 128 + 128; ++k) { const float wv = w[(size_t)k * 6144];
#pragma unroll
            for (int b = 0; b < 33; ++b) acc[b] += SC[b * 1024 + k] * wv; }
        for (int ww = 0; ww < 8; ++ww) {
            if (wid == ww) {
#pragma unroll
                for (int b = 0; b < 33; ++b) ACC[b * 64 + j] += acc[b]; }
            __syncthreads(); }
        for (int i = tid; i < 33 * 64; i += NTHR) { const int b = i >> 6, jj = i & 63; MOD[(size_t)(l * 33 + b) * 6144 + n0 + jj] = ACC[i] + P.ada_b[l * 6144 + n0 + jj]; }
        __syncthreads();
    }
}

template <bool F32SRC, bool FP8OUT> DI void phase_norm(const void* xsv, int rows, const float* gain, const float* mod, int is_ctx, int b0, int sh_idx, bf16_t* H) {
    const int tid_ = ltid(); const int lane = tid_ & 63, wid = tid_ >> 6;
    for (int r = lbid() * 8 + wid; r < rows; r += lgdim() * 8) {
        const int bi = is_ctx ? 32 : b0 + (r >> 11);
        const float* sh = mod + (size_t)bi * 6144 + sh_idx * 1024; const float* sc = sh + 1024;
        float4 v[4]; float ss = 0.f;
#pragma unroll
        for (int j = 0; j < 4; ++j) {
            if (F32SRC) v[j] = ((const float4*)((const float*)xsv + (size_t)r * 1024))[lane + 64 * j];
            else { const u32x2 w = ((const u32x2*)((const bf16_t*)xsv + (size_t)r * 1024))[lane + 64 * j]; v[j] = make_float4(lo2f(w.x), hi2f(w.x), lo2f(w.y), hi2f(w.y)); }
            ss += v[j].x * v[j].x + v[j].y * v[j].y + v[j].z * v[j].z + v[j].w * v[j].w; }
        ss = wave_sum(ss, lane);
        const float rstd = rsqrtf(ss * (1.0f / 1024.0f) + 1e-6f);
#pragma unroll
        for (int j = 0; j < 4; ++j) { const int c = (lane + 64 * j) * 4;
            const float4 g = *(const float4*)(gain + c), s1 = *(const float4*)(sc + c), s0 = *(const float4*)(sh + c);
            const float y0 = v[j].x * rstd * g.x * (1.f + s1.x) + s0.x, y1 = v[j].y * rstd * g.y * (1.f + s1.y) + s0.y, y2 = v[j].z * rstd * g.z * (1.f + s1.z) + s0.z, y3 = v[j].w * rstd * g.w * (1.f + s1.w) + s0.w;
            if (FP8OUT) *(unsigned*)((unsigned char*)H + (size_t)r * 1024 + c) = pk4_fp8(y0, y1, y2, y3);
            else { u32x2 w; w.x = pk2(y0, y1); w.y = pk2(y2, y3); *(u32x2*)(H + (size_t)r * 1024 + c) = w; } }
    }
}

DI void phase_prep(const bf16_t* Z, int rows, int is_ctx, float* RS, bf16_t* KR, bf16_t* PD, bool do_pool, const float2* rt) {
    const int tid_ = ltid(); const int lane = tid_ & 63, wid = tid_ >> 6;
    const int seqlen = is_ctx ? TC : TL;
    for (int r = lbid() * 8 + wid; r < rows; r += lgdim() * 8) {
        const bf16_t* zr = Z + (size_t)r * ZLD;
        float sq = 0.f, sk = 0.f;
        { const unsigned* p = (const unsigned*)(zr + ZC_QDN + lane * 6);
#pragma unroll
          for (int i = 0; i < 3; ++i) { const unsigned w = p[i]; const float a = lo2f(w), b = hi2f(w); sq += a * a + b * b; } }
        { const u32x2 w = *(const u32x2*)(zr + ZC_KVDN + lane * 4); const float a = lo2f(w.x), b = hi2f(w.x), c = lo2f(w.y), d = hi2f(w.y); sk = a * a + b * b + c * c + d * d; }
        sq = wave_sum(sq, lane); sk = wave_sum(sk, lane);
        if (lane == 0) { RS[r] = rsqrtf(sq * (1.0f / 384.0f) + 1e-6f); RS[16384 + r] = rsqrtf(sk * (1.0f / 256.0f) + 1e-6f); }
        { const float x = bf2f(zr[ZC_KROPE + lane]); const float xp = shx(x, 16, lane); float o = x;
          if (!is_ctx) { const int t = r & (TL - 1); const int pos = (lane < 32) ? (t >> 6) : (t & 63); const int i = lane & 15;
              const float2 cs = rt[pos * 16 + i]; const float c = cs.x, s = cs.y;
              o = ((lane & 31) < 16) ? (x * c - xp * s) : (xp * s + x * c); }
          KR[(size_t)r * 64 + lane] = f2bf(o); }
        if (do_pool) {
            const int t = r % seqlen, seq0 = r - t;
#pragma unroll
            for (int j = 0; j < 4; ++j) {
                const int hw = 1 << j; const int lo = (t - hw) < 0 ? 0 : (t - hw); const int hi = (t + hw) > seqlen ? seqlen : (t + hw);
                const int c = j * 256 + lane * 4; float s0 = 0.f, s1 = 0.f, s2 = 0.f, s3 = 0.f;
#pragma unroll
                for (int k = 0; k < 2 * hw; ++k) {
                    const int tt = t - hw + k; const bool ok = tt >= 0 && tt < seqlen; const int tc = ok ? tt : t;
                    const u32x2 w = *(const u32x2*)(Z + (size_t)(seq0 + tc) * ZLD + ZC_P + c); const float m = ok ? 1.f : 0.f;
                    s0 += m * lo2f(w.x); s1 += m * hi2f(w.x); s2 += m * lo2f(w.y); s3 += m * hi2f(w.y); }
                const u32x2 me = *(const u32x2*)(zr + ZC_P + c); const float inv = 1.0f / (float)(hi - lo);
                *(unsigned*)((unsigned char*)PD + (size_t)r * 1024 + c) = pk4_fp8(s0 * inv - lo2f(me.x), s1 * inv - hi2f(me.x), s2 * inv - lo2f(me.y), s3 * inv - hi2f(me.y)); }
        }
    }
}

template <class Fill> struct GridSched { int nM, nN, G, c; Fill fill;
    DI bool next(int i, Unit& u) const { const long L = (long)i * G + c; if (L >= (long)nM * nN) return false; int pm, pn; pg8::tile_of((int)L, nM, nN, pm, pn); u.pm = pm; u.pn = pn; u.z = 0; u.sa = 0x7f7f7f7fu; fill(u); return true; } };
template <class Fill> DI GridSched<Fill> make_sched(int nM, int nN, Fill f) { GridSched<Fill> s{nM, nN, lgdim(), lbid(), f}; return s; }
template <class Fill> struct TripleSched { int nM, nN, G, c; Fill fill;
    DI bool next(int i, Unit& u) const { const long L = (long)(i / 3) * G + c; if (L >= (long)nM * nN) return false; int pm, pn; pg8::tile_of((int)L, nM, nN, pm, pn); u.pm = pm; u.pn = pn; u.z = i % 3; u.sa = 0x7f7f7f7fu; fill(u); return true; } };

DI bf16x8 pack8(const f32x16& x, int sp) { u32x4 p; p.x = pk2(x[8 * sp], x[8 * sp + 1]); p.y = pk2(x[8 * sp + 2], x[8 * sp + 3]); p.z = pk2(x[8 * sp + 4], x[8 * sp + 5]); p.w = pk2(x[8 * sp + 6], x[8 * sp + 7]);
    return __builtin_bit_cast(bf16x8, p); }
DI bf16x8 read_perm(const LAS unsigned char* p) {
    const s16x4 lo = *(const LAS s16x4*)p, hi = *(const LAS s16x4*)(p + 16);
    bf16x8 v; v[0] = lo[0]; v[1] = lo[1]; v[2] = lo[2]; v[3] = lo[3]; v[4] = hi[0]; v[5] = hi[1]; v[6] = hi[2]; v[7] = hi[3]; return v; }
DI void store8_bf16(bf16_t* p, const f32x4& a, const f32x4& b) { u32x4 w; w.x = pk2(a[0], a[1]); w.y = pk2(a[2], a[3]); w.z = pk2(b[0], b[1]); w.w = pk2(b[2], b[3]); *(u32x4*)p = w; }

DI void attn_item(LAS unsigned char* lds, const float2* rt, const bf16_t* Qp, int h, bool rope, int tq0,
                  const bf16_t* kn0, const bf16_t* kr0, const bf16_t* vt0, int ldv0, int nt0,
                  const bf16_t* kn1, const bf16_t* kr1, const bf16_t* vt1, int ldv1, int nt1, unsigned char* Op) {
    int tid = threadIdx.x; asm volatile("" : "+v"(tid));
    const int wid = tid >> 6, lane = tid & 63, ql = lane & 31, hh = lane >> 5;
    const bool grpB = __builtin_amdgcn_readfirstlane(wid) >= 4;
    constexpr int KPITCH = 400, VPITCH = 136, VOFF = 64 * KPITCH, BUFB = VOFF + 128 * VPITCH;
    constexpr float SL = 0.10411755f;
    bf16x8 qf[12];
    { const bf16_t* qrow = Qp + (size_t)(wid * 32 + ql) * 1536 + h * 192;
#pragma unroll
      for (int ks = 0; ks < 12; ++ks) qf[ks] = *(const bf16x8*)(qrow + ks * 16 + hh * 8); }
    if (rope) {
        const int t = tq0 + wid * 32 + ql; const int rp = t >> 6, cp = t & 63;
#pragma unroll
        for (int j = 0; j < 8; ++j) {
            float2 cs = rt[rp * 16 + 8 * hh + j]; float c = cs.x, s = cs.y;
            { const float x1 = bf2f((bf16_t)qf[8][j]), x2 = bf2f((bf16_t)qf[9][j]); qf[8][j] = (short)f2bf(x1 * c - x2 * s); qf[9][j] = (short)f2bf(x1 * s + x2 * c); }
            cs = rt[cp * 16 + 8 * hh + j]; c = cs.x; s = cs.y;
            { const float x1 = bf2f((bf16_t)qf[10][j]), x2 = bf2f((bf16_t)qf[11][j]); qf[10][j] = (short)f2bf(x1 * c - x2 * s); qf[11][j] = (short)f2bf(x1 * s + x2 * c); }
        }
    }
    f32x16 oacc[4];
#pragma unroll
    for (int db = 0; db < 4; ++db)
#pragma unroll
        for (int r = 0; r < 16; ++r) oacc[db][r] = 0.f;
    float m_run = -1e30f, l_run = 0.f;
    const int ntile = nt0 + nt1;
    u32x4 kst[3], vst[2];
    auto issueK = [&](int j) {
        const bool s1 = j >= nt0; const int key0 = (s1 ? j - nt0 : j) * 64;
        const bf16_t* kn = s1 ? kn1 : kn0; const bf16_t* kr = s1 ? kr1 : kr0;
#pragma unroll
        for (int i = 0; i < 2; ++i) { const int id = tid + 512 * i, key = id >> 4, c = id & 15;
            kst[i] = *(const u32x4*)(kn + (size_t)(key0 + key) * 1024 + h * 128 + c * 8); }
        { const int key = tid >> 3, c = tid & 7;
            kst[2] = *(const u32x4*)(kr + (size_t)(key0 + key) * 64 + c * 8); } };
    auto issueV = [&](int j) {
        const bool s1 = j >= nt0; const int key0 = (s1 ? j - nt0 : j) * 64;
        const bf16_t* vt = s1 ? vt1 : vt0; const int ldv = s1 ? ldv1 : ldv0;
#pragma unroll
        for (int i = 0; i < 2; ++i) { const int id = tid + 512 * i, d = id >> 3, c = id & 7;
            vst[i] = *(const u32x4*)(vt + (size_t)(h * 128 + d) * ldv + key0 + c * 8); } };
    auto commitK = [&](int buf) {
        LAS unsigned char* base = lds + buf * BUFB;
#pragma unroll
        for (int i = 0; i < 2; ++i) { const int id = tid + 512 * i, key = id >> 4, c = id & 15; *(LAS u32x4*)(base + key * KPITCH + c * 16) = kst[i]; }
        { const int key = tid >> 3, c = tid & 7; *(LAS u32x4*)(base + key * KPITCH + (16 + c) * 16) = kst[2]; } };
    auto commitV = [&](int buf) {
        LAS unsigned char* base = lds + buf * BUFB + VOFF;
#pragma unroll
        for (int i = 0; i < 2; ++i) { const int id = tid + 512 * i, d = id >> 3, c = id & 7; LAS u32x2* p = (LAS u32x2*)(base + d * VPITCH + c * 16);
            u32x2 a; a.x = vst[i].x; a.y = vst[i].y; u32x2 b; b.x = vst[i].z; b.y = vst[i].w; p[0] = a; p[1] = b; } };
    auto wgbar = [&]() { asm volatile("s_waitcnt lgkmcnt(0)" ::: "memory"); __builtin_amdgcn_s_barrier(); asm volatile("" ::: "memory"); };
    f32x16 s0, s1;
    auto scores = [&](int j) {
        const LAS unsigned char* Kb = lds + (j & 1) * BUFB;
#pragma unroll
        for (int r = 0; r < 16; ++r) { s0[r] = 0.f; s1[r] = 0.f; }
        const LAS unsigned char* kp0 = Kb + ql * KPITCH + hh * 16; const LAS unsigned char* kp1 = Kb + (32 + ql) * KPITCH + hh * 16;
        bf16x8 k0c = *(const LAS bf16x8*)kp0, k1c = *(const LAS bf16x8*)kp1;
#pragma unroll
        for (int ks = 0; ks < 12; ++ks) {
            bf16x8 k0n = k0c, k1n = k1c;
            if (ks < 11) { k0n = *(const LAS bf16x8*)(kp0 + (ks + 1) * 32); k1n = *(const LAS bf16x8*)(kp1 + (ks + 1) * 32); }
            __builtin_amdgcn_sched_barrier(0);
            s0 = __builtin_amdgcn_mfma_f32_32x32x16_bf16(k0c, qf[ks], s0, 0, 0, 0);
            s1 = __builtin_amdgcn_mfma_f32_32x32x16_bf16(k1c, qf[ks], s1, 0, 0, 0);
            __builtin_amdgcn_sched_barrier(0);
            k0c = k0n; k1c = k1n;
        }
        float mx = s0[0];
#pragma unroll
        for (int r = 0; r < 16; ++r) { mx = fmaxf(mx, s0[r]); mx = fmaxf(mx, s1[r]); }
        mx = fmaxf(mx, shx(mx, 32, lane));
        const bool grow = (mx - m_run) * SL > 8.0f;
        if (__builtin_amdgcn_ballot_w64(grow) != 0ull) {
            const float m_new = grow ? mx : m_run; const float alpha = exp2f((m_run - m_new) * SL); m_run = m_new;
            l_run *= alpha;
#pragma unroll
            for (int db = 0; db < 4; ++db)
#pragma unroll
                for (int r = 0; r < 16; ++r) oacc[db][r] *= alpha;
        }
    };
    auto pv = [&](int j) {
        { float ps = 0.f; const float mb = m_run * SL;
#pragma unroll
          for (int r = 0; r < 16; ++r) { s0[r] = exp2f(s0[r] * SL - mb); s1[r] = exp2f(s1[r] * SL - mb); ps += s0[r] + s1[r]; }
          l_run += ps; }
        const LAS unsigned char* vbase = lds + (j & 1) * BUFB + VOFF + ql * VPITCH + hh * 8;
        bf16x8 vc = read_perm(vbase);
#pragma unroll
        for (int it = 0; it < 16; ++it) {
            const int kb = it >> 3, sp = (it >> 2) & 1, db = it & 3;
            bf16x8 vn = vc;
            if (it < 15) { const int kb2 = (it + 1) >> 3, sp2 = ((it + 1) >> 2) & 1, db2 = (it + 1) & 3; vn = read_perm(vbase + db2 * 32 * VPITCH + (32 * kb2 + 16 * sp2) * 2); }
            const bf16x8 pf = pack8(kb == 0 ? s0 : s1, sp);
            __builtin_amdgcn_sched_barrier(0);
            if (db == 0) oacc[0] = __builtin_amdgcn_mfma_f32_32x32x16_bf16(vc, pf, oacc[0], 0, 0, 0);
            if (db == 1) oacc[1] = __builtin_amdgcn_mfma_f32_32x32x16_bf16(vc, pf, oacc[1], 0, 0, 0);
            if (db == 2) oacc[2] = __builtin_amdgcn_mfma_f32_32x32x16_bf16(vc, pf, oacc[2], 0, 0, 0);
            if (db == 3) oacc[3] = __builtin_amdgcn_mfma_f32_32x32x16_bf16(vc, pf, oacc[3], 0, 0, 0);
            __builtin_amdgcn_sched_barrier(0);
            vc = vn;
        }
    };
    issueK(0); issueV(0); commitK(0); commitV(0); wgbar();
    if (!grpB) {
        for (int m = 0; m < ntile; ++m) {
            if (m >= 1) commitV(m & 1);
            if (m + 1 < ntile) issueK(m + 1);
            scores(m);
            wgbar();
            if (m + 1 < ntile) { commitK((m + 1) & 1); issueV(m + 1); }
            pv(m);
            wgbar();
        }
        wgbar();
    } else {
        if (1 < ntile) issueK(1);
        wgbar();
        for (int m = 0; m < ntile; ++m) {
            if (m + 1 < ntile) { commitK((m + 1) & 1); issueV(m + 1); }
            scores(m);
            wgbar();
            if (m + 1 < ntile) commitV((m + 1) & 1);
            if (m + 2 < ntile) issueK(m + 2);
            pv(m);
            wgbar();
        }
    }
    const float linv = 4.0f / (l_run + shx(l_run, 32, lane));
    unsigned char* orow = Op + (size_t)(wid * 32 + ql) * 1024 + h * 128;
#pragma unroll
    for (int db = 0; db < 4; ++db)
#pragma unroll
        for (int g = 0; g < 4; ++g) *(unsigned*)(orow + db * 32 + g * 8 + hh * 4) = pk4_fp8(oacc[db][4 * g] * linv, oacc[db][4 * g + 1] * linv, oacc[db][4 * g + 2] * linv, oacc[db][4 * g + 3] * linv);
    __syncthreads();
}

DI void gla_item(LAS unsigned char* lds, const bf16_t* Zseq, int len, int h, int dir, const float* gw, const float* gb,
                 const float* Sin, float* Sout, bf16_t* Oseq) {
    constexpr int QP = 272, KDP = 144, VP = 144;
    LAS unsigned char* QE = lds; LAS unsigned char* KE = lds + 17408; LAS unsigned char* KDT = lds + 34816; LAS unsigned char* VT = lds + 53248;
    LAS float* LR = (LAS float*)(lds + 90112); LAS float* SEG = (LAS float*)(lds + 94208); LAS float* DEC = (LAS float*)(lds + 96256);
    int tid = threadIdx.x; asm volatile("" : "+v"(tid));
    const int wid = tid >> 6, lane = tid & 63, ql = lane & 31, hh = lane >> 5, d = tid & 127, part = tid >> 7;
    float gwr[16];
#pragma unroll
    for (int j = 0; j < 16; ++j) gwr[j] = gw[j * 512 + h * 128 + d];
    const float gbr = gb[h * 128 + d];
    f32x16 S[4];
#pragma unroll
    for (int db = 0; db < 4; ++db)
#pragma unroll
        for (int r = 0; r < 16; ++r) S[db][r] = Sin ? Sin[(size_t)(32 * db + (r & 3) + 8 * (r >> 2) + 4 * hh) * 256 + 32 * wid + ql] : 0.f;
    const int lrcol = dir ? ZC_LRB : ZC_LRF;
    for (int n0 = 0; n0 < len; n0 += 64) {
#pragma unroll
        for (int i = 0; i < 2; ++i) { const int e = tid + 512 * i, row = e >> 4, j = e & 15; const int t = dir ? len - 1 - (n0 + row) : n0 + row;
            LR[e] = bf2f(Zseq[(size_t)t * ZLD + lrcol + j]); }
#pragma unroll
        for (int i = 0; i < 4; ++i) { const int cidx = tid + 512 * i, row = cidx & 63, c8 = cidx >> 6; const int t = dir ? len - 1 - (n0 + row) : n0 + row;
            const u32x4 v = *(const u32x4*)(Zseq + (size_t)t * ZLD + ZC_V + h * 256 + c8 * 8);
            LAS bf16_t* vp = (LAS bf16_t*)(VT + (c8 * 8) * VP + row * 2);
            const unsigned v0 = v.x, v1 = v.y, v2 = v.z, v3 = v.w;
            vp[0 * (VP / 2)] = (bf16_t)v0; vp[1 * (VP / 2)] = (bf16_t)(v0 >> 16); vp[2 * (VP / 2)] = (bf16_t)v1; vp[3 * (VP / 2)] = (bf16_t)(v1 >> 16);
            vp[4 * (VP / 2)] = (bf16_t)v2; vp[5 * (VP / 2)] = (bf16_t)(v2 >> 16); vp[6 * (VP / 2)] = (bf16_t)v3; vp[7 * (VP / 2)] = (bf16_t)(v3 >> 16); }
        bf16_t qraw[16], kraw[16];
#pragma unroll
        for (int ii = 0; ii < 16; ++ii) { const int row = part * 16 + ii; const int t = dir ? len - 1 - (n0 + row) : n0 + row;
            qraw[ii] = Zseq[(size_t)t * ZLD + ZC_Q + h * 128 + d]; kraw[ii] = Zseq[(size_t)t * ZLD + ZC_K + h * 128 + d]; }
        __syncthreads();
        float bl[16]; float run = 0.f;
#pragma unroll
        for (int ii = 0; ii < 16; ++ii) { float z = gbr;
#pragma unroll
            for (int j = 0; j < 16; ++j) z += LR[(part * 16 + ii) * 16 + j] * gwr[j];
            run += (fminf(z, 0.f) - __logf(1.0f + __expf(-fabsf(z)))) * 0.0625f; bl[ii] = run; }
        SEG[part * 128 + d] = run;
        __syncthreads();
        float off = 0.f, blast = 0.f;
#pragma unroll
        for (int pp = 0; pp < 4; ++pp) { const float sg = SEG[pp * 128 + d]; off += (pp < part) ? sg : 0.f; blast += sg; }
        if (part == 0) DEC[d] = __expf(blast);
        unsigned kdp[8];
#pragma unroll
        for (int ii = 0; ii < 16; ++ii) { const int row = part * 16 + ii; const float b = off + bl[ii];
            const float qv = bf2f(qraw[ii]), kv = bf2f(kraw[ii]);
            *(LAS bf16_t*)(QE + row * QP + d * 2) = f2bf(qv * __expf(b));
            *(LAS bf16_t*)(KE + row * QP + d * 2) = f2bf(kv * __expf(-b));
            const unsigned kd = f2bf(kv * __expf(blast - b));
            if (ii & 1) kdp[ii >> 1] |= kd << 16; else kdp[ii >> 1] = kd; }
        { u32x4 a; a.x = kdp[0]; a.y = kdp[1]; a.z = kdp[2]; a.w = kdp[3]; u32x4 b; b.x = kdp[4]; b.y = kdp[5]; b.z = kdp[6]; b.w = kdp[7];
          *(LAS u32x4*)(KDT + d * KDP + part * 32) = a; *(LAS u32x4*)(KDT + d * KDP + part * 32 + 16) = b; }
        __syncthreads();
        f32x16 att00, att01, att11, o0, o1;
#pragma unroll
        for (int r = 0; r < 16; ++r) { att00[r] = 0.f; att01[r] = 0.f; att11[r] = 0.f; o0[r] = 0.f; o1[r] = 0.f; }
#pragma unroll
        for (int ks = 0; ks < 8; ++ks) {
            const int co = (ks * 16 + hh * 8) * 2;
            const bf16x8 kf0 = *(const LAS bf16x8*)(KE + ql * QP + co), kf1 = *(const LAS bf16x8*)(KE + (32 + ql) * QP + co);
            const bf16x8 qf0 = *(const LAS bf16x8*)(QE + ql * QP + co), qf1 = *(const LAS bf16x8*)(QE + (32 + ql) * QP + co);
            att00 = __builtin_amdgcn_mfma_f32_32x32x16_bf16(kf0, qf0, att00, 0, 0, 0);
            att01 = __builtin_amdgcn_mfma_f32_32x32x16_bf16(kf0, qf1, att01, 0, 0, 0);
            att11 = __builtin_amdgcn_mfma_f32_32x32x16_bf16(kf1, qf1, att11, 0, 0, 0);
            if (ks & 1) __builtin_amdgcn_sched_barrier(0);
        }
#pragma unroll
        for (int r = 0; r < 16; ++r) { const int srow = (r & 3) + 8 * (r >> 2) + 4 * hh; if (srow > ql) { att00[r] = 0.f; att11[r] = 0.f; } }
        const LAS unsigned char* vrow = VT + (32 * wid + ql) * VP + hh * 8;
#pragma unroll
        for (int sp = 0; sp < 2; ++sp) {
            const bf16x8 va = read_perm(vrow + (16 * sp) * 2), vb = read_perm(vrow + (32 + 16 * sp) * 2);
            o0 = __builtin_amdgcn_mfma_f32_32x32x16_bf16(va, pack8(att00, sp), o0, 0, 0, 0);
            o1 = __builtin_amdgcn_mfma_f32_32x32x16_bf16(va, pack8(att01, sp), o1, 0, 0, 0);
            o1 = __builtin_amdgcn_mfma_f32_32x32x16_bf16(vb, pack8(att11, sp), o1, 0, 0, 0);
        }
#pragma unroll
        for (int db = 0; db < 4; ++db)
#pragma unroll
            for (int sp = 0; sp < 2; ++sp) {
                const bf16x8 sa = pack8(S[db], sp);
                const int co = (32 * db + 16 * sp + 4 * hh) * 2;
                const bf16x8 qb0 = read_perm(QE + ql * QP + co), qb1 = read_perm(QE + (32 + ql) * QP + co);
                o0 = __builtin_amdgcn_mfma_f32_32x32x16_bf16(sa, qb0, o0, 0, 0, 0);
                o1 = __builtin_amdgcn_mfma_f32_32x32x16_bf16(sa, qb1, o1, 0, 0, 0);
                if (sp) __builtin_amdgcn_sched_barrier(0);
            }
#pragma unroll
        for (int db = 0; db < 4; ++db) {
#pragma unroll
            for (int g4 = 0; g4 < 4; ++g4) { const f32x4 dc = *(const LAS f32x4*)(DEC + 32 * db + 8 * g4 + 4 * hh);
#pragma unroll
                for (int i = 0; i < 4; ++i) S[db][4 * g4 + i] *= dc[i]; }
#pragma unroll
            for (int ks = 0; ks < 4; ++ks) {
                const bf16x8 af = *(const LAS bf16x8*)(KDT + (32 * db + ql) * KDP + (16 * ks + 8 * hh) * 2);
                const bf16x8 bv = *(const LAS bf16x8*)(VT + (32 * wid + ql) * VP + (16 * ks + 8 * hh) * 2);
                S[db] = __builtin_amdgcn_mfma_f32_32x32x16_bf16(af, bv, S[db], 0, 0, 0);
            }
            __builtin_amdgcn_sched_barrier(0);
        }
#pragma unroll
        for (int tb = 0; tb < 2; ++tb) { const int row = 32 * tb + ql; const int t = dir ? len - 1 - (n0 + row) : n0 + row;
            bf16_t* op = Oseq + (size_t)t * 1024 + h * 256 + 32 * wid + 4 * hh;
#pragma unroll
            for (int g4 = 0; g4 < 4; ++g4) { u32x2 w2;
                if (tb == 0) { w2.x = pk2(o0[4 * g4], o0[4 * g4 + 1]); w2.y = pk2(o0[4 * g4 + 2], o0[4 * g4 + 3]); }
                else { w2.x = pk2(o1[4 * g4], o1[4 * g4 + 1]); w2.y = pk2(o1[4 * g4 + 2], o1[4 * g4 + 3]); }
                *(u32x2*)(op + 8 * g4) = w2; } }
        __syncthreads();
    }
    if (Sout) {
#pragma unroll
        for (int db = 0; db < 4; ++db)
#pragma unroll
            for (int r = 0; r < 16; ++r) Sout[(size_t)(32 * db + (r & 3) + 8 * (r >> 2) + 4 * hh) * 256 + 32 * wid + ql] = S[db][r]; }
}

DI void phase_glafin(const bf16_t* OF, const bf16_t* OB, const bf16_t* Z, const float* gg, int rows, bf16_t* GF) {
    const int tid_ = ltid(); const int lane = tid_ & 63, wid = tid_ >> 6;
    const float4 g4 = *(const float4*)(gg + lane * 4);
    for (int r = lbid() * 8 + wid; r < rows; r += lgdim() * 8) {
#pragma unroll
        for (int h = 0; h < 4; ++h) {
            const int c = h * 256 + lane * 4;
            const u32x2 a = *(const u32x2*)(OF + (size_t)r * 1024 + c), b = *(const u32x2*)(OB + (size_t)r * 1024 + c), rr = *(const u32x2*)(Z + (size_t)r * ZLD + ZC_R + c);
            const float s0 = lo2f(a.x) + lo2f(b.x), s1 = hi2f(a.x) + hi2f(b.x), s2 = lo2f(a.y) + lo2f(b.y), s3 = hi2f(a.y) + hi2f(b.y);
            const float ss = wave_sum(s0 * s0 + s1 * s1 + s2 * s2 + s3 * s3, lane);
            const float rstd = rsqrtf(ss * (1.0f / 256.0f) + 1e-6f);
            const float r0 = lo2f(rr.x), r1 = hi2f(rr.x), r2 = lo2f(rr.y), r3 = hi2f(rr.y);
            *(unsigned*)((unsigned char*)GF + (size_t)r * 1024 + c) = pk4_fp8(s0 * rstd * g4.x * (r0 * sigmoidf_(r0)), s1 * rstd * g4.y * (r1 * sigmoidf_(r1)), s2 * rstd * g4.z * (r2 * sigmoidf_(r2)), s3 * rstd * g4.w * (r3 * sigmoidf_(r3)));
        }
    }
}

DI unsigned fkey(float f) { const unsigned u = __float_as_uint(f); return u ^ ((unsigned)((int)u >> 31) | 0x80000000u); }
DI float unfkey(unsigned k) { return __uint_as_float((k & 0x80000000u) ? (k ^ 0x80000000u) : ~k); }
DI void key_insert(unsigned (&t)[16], unsigned k) {
#pragma unroll
    for (int j = 0; j < 16; ++j) { const unsigned hi = t[j] > k ? t[j] : k; const unsigned lo = t[j] > k ? k : t[j]; t[j] = hi; k = lo; }
}
DI void phase_select(const _Float16* SC, int rows, uint2* ROUTE, unsigned short* EID, LAS unsigned char* lds) {
    const int tid_ = ltid(); const int lane = tid_ & 63, wid = tid_ >> 6;
    LAS float* T = (LAS float*)lds + wid * (64 * 65);
    for (int pbase = (lbid() * 8 + wid) * 64; pbase < rows * 8; pbase += lgdim() * 8 * 64) {
        const int p = pbase + lane;
        unsigned k1[16], k2[16];
#pragma unroll
        for (int j = 0; j < 16; ++j) { k1[j] = 0u; k2[j] = 0u; }
#pragma unroll
        for (int pass = 0; pass < 4; ++pass) {
#pragma unroll
            for (int k = 0; k < 8; ++k) { const int pp = 8 * k + (lane >> 3), c8 = lane & 7;
                const h16x8 v = *(const h16x8*)(SC + (size_t)(pbase + pp) * 256 + pass * 32 + (c8 & 3) * 8 + (c8 >> 2) * 128);
                LAS float* tp = T + (8 * c8) * 65 + pp;
#pragma unroll
                for (int c = 0; c < 8; ++c) tp[c * 65] = (float)v[c]; }
            for (int f = 0; f < 32; ++f) { const float va = T[f * 65 + lane], vb = T[(32 + f) * 65 + lane]; const unsigned ix = (unsigned)(127 - (pass * 32 + f));
                key_insert(k1, (fkey(va) & ~127u) | ix); key_insert(k2, (fkey(vb) & ~127u) | ix); }
        }
        float t1[16], t2[16]; unsigned i1p[4] = {0u, 0u, 0u, 0u}, i2p[4] = {0u, 0u, 0u, 0u};
#pragma unroll
        for (int j = 0; j < 16; ++j) { t1[j] = unfkey(k1[j] & ~127u); t2[j] = unfkey(k2[j] & ~127u);
            i1p[j >> 2] |= (127u - (k1[j] & 127u)) << (8 * (j & 3)); i2p[j >> 2] |= (127u - (k2[j] & 127u)) << (8 * (j & 3)); }
        unsigned kc[16];
#pragma unroll
        for (int j = 0; j < 16; ++j) kc[j] = 0u;
#pragma unroll
        for (int a = 0; a < 16; ++a)
#pragma unroll
            for (int b = 0; b < 16; ++b)
                if ((a + 1) * (b + 1) <= 16) key_insert(kc, (fkey(t1[a] + t2[b]) & ~255u) | (unsigned)(a * 16 + b));
        float e[16]; unsigned ei[16]; float mx = -3.0e38f;
#pragma unroll
        for (int j = 0; j < 16; ++j) { const unsigned a = (kc[j] >> 4) & 15u, b = kc[j] & 15u;
            const unsigned wa = (a >> 2) == 0u ? i1p[0] : (a >> 2) == 1u ? i1p[1] : (a >> 2) == 2u ? i1p[2] : i1p[3];
            const unsigned wb = (b >> 2) == 0u ? i2p[0] : (b >> 2) == 1u ? i2p[1] : (b >> 2) == 2u ? i2p[2] : i2p[3];
            ei[j] = (((wa >> (8 * (a & 3u))) & 127u) << 7) | ((wb >> (8 * (b & 3u))) & 127u);
            e[j] = unfkey(kc[j] & ~255u); mx = fmaxf(mx, e[j]); }
        float sum = 0.f;
#pragma unroll
        for (int j = 0; j < 16; ++j) { e[j] = __expf(e[j] - mx); sum += e[j]; }
        const float inv = 1.0f / sum;
        uint2* dst = ROUTE + (size_t)p * 16; unsigned short* de = EID + (size_t)p * 16;
#pragma unroll
        for (int j = 0; j < 16; ++j) { dst[j] = make_uint2(ei[j], __float_as_uint(e[j] * inv)); de[j] = (unsigned short)ei[j]; }
    }
}

DI float dot2u(unsigned a, unsigned b, float acc) { return __builtin_amdgcn_fdot2_f32_bf16(__builtin_bit_cast(bf16x2_t, a), __builtin_bit_cast(bf16x2_t, b), acc, false); }
DI float dot8(const u32x4& a, const u32x4& b, float acc) {
    const unsigned a0 = a.x, a1 = a.y, a2 = a.z, a3 = a.w, b0 = b.x, b1 = b.y, b2 = b.z, b3 = b.w;
    acc = dot2u(a0, b0, acc); acc = dot2u(a1, b1, acc); acc = dot2u(a2, b2, acc); acc = dot2u(a3, b3, acc);
    return acc;
}
template <int CTRL> DI float dppf(float v) { return __builtin_bit_cast(float, __builtin_amdgcn_update_dpp(0, __builtin_bit_cast(int, v), CTRL, 0xF, 0xF, true)); }
typedef float f32x2_t __attribute__((ext_vector_type(2)));
DI void phase_peer_u(const bf16_t* H2, const unsigned short* EID, const unsigned char* PU, int rows, float* PART) {
    const int tid_ = ltid(); const int lane = tid_ & 63, wid = tid_ >> 6, g = lane >> 3, pc = lane & 7;
    const int x = lbid() & 7, gw = (lbid() >> 3) * 8 + wid, nw = (lgdim() >> 3) * 8;
    const unsigned lbase = ((unsigned)x << 21) + (unsigned)(pc * 16);
    auto finish = [&](int r, const u32x4 (&uv)[16], const u32x4& h0, const u32x4& h1) {
        f32x2_t hp[8];
        { const unsigned a0 = h0.x, a1 = h0.y, a2 = h0.z, a3 = h0.w, b0 = h1.x, b1 = h1.y, b2 = h1.z, b3 = h1.w;
          hp[0] = (f32x2_t){lo2f(a0), hi2f(a0)}; hp[1] = (f32x2_t){lo2f(a1), hi2f(a1)}; hp[2] = (f32x2_t){lo2f(a2), hi2f(a2)}; hp[3] = (f32x2_t){lo2f(a3), hi2f(a3)};
          hp[4] = (f32x2_t){lo2f(b0), hi2f(b0)}; hp[5] = (f32x2_t){lo2f(b1), hi2f(b1)}; hp[6] = (f32x2_t){lo2f(b2), hi2f(b2)}; hp[7] = (f32x2_t){lo2f(b3), hi2f(b3)}; }
        float a[16];
#pragma unroll
        for (int j = 0; j < 16; ++j) {
            const unsigned w0 = uv[j].x, w1 = uv[j].y, w2 = uv[j].z, w3 = uv[j].w;
            f32x2_t s = __builtin_amdgcn_cvt_pk_f32_fp8((int)w0, false) * hp[0];
            s = __builtin_elementwise_fma(__builtin_amdgcn_cvt_pk_f32_fp8((int)w0, true), hp[1], s);
            s = __builtin_elementwise_fma(__builtin_amdgcn_cvt_pk_f32_fp8((int)w1, false), hp[2], s);
            s = __builtin_elementwise_fma(__builtin_amdgcn_cvt_pk_f32_fp8((int)w1, true), hp[3], s);
            s = __builtin_elementwise_fma(__builtin_amdgcn_cvt_pk_f32_fp8((int)w2, false), hp[4], s);
            s = __builtin_elementwise_fma(__builtin_amdgcn_cvt_pk_f32_fp8((int)w2, true), hp[5], s);
            s = __builtin_elementwise_fma(__builtin_amdgcn_cvt_pk_f32_fp8((int)w3, false), hp[6], s);
            s = __builtin_elementwise_fma(__builtin_amdgcn_cvt_pk_f32_fp8((int)w3, true), hp[7], s);
            a[j] = s[0] + s[1];
        }
        const bool u4 = (pc & 4) != 0, u2 = (pc & 2) != 0, u1 = (pc & 1) != 0;
        float k8[8], k4[4], k2[2];
#pragma unroll
        for (int i = 0; i < 8; ++i) { const float send = u4 ? a[i] : a[i + 8]; k8[i] = (u4 ? a[i + 8] : a[i]) + dppf<0x141>(send); }
#pragma unroll
        for (int i = 0; i < 4; ++i) { const float send = u2 ? k8[i] : k8[i + 4]; k4[i] = (u2 ? k8[i + 4] : k8[i]) + dppf<0x4E>(send); }
#pragma unroll
        for (int i = 0; i < 2; ++i) { const float send = u1 ? k4[i] : k4[i + 2]; k2[i] = (u1 ? k4[i + 2] : k4[i]) + dppf<0xB1>(send); }
        if (r < rows) *(float2*)(PART + (unsigned)((r * 8 + x) * 128 + g * 16 + 2 * pc)) = make_float2(k2[0] * 0.03125f, k2[1] * 0.03125f); };
    auto ids = [&](int r, unsigned (&e)[8]) { const int rr = r < rows ? r : rows - 1;
        const u32x4* ep = (const u32x4*)(EID + (unsigned)(rr * 128 + g * 16)); const u32x4 t0 = ep[0], t1 = ep[1];
        e[0] = t0.x; e[1] = t0.y; e[2] = t0.z; e[3] = t0.w; e[4] = t1.x; e[5] = t1.y; e[6] = t1.z; e[7] = t1.w; };
    auto issue = [&](int r, const unsigned (&e)[8], u32x4 (&uv)[16], u32x4& h0, u32x4& h1) {
#pragma unroll
        for (int j = 0; j < 16; ++j) uv[j] = *(const u32x4*)(PU + ((((j & 1) ? (e[j >> 1] >> 16) : (e[j >> 1] & 0xffffu)) << 7) + lbase));
        const int rr = r < rows ? r : rows - 1;
        const u32x4* hp = (const u32x4*)(H2 + (unsigned)(rr * 1024 + x * 128 + pc * 16)); h0 = hp[0]; h1 = hp[1]; };
    unsigned eA[8], eB[8]; u32x4 hA0, hA1, hB0, hB1; u32x4 uA[16], uB[16];
    ids(gw, eA); ids(gw + nw, eB);
    issue(gw, eA, uA, hA0, hA1); ids(gw + 2 * nw, eA);
    issue(gw + nw, eB, uB, hB0, hB1); ids(gw + 3 * nw, eB);
    for (int r = gw; r < rows; r += 2 * nw) {
        __builtin_amdgcn_sched_barrier(0);
        finish(r, uA, hA0, hA1);
        __builtin_amdgcn_sched_barrier(0);
        issue(r + 2 * nw, eA, uA, hA0, hA1); ids(r + 4 * nw, eA);
        __builtin_amdgcn_sched_barrier(0);
        finish(r + nw, uB, hB0, hB1);
        __builtin_amdgcn_sched_barrier(0);
        issue(r + 3 * nw, eB, uB, hB0, hB1); ids(r + 5 * nw, eB);
    }
}
DI void phase_peer_w(const float* PART, const uint2* ROUTE, int rows, bf16_t* WG) {
    const int tid_ = ltid(); const int lane = tid_ & 63, wid = tid_ >> 6;
    for (int r = lbid() * 8 + wid; r < rows; r += lgdim() * 8) {
        float a0 = 0.f, a1 = 0.f;
#pragma unroll
        for (int x = 0; x < 8; ++x) { const float* pp = PART + ((size_t)r * 8 + x) * 128; a0 += pp[lane]; a1 += pp[64 + lane]; }
        const float g0 = __uint_as_float(ROUTE[(size_t)r * 128 + lane].y), g1 = __uint_as_float(ROUTE[(size_t)r * 128 + 64 + lane].y);
        WG[(size_t)r * 128 + lane] = f2bf(g0 * 0.5f * a0 * (1.0f + erff(a0 * 0.70710678118654752f)));
        WG[(size_t)r * 128 + 64 + lane] = f2bf(g1 * 0.5f * a1 * (1.0f + erff(a1 * 0.70710678118654752f)));
    }
}
DI void phase_peer_v(const bf16_t* WG, const unsigned short* EID, const unsigned char* PV, const float* mod, int is_ctx, int b0, int rows, bf16_t* X, bool dry) {
    const int tid_ = ltid(); const int lane = tid_ & 63, wid = tid_ >> 6, g = lane >> 3, pc = lane & 7;
    const int x = lbid() & 7, gw = (lbid() >> 3) * 8 + wid, nw = (lgdim() >> 3) * 8;
    const unsigned lbase = ((unsigned)x << 21) + (unsigned)(pc * 16);
    const int mydim = x * 128 + pc * 16 + 8 * ((lane >> 5) & 1) + 4 * ((lane >> 4) & 1) + 2 * ((lane >> 3) & 1);
    auto meta = [&](int r, unsigned (&e)[8]) {
        const int rr = r < rows ? r : rows - 1;
        const u32x4* ep = (const u32x4*)(EID + (unsigned)(rr * 128 + g * 16)); const u32x4 t0 = ep[0], t1 = ep[1];
        e[0] = t0.x; e[1] = t0.y; e[2] = t0.z; e[3] = t0.w; e[4] = t1.x; e[5] = t1.y; e[6] = t1.z; e[7] = t1.w; };
    auto wload = [&](int r, unsigned (&w)[8]) {
        const int rr = r < rows ? r : rows - 1;
        const u32x4* wp = (const u32x4*)(WG + (unsigned)(rr * 128 + g * 16)); const u32x4 t0 = wp[0], t1 = wp[1];
        w[0] = t0.x; w[1] = t0.y; w[2] = t0.z; w[3] = t0.w; w[4] = t1.x; w[5] = t1.y; w[6] = t1.z; w[7] = t1.w; };
    auto xload = [&](int r, unsigned& xw, float2& m) {
        const int rr = r < rows ? r : rows - 1; const int bi = is_ctx ? 32 : b0 + (rr >> 11);
        m = *(const float2*)(mod + (unsigned)(bi * 6144 + 5 * 1024 + mydim)); xw = *(const unsigned*)(X + (unsigned)(rr * 1024 + mydim)); };
    auto finish = [&](int r, const u32x4 (&vv)[16], const unsigned (&w)[8], const unsigned xw, const float2 m) {
        float o[16];
#pragma unroll
        for (int i = 0; i < 16; ++i) o[i] = 0.f;
#pragma unroll
        for (int j = 0; j < 16; ++j) { const unsigned w0 = vv[j].x, w1 = vv[j].y, w2 = vv[j].z, w3 = vv[j].w; const float wj = (j & 1) ? hi2f(w[j >> 1]) : lo2f(w[j >> 1]);
            { const f32x2_t l = __builtin_amdgcn_cvt_pk_f32_fp8((int)w0, false), h2 = __builtin_amdgcn_cvt_pk_f32_fp8((int)w0, true); o[0] += wj * l[0]; o[1] += wj * l[1]; o[2] += wj * h2[0]; o[3] += wj * h2[1]; }
            { const f32x2_t l = __builtin_amdgcn_cvt_pk_f32_fp8((int)w1, false), h2 = __builtin_amdgcn_cvt_pk_f32_fp8((int)w1, true); o[4] += wj * l[0]; o[5] += wj * l[1]; o[6] += wj * h2[0]; o[7] += wj * h2[1]; }
            { const f32x2_t l = __builtin_amdgcn_cvt_pk_f32_fp8((int)w2, false), h2 = __builtin_amdgcn_cvt_pk_f32_fp8((int)w2, true); o[8] += wj * l[0]; o[9] += wj * l[1]; o[10] += wj * h2[0]; o[11] += wj * h2[1]; }
            { const f32x2_t l = __builtin_amdgcn_cvt_pk_f32_fp8((int)w3, false), h2 = __builtin_amdgcn_cvt_pk_f32_fp8((int)w3, true); o[12] += wj * l[0]; o[13] += wj * l[1]; o[14] += wj * h2[0]; o[15] += wj * h2[1]; } }
        float k8[8], k4[4], k2[2];
#pragma unroll
        for (int i = 0; i < 8; ++i) { const bool up = (lane & 32) != 0; const float send = up ? o[i] : o[i + 8]; k8[i] = (up ? o[i + 8] : o[i]) + shx(send, 32, lane); }
#pragma unroll
        for (int i = 0; i < 4; ++i) { const bool up = (lane & 16) != 0; const float send = up ? k8[i] : k8[i + 4]; k4[i] = (up ? k8[i + 4] : k8[i]) + shx(send, 16, lane); }
#pragma unroll
        for (int i = 0; i < 2; ++i) { const bool up = (lane & 8) != 0; const float send = up ? k4[i] : k4[i + 2]; k2[i] = (up ? k4[i + 2] : k4[i]) + dppf<0x128>(send); }
        if (dry && k2[0] != 12345.678f) return;
        if (r < rows) { unsigned* xr = (unsigned*)(X + (unsigned)(r * 1024 + mydim)); *xr = pk2(lo2f(xw) + m.x * k2[0], hi2f(xw) + m.y * k2[1]); } };
    unsigned eA[8];
    meta(gw, eA);
    for (int r = gw; r < rows; r += nw) {
        u32x4 vA[16]; unsigned wA[8]; unsigned xw; float2 m;
#pragma unroll
        for (int j = 0; j < 16; ++j) vA[j] = *(const u32x4*)(PV + ((((j & 1) ? (eA[j >> 1] >> 16) : (eA[j >> 1] & 0xffffu)) << 7) + lbase));
        wload(r, wA); xload(r, xw, m);
        meta(r + nw, eA);
        finish(r, vA, wA, xw, m);
    }
}

DI void phase_final(const bf16_t* xb, float* out, const float* gain, int rows) {
    const int tid_ = ltid(); const int lane = tid_ & 63, wid = tid_ >> 6;
    for (int r = lbid() * 8 + wid; r < rows; r += lgdim() * 8) {
        float4 v[4]; float ss = 0.f;
#pragma unroll
        for (int j = 0; j < 4; ++j) { const u32x2 w = ((const u32x2*)(xb + (size_t)r * 1024))[lane + 64 * j]; v[j] = make_float4(lo2f(w.x), hi2f(w.x), lo2f(w.y), hi2f(w.y));
            ss += v[j].x * v[j].x + v[j].y * v[j].y + v[j].z * v[j].z + v[j].w * v[j].w; }
        ss = wave_sum(ss, lane);
        const float rstd = rsqrtf(ss * (1.0f / 1024.0f) + 1e-6f);
        float4* orow = (float4*)(out + (size_t)r * 1024);
#pragma unroll
        for (int j = 0; j < 4; ++j) { const float4 g = *(const float4*)(gain + (lane + 64 * j) * 4);
            float4 o; o.x = v[j].x * rstd * g.x; o.y = v[j].y * rstd * g.y; o.z = v[j].z * rstd * g.z; o.w = v[j].w * rstd * g.w; orow[lane + 64 * j] = o; }
    }
}

enum { PH_NORM1 = 0, PH_INPROJ, PH_PREP, PH_UPPROJ, PH_MIX, PH_INPROJ2, PH_GLAFIN, PH_BRANCH, PH_WOUT, PH_NORM2, PH_WQ, PH_SELECT, PH_PEERU, PH_PEERW, PH_PEERV, PH_COUNT };

struct RunArgs { int mode;
                 int layer, chunk, phase; };

struct Bufs { bf16_t *H, *Z, *QB, *KN, *VT, *KR, *OF, *OB, *MLA, *PD, *PO, *GF, *MMB, *PQ; float *RS, *MMF, *CST, *PART; _Float16* SC; bf16_t* WG; unsigned short* EID; uint2* ROUTE; const bf16_t* W; const float* mod; unsigned* ctl; };
DI Bufs make_bufs(const Params& P, int is_ctx, int layer) {
    __attribute__((address_space(1))) unsigned char* gws = (__attribute__((address_space(1))) unsigned char*)P.ws; asm volatile("" : "+s"(gws));
    unsigned char* ws = (unsigned char*)gws; asm volatile("" : "+s"(layer));
    Bufs B;
    B.H = (bf16_t*)(ws + WS_H); B.Z = (bf16_t*)(ws + WS_Z); B.QB = (bf16_t*)(ws + WS_QB);
    B.KN = (bf16_t*)(ws + (is_ctx ? WS_CKN : WS_KN)); B.VT = (bf16_t*)(ws + (is_ctx ? WS_CVT : WS_VT)); B.KR = (bf16_t*)(ws + (is_ctx ? WS_CKR : WS_KR));
    B.RS = (float*)(ws + WS_RS); B.OF = (bf16_t*)(ws + WS_OF); B.OB = (bf16_t*)(ws + WS_OB); B.MLA = (bf16_t*)(ws + WS_MLA);
    B.PD = (bf16_t*)(ws + WS_PD); B.PO = (bf16_t*)(ws + WS_PO); B.GF = B.PO; B.MMF = (float*)(ws + WS_OF); B.MMB = (bf16_t*)(ws + WS_VT);
    B.PQ = B.QB; B.SC = (_Float16*)(ws + WS_Z); B.ROUTE = (uint2*)(ws + WS_ROUTE); B.PART = (float*)(ws + WS_Z + 128 * MiB); B.WG = (bf16_t*)(ws + WS_Z + 192 * MiB); B.EID = (unsigned short*)(ws + WS_Z + 200 * MiB); B.CST = (float*)(ws + WS_CST);
    B.W = (const bf16_t*)(ws + WS_W) + (size_t)layer * W_LAYER; B.mod = (const float*)(ws + WS_MOD) + (size_t)layer * 33 * 6144; B.ctl = (unsigned*)(ws + WS_CTL);
    return B;
}

DI Params kparams() {
    Params P;
#if defined(__HIP_DEVICE_COMPILE__)
    typedef const void* cvp; typedef const __attribute__((address_space(1))) void* gvp;
    const __attribute__((address_space(4))) gvp* q = (const __attribute__((address_space(4))) gvp*)__builtin_amdgcn_kernarg_segment_ptr();
    asm volatile("" : "+s"(q));
#pragma unroll
    for (int i = 0; i < (int)(sizeof(Params) / sizeof(void*)); ++i) ((cvp*)&P)[i] = (cvp)q[i];
#endif
    return P;
}

__global__ void __launch_bounds__(NTHR, 2) fwd_kernel(Params Pk, RunArgs R) {
    extern __shared__ __attribute__((aligned(16))) unsigned char smem[];
    LAS unsigned char* lds = (LAS unsigned char*)smem;
    LAS unsigned* ctlw = (LAS unsigned*)(lds + LDS_BYTES - 64);
    unsigned* ctl = (unsigned*)(Pk.ws + WS_CTL);
    if (threadIdx.x == 0) { ctlw[0] = 0u; ctlw[1] = 0u; ctlw[2] = 0u; ctlw[3] = 0u; }
    __syncthreads();
    XcdBarrier bar; bar.bar = ctl; bar.x = 0; bar.st = (volatile LAS unsigned*)ctlw;
    const bool single = (R.mode == 0);
    if (single) bar = xcd_barrier_post(ctl, (volatile LAS unsigned*)ctlw);
#define GRID_SYNC() do { if (single) xcd_barrier(bar); } while (0)

    if (R.mode == 0 || R.mode == 1) for (int rep_ = 0; rep_ < ((REP_PHASE) == 100 ? 2 : 1); ++rep_) { const Params P = kparams(); phase_convert(P, lds); phase_mod(P, lds); __syncthreads(); }
    GRID_SYNC();

    if (R.mode == 0 || R.mode == 2) {
    const int l_lo = single ? 0 : R.layer, l_hi = single ? NLAYER : R.layer + 1;
    const int c_lo = single ? 0 : R.chunk, c_hi = single ? 5 : R.chunk + 1;
    for (int layer = l_lo; layer < l_hi; ++layer)
    for (int ci = c_lo; ci < c_hi; ++ci) {
        const bool is_ctx = (ci == 0);
        const bool ctx_kv_only = is_ctx && layer == NLAYER - 1;
#define RUN(ph) (single || lnd(R.phase) == (ph))
#define REP(ph) for (int rep_ = 0; rep_ < (((REP_PHASE) == (ph) || (REP_PHASE) == 999) ? 2 : 1); ++rep_)
#define PHASE_LOCALS const Params P = kparams(); const Chunk ck = make_chunk(P, layer, ci); const Bufs B = make_bufs(P, ck.is_ctx, layer); const int rows = ck.rows, np = ck.np; (void)rows; (void)np;

        if ((REP_PHASE) == 200) { for (int xb = 0; xb < 10; ++xb) GRID_SYNC(); }
        if (RUN(PH_NORM1)) REP(PH_NORM1) { PHASE_LOCALS if (layer == 0) phase_norm<true, true>(ck.x32, rows, P.norm1_g + layer * 1024, B.mod, ck.is_ctx, ck.b0, 0, B.H); else phase_norm<false, true>(ck.xb, rows, P.norm1_g + layer * 1024, B.mod, ck.is_ctx, ck.b0, 0, B.H); }
        GRID_SYNC();
        if (RUN(PH_INPROJ)) REP(PH_INPROJ) { PHASE_LOCALS
            const bf16_t* H = B.H; const bf16_t* W = B.W; bf16_t* Z = B.Z;
            auto S = make_sched(np, 15, [=](Unit& u) { u.pn = (u.pn < 12) ? u.pn : u.pn + 16;
                u.A = (const char*)H + (size_t)u.pm * 256 * 1024; u.B = (const char*)(W + WO_IN) + (size_t)u.pn * 256 * 1024; });
            pg8::gemm_phase<1>(lds, 1024, 1024, 1024, S, [=](const f32x4 (&acc)[2][2][4][2], const Unit& u, int wr, int wc, int fr, int fq) {
                const bool is_gate = false;
                pg8::epi8(acc, wr, wc, fr, fq, [&](int row, int col, const f32x4& a, const f32x4& b) {
                    f32x4 a2 = a, b2 = b;
                    if (is_gate) {
#pragma unroll
                        for (int j = 0; j < 4; ++j) { a2[j] = sigmoidf_(a[j]); b2[j] = sigmoidf_(b[j]); } }
                    store8_bf16(Z + (size_t)(u.pm * 256 + row) * ZLD + u.pn * 256 + col, a2, b2); }); });
        }
        GRID_SYNC();
        if (RUN(PH_PREP)) REP(PH_PREP) { PHASE_LOCALS phase_prep(B.Z, rows, ck.is_ctx, B.RS, B.KR, B.PD, !ctx_kv_only, (const float2*)(P.ws + WS_ROPE)); }
        GRID_SYNC();
        if (RUN(PH_UPPROJ)) REP(PH_UPPROJ) {
            if (!ctx_kv_only) { PHASE_LOCALS
                const bf16_t* Z = B.Z; const bf16_t* W = B.W; bf16_t* QB = B.QB; const float* RS = B.RS;
                auto S = make_sched(np, 6, [=](Unit& u) { u.A = (const char*)(Z + (size_t)u.pm * 256 * ZLD + ZC_QDN); u.B = (const char*)(W + WO_UQ + (size_t)u.pn * 256 * 384); });
                pg8::gemm_phase<2>(lds, ZLD, 384, 384, S, [=](const f32x4 (&acc)[2][2][4][2], const Unit& u, int wr, int wc, int fr, int fq) {
                    pg8::epi8(acc, wr, wc, fr, fq, [&](int row, int col, const f32x4& a, const f32x4& b) { const int gr = u.pm * 256 + row; const float s = RS[gr];
                        store8_bf16(QB + (size_t)gr * 1536 + u.pn * 256 + col, a * s, b * s); }); });
            }
            { PHASE_LOCALS
                const bf16_t* Z = B.Z; const bf16_t* W = B.W; bf16_t* KN = B.KN; const float* RS = B.RS;
                auto S = make_sched(np, 4, [=](Unit& u) { u.A = (const char*)(Z + (size_t)u.pm * 256 * ZLD + ZC_KVDN); u.B = (const char*)(W + WO_KN + (size_t)u.pn * 256 * 256); });
                pg8::gemm_phase<2>(lds, ZLD, 256, 256, S, [=](const f32x4 (&acc)[2][2][4][2], const Unit& u, int wr, int wc, int fr, int fq) {
                    pg8::epi8(acc, wr, wc, fr, fq, [&](int row, int col, const f32x4& a, const f32x4& b) { const int gr = u.pm * 256 + row; const float s = RS[16384 + gr];
                        store8_bf16(KN + (size_t)gr * 1024 + u.pn * 256 + col, a * s, b * s); }); });
            }
            { PHASE_LOCALS
                const bf16_t* Z = B.Z; const bf16_t* W = B.W; bf16_t* VT = B.VT; const float* RS = B.RS;
                auto S = make_sched(4, np, [=](Unit& u) { u.A = (const char*)(W + WO_V + (size_t)u.pm * 256 * 256); u.B = (const char*)(Z + (size_t)u.pn * 256 * ZLD + ZC_KVDN); });
                pg8::gemm_phase<2>(lds, 256, ZLD, 256, S, [=](const f32x4 (&acc)[2][2][4][2], const Unit& u, int wr, int wc, int fr, int fq) {
                    pg8::epi8(acc, wr, wc, fr, fq, [&](int row, int col, const f32x4& a, const f32x4& b) { const int tk = u.pn * 256 + col;
                        const f32x4 r0 = *(const f32x4*)(RS + 16384 + tk), r1 = *(const f32x4*)(RS + 16384 + tk + 4);
                        store8_bf16(VT + (size_t)(u.pm * 256 + row) * rows + tk, a * r0, b * r1); }); });
            }
        }
        GRID_SYNC();
        if (RUN(PH_MIX)) for (int rep_ = 0; rep_ < (((REP_PHASE) == PH_MIX || (REP_PHASE) == 201 || (REP_PHASE) == 202 || (REP_PHASE) == 999) ? 2 : 1); ++rep_) { PHASE_LOCALS
            const int nbat = ck.is_ctx ? NB : 8;
            const int nG = (rep_ != 0 && (REP_PHASE) == 202) ? 0 : nbat * 8;
            const int nA = (rep_ != 0 && (REP_PHASE) == 201) ? 0 : (ck.is_ctx ? (layer == 0 ? NB * 8 : 0) : 8 * 8 * 8);
            unsigned* ctr = B.ctl + CTL_WORKQ + 64 * (layer * 5 + ci) + 64 * 16 * rep_;
            const int seqlen = ck.is_ctx ? TC : TL;
            for (;;) {
                if (ltid() == 0) ctlw[4] = xb_add(ctr, 1u);
                __syncthreads();
                const int item = (int)ctlw[4];
                __syncthreads();
                if (item >= nG + nA) break;
                if (item < nG) {
                    const int dir = item & 1, h = (item >> 1) & 3, bl = item >> 3;
                    const int b = ck.b0 + bl;
                    float* st = B.CST + (size_t)((b * 4 + h) * 2 + dir) * 128 * 256;
                    gla_item(lds, B.Z + (size_t)bl * seqlen * ZLD, seqlen, h, dir, P.gla_gate_w + ((size_t)layer * 2 + dir) * 16 * 512, P.gla_gate_b + ((size_t)layer * 2 + dir) * 512,
                             ck.is_ctx ? nullptr : st, ck.is_ctx ? st : nullptr, (dir ? B.OB : B.OF) + (size_t)bl * seqlen * 1024);
                } else {
                    const int a = item - nG;
                    int h, nt0, nt1, ldv0, tq0; bool rope; const bf16_t *Qp, *kn0, *kr0, *vt0, *kn1, *kr1, *vt1; unsigned char* Op;
                    if (ck.is_ctx) {
                        h = a & 7; const int bl = a >> 3; rope = false; tq0 = 0;
                        Qp = B.QB + (size_t)bl * TC * 1536; kn0 = B.KN + (size_t)bl * TC * 1024; kr0 = B.KR + (size_t)bl * TC * 64; vt0 = B.VT + (size_t)bl * TC; ldv0 = rows; nt0 = TC / 64;
                        kn1 = kn0; kr1 = kr0; vt1 = vt0; nt1 = 0; Op = (unsigned char*)B.MLA + (size_t)bl * TC * 1024;
                    } else {
                        const int qb = a & 7; h = (a >> 3) & 7; const int bl = a >> 6; const int b = ck.b0 + bl; rope = true; tq0 = qb * 256;
                        const bf16_t* CKN = (const bf16_t*)(P.ws + WS_CKN); const bf16_t* CKR = (const bf16_t*)(P.ws + WS_CKR); const bf16_t* CVT = (const bf16_t*)(P.ws + WS_CVT);
                        Qp = B.QB + (size_t)(bl * TL + qb * 256) * 1536; kn0 = CKN + (size_t)b * TC * 1024; kr0 = CKR + (size_t)b * TC * 64; vt0 = CVT + (size_t)b * TC; ldv0 = NB * TC; nt0 = TC / 64;
                        kn1 = B.KN + (size_t)bl * TL * 1024; kr1 = B.KR + (size_t)bl * TL * 64; vt1 = B.VT + (size_t)bl * TL; nt1 = TL / 64; Op = (unsigned char*)B.MLA + (size_t)(bl * TL + qb * 256) * 1024;
                    }
                    attn_item(lds, (const float2*)(P.ws + WS_ROPE), Qp, h, rope, tq0, kn0, kr0, vt0, ldv0, nt0, kn1, kr1, vt1, rows, nt1, Op);
                }
            }
        }
        GRID_SYNC();
        if (!ctx_kv_only) {
        if (RUN(PH_INPROJ2)) REP(PH_INPROJ2) { PHASE_LOCALS
            const bf16_t* H = B.H; const bf16_t* W = B.W; bf16_t* Z = B.Z;
            auto S = make_sched(np, 16, [=](Unit& u) { u.pn += 12; u.A = (const char*)H + (size_t)u.pm * 256 * 1024; u.B = (const char*)(W + WO_IN) + (size_t)u.pn * 256 * 1024; });
            pg8::gemm_phase<1>(lds, 1024, 1024, 1024, S, [=](const f32x4 (&acc)[2][2][4][2], const Unit& u, int wr, int wc, int fr, int fq) {
                const bool is_gate = (u.pn >= ZC_GZ / 256);
                pg8::epi8(acc, wr, wc, fr, fq, [&](int row, int col, const f32x4& a, const f32x4& b) {
                    f32x4 a2 = a, b2 = b;
                    if (is_gate) {
#pragma unroll
                        for (int j = 0; j < 4; ++j) { a2[j] = sigmoidf_(a[j]); b2[j] = sigmoidf_(b[j]); } }
                    store8_bf16(Z + (size_t)(u.pm * 256 + row) * ZLD + u.pn * 256 + col, a2, b2); }); });
        }
        GRID_SYNC();
        if (RUN(PH_GLAFIN)) REP(PH_GLAFIN) { PHASE_LOCALS phase_glafin(B.OF, B.OB, B.Z, P.gla_norm_g + layer * 256, rows, B.GF); }
        GRID_SYNC();
        if (RUN(PH_BRANCH)) REP(PH_BRANCH) { PHASE_LOCALS
            const bf16_t* PO = B.PD; const bf16_t* GF = B.GF; const bf16_t* MLA = B.MLA; const bf16_t* W = B.W; const bf16_t* Z = B.Z; bf16_t* MMS = (bf16_t*)B.MMF; bf16_t* MMB = B.MMB;
            auto fill = [=](Unit& u) { const bf16_t* a = (u.z == 0) ? PO : (u.z == 1) ? GF : MLA;   u.A = (const char*)a + (size_t)u.pm * 256 * 1024;
                                       u.B = (const char*)(W + WO_BR) + (size_t)u.z * 1048576 + (size_t)u.pn * 256 * 1024; u.sa = (u.z == 2) ? 0x7d7d7d7du : 0x7f7f7f7fu; };
            TripleSched<decltype(fill)> S{np, 4, lgdim(), lbid(), fill};
            pg8::gemm_phase<1>(lds, 1024, 1024, 1024, S, [=](const f32x4 (&acc)[2][2][4][2], const Unit& u, int wr, int wc, int fr, int fq) {
                pg8::epi8(acc, wr, wc, fr, fq, [&](int row, int col, const f32x4& a, const f32x4& b) {
                    const int gr = u.pm * 256 + row, c = u.pn * 256 + col;
                    const u32x4 gz = *(const u32x4*)(Z + (size_t)gr * ZLD + ZC_GZ + u.z * 1024 + c);
                    f32x4 va, vb;
                    va[0] = a[0] * lo2f(gz.x); va[1] = a[1] * hi2f(gz.x); va[2] = a[2] * lo2f(gz.y); va[3] = a[3] * hi2f(gz.y);
                    vb[0] = b[0] * lo2f(gz.z); vb[1] = b[1] * hi2f(gz.z); vb[2] = b[2] * lo2f(gz.w); vb[3] = b[3] * hi2f(gz.w);
                    bf16_t* mp = MMS + (size_t)gr * 1024 + c;
                    if (u.z != 0) { const u32x4 pm = *(const u32x4*)mp;
                        va[0] += lo2f(pm.x); va[1] += hi2f(pm.x); va[2] += lo2f(pm.y); va[3] += hi2f(pm.y); vb[0] += lo2f(pm.z); vb[1] += hi2f(pm.z); vb[2] += lo2f(pm.w); vb[3] += hi2f(pm.w); }
                    if (u.z == 2) { u32x2 w8; w8.x = pk4_fp8(va[0], va[1], va[2], va[3]); w8.y = pk4_fp8(vb[0], vb[1], vb[2], vb[3]); *(u32x2*)((unsigned char*)MMB + (size_t)gr * 1024 + c) = w8; }
                    else store8_bf16(mp, va, vb); }); });
        }
        GRID_SYNC();
        if (RUN(PH_WOUT)) for (int rep_ = 0; rep_ < (((REP_PHASE) == PH_WOUT || (REP_PHASE) == 999) && layer == 0 ? 2 : 1); ++rep_) { PHASE_LOCALS
            const bf16_t* MMB = B.MMB; const bf16_t* W = B.W; const float* mod = B.mod;
            auto S = make_sched(np, 4, [=](Unit& u) { u.A = (const char*)MMB + (size_t)u.pm * 256 * 1024; u.B = (const char*)(W + WO_OUT) + (size_t)u.pn * 256 * 1024; });
            const float* x32 = ck.x32; bf16_t* xb = ck.xb; const int isc = ck.is_ctx, b0 = ck.b0;
            pg8::gemm_phase<1>(lds, 1024, 1024, 1024, S, [=](const f32x4 (&acc)[2][2][4][2], const Unit& u, int wr, int wc, int fr, int fq) {
                const int bi = isc ? 32 : b0 + (u.pm >> 3);
                const float* g1 = mod + (size_t)bi * 6144 + 2 * 1024;
                pg8::epi8(acc, wr, wc, fr, fq, [&](int row, int col, const f32x4& a, const f32x4& b) {
                    const int c = u.pn * 256 + col; const size_t o = (size_t)(u.pm * 256 + row) * 1024 + c;
                    const f32x4 ga = *(const f32x4*)(g1 + c), gb = *(const f32x4*)(g1 + c + 4);
                    f32x4 xa, xv;
                    if (x32) { xa = *(const f32x4*)(x32 + o); xv = *(const f32x4*)(x32 + o + 4); }
                    else { const u32x4 w = *(const u32x4*)(xb + o); xa[0] = lo2f(w.x); xa[1] = hi2f(w.x); xa[2] = lo2f(w.y); xa[3] = hi2f(w.y); xv[0] = lo2f(w.z); xv[1] = hi2f(w.z); xv[2] = lo2f(w.w); xv[3] = hi2f(w.w); }
                    store8_bf16(xb + o, xa + ga * a, xv + gb * b); }); });
        }
        GRID_SYNC();
        if (RUN(PH_NORM2)) REP(PH_NORM2) { PHASE_LOCALS phase_norm<false, false>(ck.xb, rows, P.norm2_g + layer * 1024, B.mod, ck.is_ctx, ck.b0, 3, B.H); }
        GRID_SYNC();
        if (RUN(PH_WQ)) REP(PH_WQ) { PHASE_LOCALS
            const bf16_t* H = B.H; const bf16_t* W = B.W; _Float16* SC = B.SC;
            auto S = make_sched(np, 8, [=](Unit& u) { u.A = (const char*)(H + (size_t)u.pm * 256 * 1024); u.B = (const char*)(W + WO_Q + (size_t)u.pn * 256 * 1024); });
            pg8::gemm_phase<2>(lds, 1024, 1024, 1024, S, [=](const f32x4 (&acc)[2][2][4][2], const Unit& u, int wr, int wc, int fr, int fq) {
                pg8::epi8(acc, wr, wc, fr, fq, [&](int row, int col, const f32x4& a, const f32x4& b) {
                    h16x8 hv; hv[0] = (_Float16)a[0]; hv[1] = (_Float16)a[1]; hv[2] = (_Float16)a[2]; hv[3] = (_Float16)a[3]; hv[4] = (_Float16)b[0]; hv[5] = (_Float16)b[1]; hv[6] = (_Float16)b[2]; hv[7] = (_Float16)b[3];
                    *(h16x8*)(SC + (size_t)(u.pm * 256 + row) * 2048 + u.pn * 256 + col) = hv; }); });
        }
        GRID_SYNC();
        if (RUN(PH_SELECT)) REP(PH_SELECT) { PHASE_LOCALS phase_select(B.SC, rows, B.ROUTE, B.EID, lds); }
        GRID_SYNC();
        if (RUN(PH_PEERU)) REP(PH_PEERU) { PHASE_LOCALS phase_peer_u(B.H, B.EID, (const unsigned char*)(B.W + WO_PU), rows, B.PART); }
        GRID_SYNC();
        if (RUN(PH_PEERW)) REP(PH_PEERW) { PHASE_LOCALS phase_peer_w(B.PART, B.ROUTE, rows, B.WG); }
        GRID_SYNC();
        if (RUN(PH_PEERV)) REP(PH_PEERV) { PHASE_LOCALS phase_peer_v(B.WG, B.EID, (const unsigned char*)(B.W + WO_PV), B.mod, ck.is_ctx, ck.b0, rows, ck.xb, rep_ != 0); }
        GRID_SYNC();
        }
    }
    }
    if (R.mode == 0 || R.mode == 3) { const Params P = kparams(); phase_final((const bf16_t*)(P.ws + WS_XL), P.out, P.final_norm_g, NB * TL); }
#undef RUN
#undef GRID_SYNC
#undef PHASE_LOCALS
}

extern "C" void kernel_launch(void* const* d_in, const int* in_sizes, int n_in, void* d_out, int out_size, void* d_ws, size_t ws_size, hipStream_t stream) {
    static int grid = 0;
    if (grid == 0) {
        if (n_in != 25 || ws_size < WS_END) { fprintf(stderr, "kernel_launch: need 25 inputs and %zu bytes of workspace (got %d, %zu)\n", (size_t)WS_END, n_in, ws_size); grid = -1; return; }
        int dev = 0, cus = 0, per_cu = 0;
        if (hipGetDevice(&dev) != hipSuccess || hipDeviceGetAttribute(&cus, hipDeviceAttributeMultiprocessorCount, dev) != hipSuccess) { grid = -1; return; }
        if (hipFuncSetAttribute((const void*)fwd_kernel, hipFuncAttributeMaxDynamicSharedMemorySize, LDS_BYTES) != hipSuccess) { fprintf(stderr, "kernel_launch: hipFuncSetAttribute failed\n"); grid = -1; return; }
        if (hipOccupancyMaxActiveBlocksPerMultiprocessor(&per_cu, (const void*)fwd_kernel, NTHR, LDS_BYTES) != hipSuccess || per_cu < 1) { fprintf(stderr, "kernel_launch: occupancy query says %d\n", per_cu); grid = -1; return; }
        grid = cus;
    }
    if (grid <= 0) return;
    (void)hipMemsetAsync((char*)d_ws + WS_CTL, 0, CTL_BYTES, stream);
    Params P{};
    const float* const* in = (const float* const*)d_in;
    P.x = in[0]; P.c = in[1]; P.ctx = in[2]; P.c_ctx = in[3]; P.ada_w = in[4]; P.ada_b = in[5]; P.norm1_g = in[6]; P.norm2_g = in[7]; P.w_in = in[8]; P.pool_w = in[9];
    P.pool_scale = in[10]; P.gla_gate_w = in[11]; P.gla_gate_b = in[12]; P.gla_norm_g = in[13]; P.mla_q_norm_g = in[14]; P.mla_kv_norm_g = in[15]; P.mla_w_uq = in[16];
    P.mla_w_ukv = in[17]; P.branch_w = in[18]; P.w_out = in[19]; P.peer_wq = in[20]; P.peer_keys = in[21]; P.peer_u = in[22]; P.peer_v = in[23]; P.final_norm_g = in[24];
    P.out = (float*)d_out; P.ws = (unsigned char*)d_ws;
#if MK_SINGLE
    RunArgs R{0, 0, 0, 0};
    hipLaunchKernelGGL(fwd_kernel, dim3(grid), dim3(NTHR), LDS_BYTES, stream, P, R);
#else
    { RunArgs R{1, 0, 0, 0}; hipLaunchKernelGGL(fwd_kernel, dim3(grid), dim3(NTHR), LDS_BYTES, stream, P, R); }
    for (int layer = 0; layer < NLAYER; ++layer)
        for (int ci = 0; ci < 5; ++ci)
            for (int ph = 0; ph < PH_COUNT; ++ph) {
                if (ci == 0 && layer == NLAYER - 1 && ph >= PH_INPROJ2) continue;
                RunArgs R{2, layer, ci, ph}; hipLaunchKernelGGL(fwd_kernel, dim3(grid), dim3(NTHR), LDS_BYTES, stream, P, R); }
    { RunArgs R{3, 0, 0, 0}; hipLaunchKernelGGL(fwd_kernel, dim3(grid), dim3(NTHR), LDS_BYTES, stream, P, R); }
#endif
}
```

```cpp
#include <hip/hip_runtime.h>
#include <stdint.h>
#include <stdio.h>

#ifndef REP_PHASE
#define REP_PHASE -1
#endif
#ifndef MK_SINGLE
#define MK_SINGLE 1
#endif

#define DI __device__ __forceinline__
#define LAS __attribute__((address_space(3)))

typedef unsigned short bf16_t;
typedef short bf16x8 __attribute__((ext_vector_type(8)));
typedef short s16x4 __attribute__((ext_vector_type(4)));
typedef float f32x4 __attribute__((ext_vector_type(4)));
typedef float f32x16 __attribute__((ext_vector_type(16)));
typedef unsigned u32x4 __attribute__((ext_vector_type(4)));
typedef unsigned u32x2 __attribute__((ext_vector_type(2)));
typedef __bf16 bf16x2_t __attribute__((ext_vector_type(2)));
typedef _Float16 h16x8 __attribute__((ext_vector_type(8)));
typedef int i32x4 __attribute__((ext_vector_type(4)));
typedef int i32x8 __attribute__((ext_vector_type(8)));

constexpr int D = 1024, NB = 32, TL = 2048, TC = 256, NLAYER = 2;
constexpr int ZLD = 7936;
constexpr int ZC_P = 0, ZC_Q = 1024, ZC_K = 1536, ZC_V = 2048, ZC_R = 3072, ZC_GZ = 4096, ZC_QDN = 7168, ZC_KVDN = 7552,
              ZC_KROPE = 7808, ZC_LRF = 7872, ZC_LRB = 7888;
constexpr int NEXP = 16384;
constexpr int NWG = 256, NTHR = 512;
constexpr int LDS_BYTES = 147456;

constexpr size_t WO_IN = 0, WO_POOL = WO_IN + (size_t)ZLD * 1024, WO_UQ = WO_POOL + 4 * 256 * 256, WO_KN = WO_UQ + 1536 * 384,
                 WO_V = WO_KN + 1024 * 256, WO_BR = WO_V + 1024 * 256, WO_OUT = WO_BR + 3 * 1024 * 1024, WO_Q = WO_OUT + 1024 * 1024,
                 WO_KEYS = WO_Q + 2048 * 1024, WO_PU = WO_KEYS + 8 * 256 * 256, WO_PV = WO_PU + (size_t)NEXP * 512,
                 W_LAYER = WO_PV + (size_t)NEXP * 512;

constexpr size_t MiB = 1048576;
constexpr size_t WS_CTL = 0;
constexpr size_t CTL_BYTES = 65536;
constexpr size_t WS_MOD = WS_CTL + CTL_BYTES;
constexpr size_t WS_ROPE = WS_MOD + 1792 * 1024;
constexpr size_t WS_W = WS_MOD + 2 * MiB;
constexpr size_t WS_H = WS_W + ((2 * W_LAYER * 2 + 255) / 256) * 256;
constexpr size_t WS_Z = WS_H + 32 * MiB;
constexpr size_t WS_QB = WS_Z + 248 * MiB;
constexpr size_t WS_KN = WS_QB + 48 * MiB;
constexpr size_t WS_VT = WS_KN + 32 * MiB;
constexpr size_t WS_KR = WS_VT + 32 * MiB;
constexpr size_t WS_CKN = WS_KR + 2 * MiB;
constexpr size_t WS_CVT = WS_CKN + 16 * MiB;
constexpr size_t WS_CKR = WS_CVT + 16 * MiB;
constexpr size_t WS_CST = WS_CKR + 1 * MiB;
constexpr size_t WS_RS = WS_CST + 32 * MiB;
constexpr size_t WS_OF = WS_RS + 1 * MiB;
constexpr size_t WS_OB = WS_OF + 32 * MiB;
constexpr size_t WS_MLA = WS_OB + 32 * MiB;
constexpr size_t WS_PD = WS_MLA + 32 * MiB;
constexpr size_t WS_PO = WS_PD + 32 * MiB;
constexpr size_t WS_ROUTE = WS_PO + 32 * MiB;
constexpr size_t WS_XCTX = WS_ROUTE + 16 * MiB;
constexpr size_t WS_XL = WS_XCTX + 16 * MiB;
constexpr size_t WS_END = WS_XL + 128 * MiB;

DI float bf2f(bf16_t b) { return __uint_as_float((unsigned)b << 16); }
DI bf16_t f2bf(float f) { return __builtin_bit_cast(bf16_t, (__bf16)f); }
DI unsigned pk2(float lo, float hi) { bf16x2_t v; v[0] = (__bf16)lo; v[1] = (__bf16)hi; return __builtin_bit_cast(unsigned, v); }
DI unsigned pk4_fp8(float a, float b, float c, float d) { int w = 0; w = __builtin_amdgcn_cvt_pk_fp8_f32(a, b, w, false); w = __builtin_amdgcn_cvt_pk_fp8_f32(c, d, w, true); return (unsigned)w; }
DI unsigned char f2fp8(float a) { return (unsigned char)(__builtin_amdgcn_cvt_pk_fp8_f32(a, a, 0, false) & 0xff); }
DI float lo2f(unsigned w) { return __uint_as_float(w << 16); }
DI float hi2f(unsigned w) { return __uint_as_float(w & 0xffff0000u); }
DI float shx(float v, int m, int lane) { return __builtin_bit_cast(float, __builtin_amdgcn_ds_bpermute((lane ^ m) << 2, __builtin_bit_cast(int, v))); }
DI float shl(float v, int src) { return __builtin_bit_cast(float, __builtin_amdgcn_ds_bpermute(src << 2, __builtin_bit_cast(int, v))); }
DI float wave_sum(float v, int lane) {
#pragma unroll
    for (int o = 32; o >= 1; o >>= 1) v += shx(v, o, lane);
    return v;
}
DI int ltid() { int t = threadIdx.x; asm volatile("" : "+v"(t)); return t; }
DI int lnd(int x) { asm volatile("" : "+s"(x)); return x; }
DI int lbid() { return lnd((int)blockIdx.x); }
DI int lgdim() { return lnd((int)gridDim.x); }
DI float sigmoidf_(float x) { return 1.0f / (1.0f + __expf(-x)); }

#define XB_TMO      128
#define XB_XCNT(j)  (256  + 64 * (j))
#define XB_XSUB(j)  (1280 + 64 * (j))
#define XB_XGEN(j)  (2304 + 64 * (j))
#define XB_TOP      3328
#define XB_TOPGEN   3392
#define XCD_BAR_WORDS 3456
#define XB_SPIN_CAP (1u << 23)
#define CTL_WORKQ   4096

DI unsigned xb_ld(unsigned* p)              { return __hip_atomic_load(p, __ATOMIC_RELAXED, __HIP_MEMORY_SCOPE_AGENT); }
DI unsigned xb_add(unsigned* p, unsigned v) { return __hip_atomic_fetch_add(p, v, __ATOMIC_RELAXED, __HIP_MEMORY_SCOPE_AGENT); }
DI unsigned xb_xcc_id() { return (unsigned)__builtin_amdgcn_s_getreg((3 << 11) | 20) & 0xFu; }
#define XB_SPIN(cond, bar) do { unsigned _sp = 0; while (cond) { __builtin_amdgcn_s_sleep(1); \
    if ((++_sp & 255u) == 0u) { if (xb_ld(&(bar)[XB_TMO])) break; if (_sp > XB_SPIN_CAP) { atomicAdd(&(bar)[XB_TMO], 1u); break; } } } } while (0)

struct XcdBarrier { unsigned* bar; unsigned x; volatile LAS unsigned* st; };

DI XcdBarrier xcd_barrier_post(unsigned* bar, volatile LAS unsigned* st) {
    XcdBarrier b; b.bar = bar; b.x = xb_xcc_id(); b.st = st;
    if (threadIdx.x == 0) (void)xb_add(&bar[XB_XCNT(b.x)], 1u);
    return b;
}
DI void xcd_barrier_complete(unsigned* bar, unsigned x, unsigned& nloc, unsigned& nx) {
    const unsigned G = gridDim.x * gridDim.y * gridDim.z;
    unsigned sum, cnt, mine, sp = 0u;
    for (;;) {
        sum = 0u; cnt = 0u; mine = 0u;
#pragma unroll
        for (unsigned j = 0; j < 16; ++j) { const unsigned c = xb_ld(&bar[XB_XCNT(j)]); sum += c; cnt += (c > 0u) ? 1u : 0u; mine = (j == x) ? c : mine; }
        if (sum == G) break;
        __builtin_amdgcn_s_sleep(1);
        if ((++sp & 255u) == 0u) { if (xb_ld(&bar[XB_TMO])) break; if (sp > XB_SPIN_CAP) { atomicAdd(&bar[XB_TMO], 1u); break; } }
    }
    nloc = mine > 0u ? mine : 1u; nx = cnt > 0u ? cnt : 1u;
}
DI void xcd_barrier(const XcdBarrier& b) {
    asm volatile("s_waitcnt vmcnt(0)" ::: "memory");
    __syncthreads();
    if (threadIdx.x == 0) {
        __attribute__((address_space(1))) unsigned* gbar = (__attribute__((address_space(1))) unsigned*)b.bar; asm volatile("" : "+s"(gbar)); unsigned* bar = (unsigned*)gbar;
        unsigned bx = b.x; asm volatile("" : "+s"(bx));
        __builtin_amdgcn_s_waitcnt(0);
        unsigned nloc = b.st[0], nx = b.st[1];
        if (nloc == 0u) { xcd_barrier_complete(bar, bx, nloc, nx); b.st[0] = nloc; b.st[1] = nx; }
        const unsigned old = xb_add(&bar[XB_XSUB(bx)], 1u);
        const unsigned gen = old / nloc;
        if (old + 1u == (gen + 1u) * nloc) {
            __builtin_amdgcn_fence(__ATOMIC_RELEASE, "agent");
            asm volatile("s_waitcnt vmcnt(0)" ::: "memory");
            const unsigned og = xb_add(&bar[XB_TOP], 1u);
            const unsigned tg = og / nx;
            if (og + 1u == (tg + 1u) * nx) xb_add(&bar[XB_TOPGEN], 1u);
            else XB_SPIN(xb_ld(&bar[XB_TOPGEN]) == tg, bar);
            __builtin_amdgcn_fence(__ATOMIC_ACQUIRE, "agent");
            xb_add(&bar[XB_XGEN(bx)], 1u);
            asm volatile("s_waitcnt vmcnt(0)" ::: "memory");
        } else {
            XB_SPIN(xb_ld(&bar[XB_XGEN(bx)]) == gen, bar);
            __builtin_amdgcn_fence(__ATOMIC_ACQUIRE, "agent");
            asm volatile("s_waitcnt vmcnt(0)" ::: "memory");
        }
    }
    __syncthreads();
}

namespace pg8 {
constexpr int BM = 256, BK = 64, HALF = 128, HTB = HALF * BK * 2, STAGE_BYTES = 8 * HTB, NXCD = 8, WGM = 8;
DI int lds_byte(int r, int c) { const int st = (r >> 4) * 2 + (c >> 5), rr = r & 15, cc = c & 31, ob = rr * 64 + cc * 2; return st * 1024 + (ob ^ (((ob >> 9) & 1) << 5)); }
DI void stage_rc(int b, int& R, int& C) { const int st = b / 1024, sb = b % 1024, swz = sb ^ (((sb >> 9) & 1) << 5); R = (st >> 1) * 16 + swz / 64; C = (st & 1) * 32 + (swz % 64) / 2; }
DI int perm32(int rho) { const int n = rho >> 4, i = rho & 15; return 8 * (i >> 2) + 4 * n + (i & 3); }

struct Unit { const char* A; const char* B; int pm, pn, z; unsigned sa; };

DI void tile_of(int L, int nM, int nN, int& pm, int& pn) {
    const int nwg = nM * nN; int wgid = L;
    { const int q = nwg / NXCD, r = nwg % NXCD, xcd = wgid % NXCD, off = wgid / NXCD; wgid = (xcd < r ? xcd * (q + 1) : r * (q + 1) + (xcd - r) * q) + off; }
    const int nig = WGM * nN, gid = wgid / nig, fm = gid * WGM, gsz = (nM - fm) < WGM ? (nM - fm) : WGM;
    pm = fm + ((wgid % nig) % gsz); pn = (wgid % nig) / gsz;
}

template <class F> DI void epi8(const f32x4 (&acc)[2][2][4][2], int wr, int wc, int fr, int fq, F f) {
#pragma unroll
    for (int ai = 0; ai < 2; ++ai)
#pragma unroll
        for (int m = 0; m < 4; ++m) {
            const int row = ai * HALF + wr * 64 + m * 16 + fr;
#pragma unroll
            for (int bj = 0; bj < 2; ++bj) f(row, bj * HALF + wc * 32 + 8 * fq, acc[ai][bj][m][0], acc[ai][bj][m][1]);
        }
}

template <int ES, class Epi, class Sched>
DI void gemm_phase(LAS unsigned char* lds, const int lda, const int ldb, const int K, const Sched& S, const Epi& E) {
    int tid = threadIdx.x; asm volatile("" : "+v"(tid));
    const int wid = __builtin_amdgcn_readfirstlane(tid >> 6), lane = tid & 63, wr = wid >> 2, wc = wid & 3, fr = lane & 15, fq = lane >> 4;
    const int nt = K * ES / (BK * 2);
    unsigned voffA[2], voffB[2];
#pragma unroll
    for (int i = 0; i < 2; ++i) { int R, C; stage_rc(tid * 16 + i * 8192, R, C); const int Rb = (R & ~31) + perm32(R & 31);
        voffA[i] = (unsigned)(R * lda * ES + C * 2); voffB[i] = (unsigned)(Rb * ldb * ES + C * 2); }
    const size_t kstep = (size_t)(BK * 2);
    const size_t hstepA = (size_t)HALF * lda * ES, hstepB = (size_t)HALF * ldb * ES;
    const unsigned ldsw = (unsigned)wid * 1024u;
    LAS unsigned char* ldsA = lds + lds_byte(wr * 64 + fr, fq * 8); LAS unsigned char* ldsB = lds + 4 * HTB + lds_byte(wc * 32 + fr, fq * 8);
    asm volatile("" : "+v"(ldsA), "+v"(ldsB));
#define PG8_SA(b, h) (((b) * 2 + (h)) * HTB)
#define PG8_SB(b, h) ((4 + (b) * 2 + (h)) * HTB)
#define PG8_STAGE(bufoff, gbase, voff) do { const char* _g = (const char*)(gbase); asm volatile("" : "+s"(_g)); _Pragma("unroll") for (int _i = 0; _i < 2; ++_i) \
        __builtin_amdgcn_global_load_lds((const unsigned*)(_g + (voff)[_i]), (LAS unsigned*)(lds + (bufoff) + ldsw + _i * 8192), 16, 0, 0); } while (0)
#define PG8_LD16(p) (*(const LAS i32x4*)(p))
#define PG8_LDA(dst, b, h) do { _Pragma("unroll") for (int m = 0; m < 4; ++m) { \
        if constexpr (ES == 2) { _Pragma("unroll") for (int k = 0; k < 2; ++k) dst[m][k] = *(const LAS bf16x8*)(ldsA + PG8_SA(b, h) + m * 2048 + k * 1024); } \
        else dst##8[m] = __builtin_shufflevector(PG8_LD16(ldsA + PG8_SA(b, h) + m * 2048), PG8_LD16(ldsA + PG8_SA(b, h) + m * 2048 + 1024), 0, 1, 2, 3, 4, 5, 6, 7); } } while (0)
#define PG8_LDB(dst, b, h) do { _Pragma("unroll") for (int n = 0; n < 2; ++n) { \
        if constexpr (ES == 2) { _Pragma("unroll") for (int k = 0; k < 2; ++k) dst[n][k] = *(const LAS bf16x8*)(ldsB + PG8_SA(b, h) + n * 2048 + k * 1024); } \
        else dst##8[n] = __builtin_shufflevector(PG8_LD16(ldsB + PG8_SA(b, h) + n * 2048), PG8_LD16(ldsB + PG8_SA(b, h) + n * 2048 + 1024), 0, 1, 2, 3, 4, 5, 6, 7); } } while (0)
#define PG8_MMA(ai, bj, At, Bt) do { __builtin_amdgcn_s_setprio(1); _Pragma("unroll") for (int m = 0; m < 4; ++m) _Pragma("unroll") for (int n = 0; n < 2; ++n) { \
        if constexpr (ES == 2) { _Pragma("unroll") for (int k = 0; k < 2; ++k) acc[ai][bj][m][n] = __builtin_amdgcn_mfma_f32_16x16x32_bf16(Bt[n][k], At[m][k], acc[ai][bj][m][n], 0, 0, 0); } \
        else asm volatile("v_mfma_scale_f32_16x16x128_f8f6f4 %0, %1, %2, %0, %3, %4 op_sel_hi:[0,0,0]" : "+v"(acc[ai][bj][m][n]) : "v"(Bt##8[n]), "v"(At##8[m]), "v"(0x7a7a7a7a), "v"(cur.sa)); } \
        __builtin_amdgcn_s_setprio(0); if constexpr (ES == 1) __builtin_amdgcn_sched_barrier(0); } while (0)
#define PG8_WAIT_V(n) asm volatile("s_waitcnt vmcnt(" #n ")" ::: "memory")
#define PG8_WAIT_L(n) asm volatile("s_waitcnt lgkmcnt(" #n ")" ::: "memory")
#define PG8_BAR __builtin_amdgcn_s_barrier()
#define PG8_SCHED __builtin_amdgcn_sched_barrier(0)
    Unit cur, nxt; int ui = 0;
    if (!S.next(0, cur)) return;
    f32x4 acc[2][2][4][2];
#pragma unroll
    for (int a = 0; a < 2; ++a)
#pragma unroll
        for (int b = 0; b < 2; ++b)
#pragma unroll
            for (int m = 0; m < 4; ++m)
#pragma unroll
                for (int n = 0; n < 2; ++n) acc[a][b][m][n] = (f32x4){0.f, 0.f, 0.f, 0.f};
    bf16x8 At[4][2], B0[2][2], B1[2][2];
    i32x8 At8[4], B08[2], B18[2];
    const char* cA = cur.A; const char* cB = cur.B;
    PG8_STAGE(PG8_SB(0, 0), cB, voffB); PG8_STAGE(PG8_SA(0, 0), cA, voffA); PG8_STAGE(PG8_SB(0, 1), cB + hstepB, voffB); PG8_STAGE(PG8_SA(0, 1), cA + hstepA, voffA);
    if (wr == 1) PG8_BAR;
    PG8_WAIT_V(4); PG8_BAR;
    PG8_STAGE(PG8_SB(1, 0), cB + kstep, voffB); PG8_STAGE(PG8_SA(1, 0), cA + kstep, voffA); PG8_STAGE(PG8_SB(1, 1), cB + hstepB + kstep, voffB);
    PG8_WAIT_V(6); PG8_BAR;
    for (;;) {
        const bool has_next = S.next(ui + 1, nxt);
        const char* nA = has_next ? nxt.A : cA; const char* nB = has_next ? nxt.B : cB;
#pragma nounroll
        for (int t = 0; t < nt; t += 2) {
            const bool last = (t == nt - 2);
            const char* a1 = cA + (size_t)(t + 1) * kstep;
            const char* a2 = last ? nA : cA + (size_t)(t + 2) * kstep; const char* b2 = last ? nB : cB + (size_t)(t + 2) * kstep;
            const char* a3 = a2 + kstep; const char* b3 = b2 + kstep;
            PG8_LDB(B0, 0, 0); PG8_SCHED; PG8_LDA(At, 0, 0); PG8_STAGE(PG8_SA(1, 1), a1 + hstepA, voffA);
            PG8_WAIT_L(8); PG8_BAR; PG8_WAIT_L(0); PG8_MMA(0, 0, At, B0); PG8_BAR; PG8_SCHED;
            PG8_LDB(B1, 0, 1); PG8_STAGE(PG8_SB(0, 0), b2, voffB);
            PG8_BAR; PG8_WAIT_L(0); PG8_MMA(0, 1, At, B1); PG8_BAR;
            PG8_LDA(At, 0, 1); PG8_STAGE(PG8_SA(0, 0), a2, voffA);
            PG8_BAR; PG8_WAIT_L(0); PG8_MMA(1, 0, At, B0); PG8_BAR; PG8_SCHED;
            PG8_STAGE(PG8_SB(0, 1), b2 + hstepB, voffB);
            PG8_WAIT_V(6); PG8_BAR; PG8_MMA(1, 1, At, B1); PG8_BAR;
            PG8_LDB(B0, 1, 0); PG8_SCHED; PG8_LDA(At, 1, 0); PG8_STAGE(PG8_SA(0, 1), a2 + hstepA, voffA);
            PG8_WAIT_L(8); PG8_BAR; PG8_WAIT_L(0); PG8_MMA(0, 0, At, B0); PG8_BAR; PG8_SCHED;
            PG8_LDB(B1, 1, 1); PG8_STAGE(PG8_SB(1, 0), b3, voffB);
            PG8_BAR; PG8_WAIT_L(0); PG8_MMA(0, 1, At, B1); PG8_BAR;
            PG8_LDA(At, 1, 1); PG8_STAGE(PG8_SA(1, 0), a3, voffA);
            PG8_BAR; PG8_WAIT_L(0); PG8_MMA(1, 0, At, B0); PG8_BAR; PG8_SCHED;
            PG8_STAGE(PG8_SB(1, 1), b3 + hstepB, voffB);
            PG8_WAIT_V(6); PG8_BAR; PG8_MMA(1, 1, At, B1); PG8_BAR;
        }
        if constexpr (ES == 1) asm volatile("s_nop 15\n\ts_nop 15" ::: "memory");
        E(acc, cur, wr, wc, fr, fq);
        if (!has_next) break;
#pragma unroll
        for (int a = 0; a < 2; ++a)
#pragma unroll
            for (int b = 0; b < 2; ++b)
#pragma unroll
                for (int m = 0; m < 4; ++m)
#pragma unroll
                    for (int n = 0; n < 2; ++n) acc[a][b][m][n] = (f32x4){0.f, 0.f, 0.f, 0.f};
        cur = nxt; cA = nA; cB = nB; ++ui;
    }
    PG8_WAIT_V(0);
    if (wr == 0) PG8_BAR;
    PG8_BAR;
#undef PG8_SA
#undef PG8_SB
#undef PG8_STAGE
#undef PG8_LDA
#undef PG8_LDB
#undef PG8_MMA
#undef PG8_WAIT_V
#undef PG8_WAIT_L
#undef PG8_BAR
#undef PG8_SCHED
}
}
using pg8::Unit;

struct Params {
    const float *x, *c, *ctx, *c_ctx, *ada_w, *ada_b, *norm1_g, *norm2_g, *w_in, *pool_w, *pool_scale, *gla_gate_w, *gla_gate_b, *gla_norm_g,
                *mla_q_norm_g, *mla_kv_norm_g, *mla_w_uq, *mla_w_ukv, *branch_w, *w_out, *peer_wq, *peer_keys, *peer_u, *peer_v, *final_norm_g;
    float* out; unsigned char* ws;
};
struct Chunk { int is_ctx, rows, b0, np; const float* x32; bf16_t* xb; };

DI Chunk make_chunk(const Params& P, int layer, int ci) {
    Chunk c; c.is_ctx = (ci == 0); c.rows = c.is_ctx ? NB * TC : 8 * TL; c.b0 = c.is_ctx ? 0 : 8 * (ci - 1); c.np = c.rows / 256;
    c.xb = c.is_ctx ? (bf16_t*)(P.ws + WS_XCTX) : (bf16_t*)(P.ws + WS_XL) + (size_t)c.b0 * TL * D;
    c.x32 = (layer == 0) ? (c.is_ctx ? P.ctx : P.x + (size_t)c.b0 * TL * D) : nullptr;
    return c;
}
DI const bf16_t* wlayer(const Params& P, int l) { return (const bf16_t*)(P.ws + WS_W) + (size_t)l * W_LAYER; }
DI const float* modlayer(const Params& P, int l) { return (const float*)(P.ws + WS_MOD) + (size_t)l * 33 * 6144; }

template <bool FP8 = false, class SrcF> DI void tconv_tiles(LAS float* tile, bf16_t* dst, int K, int N, SrcF src, int rot) {
    const int tid = ltid(), ntk = K / 64, ntn = N / 64, nwg = lgdim();
    const int wg = (int)(((unsigned)lbid() + (unsigned)rot) % (unsigned)nwg);
    for (int t = wg; t < ntk * ntn; t += nwg) {
        const int kt = t % ntk, nt_ = t / ntk;
#pragma unroll
        for (int rr = 0; rr < 8; ++rr) { const int i = (tid >> 6) + 8 * rr, j = tid & 63; tile[i * 65 + j] = src(kt * 64 + i, nt_ * 64 + j); }
        __syncthreads();
#pragma unroll
        for (int rr = 0; rr < 8; ++rr) { const int jj = (tid >> 6) + 8 * rr, ii = tid & 63; const size_t o = (size_t)(nt_ * 64 + jj) * K + kt * 64 + ii;
            if (FP8) ((unsigned char*)dst)[o] = f2fp8(tile[ii * 65 + jj] * 32.0f); else dst[o] = f2bf(tile[ii * 65 + jj]); }
        __syncthreads();
    }
}
DI void conv_direct(const float* src, bf16_t* dst, size_t n) {
    const size_t stride = (size_t)lgdim() * NTHR;
    const int tid_ = ltid();
    for (size_t i = (size_t)lbid() * NTHR + tid_; i < n / 4; i += stride) {
        const float4 v = ((const float4*)src)[i]; u32x2 w; w.x = pk2(v.x, v.y); w.y = pk2(v.z, v.w); ((u32x2*)dst)[i] = w; }
}
DI void conv_fp8(const float* src, unsigned* dst, size_t n, float scale) {
    const size_t stride = (size_t)lgdim() * NTHR;
    const int tid_ = ltid();
    for (size_t i = (size_t)lbid() * NTHR + tid_; i < n / 4; i += stride) {
        const float4 v = ((const float4*)src)[i]; int w = 0;
        w = __builtin_amdgcn_cvt_pk_fp8_f32(v.x * scale, v.y * scale, w, false); w = __builtin_amdgcn_cvt_pk_fp8_f32(v.z * scale, v.w * scale, w, true);
        const size_t e = i >> 8, d4 = i & 255;
        dst[((d4 >> 5) * (size_t)NEXP + e) * 32 + (d4 & 31)] = (unsigned)w; }
}
DI void phase_convert(const Params& P, LAS unsigned char* lds) {
    LAS float* tile = (LAS float*)lds;
    for (int l = 0; l < NLAYER; ++l) {
        bf16_t* W = (bf16_t*)(P.ws + WS_W) + (size_t)l * W_LAYER;
        { const float* w = P.w_in + (size_t)l * 1024 * 7904;
          tconv_tiles<true>(tile, W + WO_IN, 1024, ZLD, [=](int k, int n) -> float {
              int sc; float s = 1.0f;
              if (n < 4096) { sc = n; if (n >= 1024 && n < 1536) s = 0.08838834764831845f; }
              else if (n < 7168) sc = n - 4096 + 4832;
              else if (n < 7552) sc = n - 7168 + 4128;
              else if (n < 7808) sc = n - 7552 + 4512;
              else if (n < 7872) sc = n - 7808 + 4768;
              else if (n < 7888) sc = n - 7872 + 4096;
              else if (n < 7904) sc = n - 7888 + 4112;
              else return 0.0f;
              return w[(size_t)k * 7904 + sc] * s; }, 0); }
        { const float* w = P.mla_w_uq + (size_t)l * 384 * 1536; const float* g = P.mla_q_norm_g + l * 384;
          tconv_tiles(tile, W + WO_UQ, 384, 1536, [=](int k, int n) -> float { return g[k] * w[k * 1536 + n]; }, 81); }
        { const float* w = P.mla_w_ukv + (size_t)l * 256 * 2048; const float* g = P.mla_kv_norm_g + l * 256;
          tconv_tiles(tile, W + WO_KN, 256, 1024, [=](int k, int n) -> float { return g[k] * w[k * 2048 + (n >> 7) * 256 + (n & 127)]; }, 120);
          tconv_tiles(tile, W + WO_V, 256, 1024, [=](int k, int n) -> float { return g[k] * w[k * 2048 + (n >> 7) * 256 + 128 + (n & 127)]; }, 184); }
        for (int i = 1; i < 3; ++i) { const float* w = P.branch_w + ((size_t)l * 3 + i) * 1048576;
          tconv_tiles<true>(tile, (bf16_t*)((unsigned char*)(W + WO_BR) + (size_t)i * 1048576), 1024, 1024, [=](int k, int n) -> float { return w[k * 1024 + n]; }, 0); }
        {
            const float* pw = P.pool_w + (size_t)l * 4 * 65536; const float* ps = P.pool_scale + l * 1024; const float* bw = P.branch_w + (size_t)l * 3 * 1048576; unsigned char* dst = (unsigned char*)(W + WO_BR);
            LAS float* AS = (LAS float*)lds; LAS float* BS = AS + 64 * 257;
            const int tid = ltid();
            for (int t = lbid(); t < 256; t += lgdim()) {
                const int g = t >> 6, nb = (t >> 2) & 15, kb = t & 3;
                __syncthreads();
                for (int i = tid; i < 64 * 256; i += NTHR) { const int r = i >> 8, j = i & 255; AS[r * 257 + j] = pw[(size_t)g * 65536 + (kb * 64 + r) * 256 + j] * ps[g * 256 + j]; }
                for (int i = tid; i < 256 * 64; i += NTHR) { const int j = i >> 6, n = i & 63; BS[j * 65 + n] = bw[(size_t)(g * 256 + j) * 1024 + nb * 64 + n]; }
                __syncthreads();
                const int kq = tid & 63, n0 = (tid >> 6) * 8;
                float acc[8];
#pragma unroll
                for (int j = 0; j < 8; ++j) acc[j] = 0.f;
                for (int j = 0; j < 256; ++j) { const float a = AS[kq * 257 + j];
#pragma unroll
                    for (int q = 0; q < 8; ++q) acc[q] += a * BS[j * 65 + n0 + q]; }
#pragma unroll
                for (int q = 0; q < 8; ++q) dst[(size_t)(nb * 64 + n0 + q) * 1024 + g * 256 + kb * 64 + kq] = f2fp8(acc[q] * 32.0f);
            }
            __syncthreads();
        }
        { const float* w = P.w_out + (size_t)l * 1048576;
          tconv_tiles<true>(tile, W + WO_OUT, 1024, 1024, [=](int k, int n) -> float { return w[k * 1024 + n]; }, 0); }
        {
            const float* wq = P.peer_wq + (size_t)l * 1024 * 2048; const float* kk = P.peer_keys + (size_t)l * 2 * 8 * 128 * 128; bf16_t* dst = W + WO_Q;
            LAS float* KY = (LAS float*)lds; LAS float* WQS = KY + 128 * 129;
            const int tid = ltid();
            for (int t = lbid(); t < 256; t += lgdim()) {
                const int hs = t >> 4, k0 = (t & 15) * 64, h = hs >> 1, half = hs & 1;
                __syncthreads();
                for (int i = tid; i < 128 * 128; i += NTHR) { const int key = i >> 7, d = i & 127; KY[key * 129 + d] = kk[((size_t)(half * 8 + h) * 128 + key) * 128 + d]; }
                for (int i = tid; i < 64 * 128; i += NTHR) { const int r = i >> 7, d = i & 127; WQS[r * 129 + d] = wq[(size_t)(k0 + r) * 2048 + h * 256 + half * 128 + d]; }
                __syncthreads();
                const int kq = tid & 63, key0 = (tid >> 6) * 16;
                float acc[16];
#pragma unroll
                for (int j = 0; j < 16; ++j) acc[j] = 0.f;
                for (int d = 0; d < 128; ++d) { const float a = WQS[kq * 129 + d];
#pragma unroll
                    for (int j = 0; j < 16; ++j) acc[j] += a * KY[(key0 + j) * 129 + d]; }
#pragma unroll
                for (int j = 0; j < 16; ++j) dst[(size_t)(h * 256 + half * 128 + key0 + j) * 1024 + k0 + kq] = f2bf(acc[j]);
            }
            __syncthreads();
        }
        conv_fp8(P.peer_u + (size_t)l * NEXP * 1024, (unsigned*)(W + WO_PU), (size_t)NEXP * 1024, 32.0f);
        conv_fp8(P.peer_v + (size_t)l * NEXP * 1024, (unsigned*)(W + WO_PV), (size_t)NEXP * 1024, 1.0f);
    }
    if (lbid() == 0) {
        float2* rt = (float2*)(P.ws + WS_ROPE);
        for (int i = ltid(); i < 64 * 16; i += NTHR) { const float inv = exp2f(-(float)(i & 15) * 0.8304820237218406f); float sn, cs; sincosf((float)(i >> 4) * inv, &sn, &cs); rt[i] = make_float2(cs, sn); }
    }
}
DI void phase_mod(const Params& P, LAS unsigned char* lds) {
    LAS float* SC = (LAS float*)lds;
    LAS float* ACC = SC + 33 * 1024;
    const int tid = ltid(), wid = tid >> 6;
    if (lbid() >= 192) return;
    for (int i = tid; i < 33 * 1024; i += NTHR) { const int b = i >> 10, k = i & 1023; const float v = b < 32 ? P.c[b * 1024 + k] : P.c_ctx[k]; SC[i] = v / (1.0f + __expf(-v)); }
    float* MOD = (float*)(P.ws + WS_MOD);
    for (int grp = lbid(); grp < 192; grp += lgdim()) {
        const int l = grp / 96, n0 = (grp % 96) * 64;
        for (int i = tid; i < 33 * 64; i += NTHR) ACC[i] = 0.f;
        __syncthreads();
        const int j = tid & 63, ks = tid >> 6;
        float acc[33];
#pragma unroll
        for (int b = 0; b < 33; ++b) acc[b] = 0.f;
        const float* w = P.ada_w + (size_t)l * 1024 * 6144 + n0 + j;
        for (int k = ks * 128; k < ks * 128 + 128; ++k) { const float wv = w[(size_t)k * 6144];
#pragma unroll
            for (int b = 0; b < 33; ++b) acc[b] += SC[b * 1024 + k] * wv; }
        for (int ww = 0; ww < 8; ++ww) {
            if (wid == ww) {
#pragma unroll
                for (int b = 0; b < 33; ++b) ACC[b * 64 + j] += acc[b]; }
            __syncthreads(); }
        for (int i = tid; i < 33 * 64; i += NTHR) { const int b = i >> 6, jj = i & 63; MOD[(size_t)(l * 33 + b) * 6144 + n0 + jj] = ACC[i] + P.ada_b[l * 6144 + n0 + jj]; }
        __syncthreads();
    }
}

template <bool F32SRC, bool FP8OUT> DI void phase_norm(const void* xsv, int rows, const float* gain, const float* mod, int is_ctx, int b0, int sh_idx, bf16_t* H) {
    const int tid_ = ltid(); const int lane = tid_ & 63, wid = tid_ >> 6;
    for (int r = lbid() * 8 + wid; r < rows; r += lgdim() * 8) {
        const int bi = is_ctx ? 32 : b0 + (r >> 11);
        const float* sh = mod + (size_t)bi * 6144 + sh_idx * 1024; const float* sc = sh + 1024;
        float4 v[4]; float ss = 0.f;
#pragma unroll
        for (int j = 0; j < 4; ++j) {
            if (F32SRC) v[j] = ((const float4*)((const float*)xsv + (size_t)r * 1024))[lane + 64 * j];
            else { const u32x2 w = ((const u32x2*)((const bf16_t*)xsv + (size_t)r * 1024))[lane + 64 * j]; v[j] = make_float4(lo2f(w.x), hi2f(w.x), lo2f(w.y), hi2f(w.y)); }
            ss += v[j].x * v[j].x + v[j].y * v[j].y + v[j].z * v[j].z + v[j].w * v[j].w; }
        ss = wave_sum(ss, lane);
        const float rstd = rsqrtf(ss * (1.0f / 1024.0f) + 1e-6f);
#pragma unroll
        for (int j = 0; j < 4; ++j) { const int c = (lane + 64 * j) * 4;
            const float4 g = *(const float4*)(gain + c), s1 = *(const float4*)(sc + c), s0 = *(const float4*)(sh + c);
            const float y0 = v[j].x * rstd * g.x * (1.f + s1.x) + s0.x, y1 = v[j].y * rstd * g.y * (1.f + s1.y) + s0.y, y2 = v[j].z * rstd * g.z * (1.f + s1.z) + s0.z, y3 = v[j].w * rstd * g.w * (1.f + s1.w) + s0.w;
            if (FP8OUT) *(unsigned*)((unsigned char*)H + (size_t)r * 1024 + c) = pk4_fp8(y0, y1, y2, y3);
            else { u32x2 w; w.x = pk2(y0, y1); w.y = pk2(y2, y3); *(u32x2*)(H + (size_t)r * 1024 + c) = w; } }
    }
}

DI void phase_prep(const bf16_t* Z, int rows, int is_ctx, float* RS, bf16_t* KR, bf16_t* PD, bool do_pool, const float2* rt) {
    const int tid_ = ltid(); const int lane = tid_ & 63, wid = tid_ >> 6;
    const int seqlen = is_ctx ? TC : TL;
    for (int r = lbid() * 8 + wid; r < rows; r += lgdim() * 8) {
        const bf16_t* zr = Z + (size_t)r * ZLD;
        float sq = 0.f, sk = 0.f;
        { const unsigned* p = (const unsigned*)(zr + ZC_QDN + lane * 6);
#pragma unroll
          for (int i = 0; i < 3; ++i) { const unsigned w = p[i]; const float a = lo2f(w), b = hi2f(w); sq += a * a + b * b; } }
        { const u32x2 w = *(const u32x2*)(zr + ZC_KVDN + lane * 4); const float a = lo2f(w.x), b = hi2f(w.x), c = lo2f(w.y), d = hi2f(w.y); sk = a * a + b * b + c * c + d * d; }
        sq = wave_sum(sq, lane); sk = wave_sum(sk, lane);
        if (lane == 0) { RS[r] = rsqrtf(sq * (1.0f / 384.0f) + 1e-6f); RS[16384 + r] = rsqrtf(sk * (1.0f / 256.0f) + 1e-6f); }
        { const float x = bf2f(zr[ZC_KROPE + lane]); const float xp = shx(x, 16, lane); float o = x;
          if (!is_ctx) { const int t = r & (TL - 1); const int pos = (lane < 32) ? (t >> 6) : (t & 63); const int i = lane & 15;
              const float2 cs = rt[pos * 16 + i]; const float c = cs.x, s = cs.y;
              o = ((lane & 31) < 16) ? (x * c - xp * s) : (xp * s + x * c); }
          KR[(size_t)r * 64 + lane] = f2bf(o); }
        if (do_pool) {
            const int t = r % seqlen, seq0 = r - t;
#pragma unroll
            for (int j = 0; j < 4; ++j) {
                const int hw = 1 << j; const int lo = (t - hw) < 0 ? 0 : (t - hw); const int hi = (t + hw) > seqlen ? seqlen : (t + hw);
                const int c = j * 256 + lane * 4; float s0 = 0.f, s1 = 0.f, s2 = 0.f, s3 = 0.f;
#pragma unroll
                for (int k = 0; k < 2 * hw; ++k) {
                    const int tt = t - hw + k; const bool ok = tt >= 0 && tt < seqlen; const int tc = ok ? tt : t;
                    const u32x2 w = *(const u32x2*)(Z + (size_t)(seq0 + tc) * ZLD + ZC_P + c); const float m = ok ? 1.f : 0.f;
                    s0 += m * lo2f(w.x); s1 += m * hi2f(w.x); s2 += m * lo2f(w.y); s3 += m * hi2f(w.y); }
                const u32x2 me = *(const u32x2*)(zr + ZC_P + c); const float inv = 1.0f / (float)(hi - lo);
                *(unsigned*)((unsigned char*)PD + (size_t)r * 1024 + c) = pk4_fp8(s0 * inv - lo2f(me.x), s1 * inv - hi2f(me.x), s2 * inv - lo2f(me.y), s3 * inv - hi2f(me.y)); }
        }
    }
}

template <class Fill> struct GridSched { int nM, nN, G, c; Fill fill;
    DI bool next(int i, Unit& u) const { const long L = (long)i * G + c; if (L >= (long)nM * nN) return false; int pm, pn; pg8::tile_of((int)L, nM, nN, pm, pn); u.pm = pm; u.pn = pn; u.z = 0; u.sa = 0x7f7f7f7fu; fill(u); return true; } };
template <class Fill> DI GridSched<Fill> make_sched(int nM, int nN, Fill f) { GridSched<Fill> s{nM, nN, lgdim(), lbid(), f}; return s; }
template <class Fill> struct TripleSched { int nM, nN, G, c; Fill fill;
    DI bool next(int i, Unit& u) const { const long L = (long)(i / 3) * G + c; if (L >= (long)nM * nN) return false; int pm, pn; pg8::tile_of((int)L, nM, nN, pm, pn); u.pm = pm; u.pn = pn; u.z = i % 3; u.sa = 0x7f7f7f7fu; fill(u); return true; } };

DI bf16x8 pack8(const f32x16& x, int sp) { u32x4 p; p.x = pk2(x[8 * sp], x[8 * sp + 1]); p.y = pk2(x[8 * sp + 2], x[8 * sp + 3]); p.z = pk2(x[8 * sp + 4], x[8 * sp + 5]); p.w = pk2(x[8 * sp + 6], x[8 * sp + 7]);
    return __builtin_bit_cast(bf16x8, p); }
DI bf16x8 read_perm(const LAS unsigned char* p) {
    const s16x4 lo = *(const LAS s16x4*)p, hi = *(const LAS s16x4*)(p + 16);
    bf16x8 v; v[0] = lo[0]; v[1] = lo[1]; v[2] = lo[2]; v[3] = lo[3]; v[4] = hi[0]; v[5] = hi[1]; v[6] = hi[2]; v[7] = hi[3]; return v; }
DI void store8_bf16(bf16_t* p, const f32x4& a, const f32x4& b) { u32x4 w; w.x = pk2(a[0], a[1]); w.y = pk2(a[2], a[3]); w.z = pk2(b[0], b[1]); w.w = pk2(b[2], b[3]); *(u32x4*)p = w; }

DI void attn_item(LAS unsigned char* lds, const float2* rt, const bf16_t* Qp, int h, bool rope, int tq0,
                  const bf16_t* kn0, const bf16_t* kr0, const bf16_t* vt0, int ldv0, int nt0,
                  const bf16_t* kn1, const bf16_t* kr1, const bf16_t* vt1, int ldv1, int nt1, unsigned char* Op) {
    int tid = threadIdx.x; asm volatile("" : "+v"(tid));
    const int wid = tid >> 6, lane = tid & 63, ql = lane & 31, hh = lane >> 5;
    const bool grpB = __builtin_amdgcn_readfirstlane(wid) >= 4;
    constexpr int KPITCH = 400, VPITCH = 136, VOFF = 64 * KPITCH, BUFB = VOFF + 128 * VPITCH;
    constexpr float SL = 0.10411755f;
    bf16x8 qf[12];
    { const bf16_t* qrow = Qp + (size_t)(wid * 32 + ql) * 1536 + h * 192;
#pragma unroll
      for (int ks = 0; ks < 12; ++ks) qf[ks] = *(const bf16x8*)(qrow + ks * 16 + hh * 8); }
    if (rope) {
        const int t = tq0 + wid * 32 + ql; const int rp = t >> 6, cp = t & 63;
#pragma unroll
        for (int j = 0; j < 8; ++j) {
            float2 cs = rt[rp * 16 + 8 * hh + j]; float c = cs.x, s = cs.y;
            { const float x1 = bf2f((bf16_t)qf[8][j]), x2 = bf2f((bf16_t)qf[9][j]); qf[8][j] = (short)f2bf(x1 * c - x2 * s); qf[9][j] = (short)f2bf(x1 * s + x2 * c); }
            cs = rt[cp * 16 + 8 * hh + j]; c = cs.x; s = cs.y;
            { const float x1 = bf2f((bf16_t)qf[10][j]), x2 = bf2f((bf16_t)qf[11][j]); qf[10][j] = (short)f2bf(x1 * c - x2 * s); qf[11][j] = (short)f2bf(x1 * s + x2 * c); }
        }
    }
    f32x16 oacc[4];
#pragma unroll
    for (int db = 0; db < 4; ++db)
#pragma unroll
        for (int r = 0; r < 16; ++r) oacc[db][r] = 0.f;
    float m_run = -1e30f, l_run = 0.f;
    const int ntile = nt0 + nt1;
    u32x4 kst[3], vst[2];
    auto issueK = [&](int j) {
        const bool s1 = j >= nt0; const int key0 = (s1 ? j - nt0 : j) * 64;
        const bf16_t* kn = s1 ? kn1 : kn0; const bf16_t* kr = s1 ? kr1 : kr0;
#pragma unroll
        for (int i = 0; i < 2; ++i) { const int id = tid + 512 * i, key = id >> 4, c = id & 15;
            kst[i] = *(const u32x4*)(kn + (size_t)(key0 + key) * 1024 + h * 128 + c * 8); }
        { const int key = tid >> 3, c = tid & 7;
            kst[2] = *(const u32x4*)(kr + (size_t)(key0 + key) * 64 + c * 8); } };
    auto issueV = [&](int j) {
        const bool s1 = j >= nt0; const int key0 = (s1 ? j - nt0 : j) * 64;
        const bf16_t* vt = s1 ? vt1 : vt0; const int ldv = s1 ? ldv1 : ldv0;
#pragma unroll
        for (int i = 0; i < 2; ++i) { const int id = tid + 512 * i, d = id >> 3, c = id & 7;
            vst[i] = *(const u32x4*)(vt + (size_t)(h * 128 + d) * ldv + key0 + c * 8); } };
    auto commitK = [&](int buf) {
        LAS unsigned char* base = lds + buf * BUFB;
#pragma unroll
        for (int i = 0; i < 2; ++i) { const int id = tid + 512 * i, key = id >> 4, c = id & 15; *(LAS u32x4*)(base + key * KPITCH + c * 16) = kst[i]; }
        { const int key = tid >> 3, c = tid & 7; *(LAS u32x4*)(base + key * KPITCH + (16 + c) * 16) = kst[2]; } };
    auto commitV = [&](int buf) {
        LAS unsigned char* base = lds + buf * BUFB + VOFF;
#pragma unroll
        for (int i = 0; i < 2; ++i) { const int id = tid + 512 * i, d = id >> 3, c = id & 7; LAS u32x2* p = (LAS u32x2*)(base + d * VPITCH + c * 16);
            u32x2 a; a.x = vst[i].x; a.y = vst[i].y; u32x2 b; b.x = vst[i].z; b.y = vst[i].w; p[0] = a; p[1] = b; } };
    auto wgbar = [&]() { asm volatile("s_waitcnt lgkmcnt(0)" ::: "memory"); __builtin_amdgcn_s_barrier(); asm volatile("" ::: "memory"); };
    f32x16 s0, s1;
    auto scores = [&](int j) {
        const LAS unsigned char* Kb = lds + (j & 1) * BUFB;
#pragma unroll
        for (int r = 0; r < 16; ++r) { s0[r] = 0.f; s1[r] = 0.f; }
        const LAS unsigned char* kp0 = Kb + ql * KPITCH + hh * 16; const LAS unsigned char* kp1 = Kb + (32 + ql) * KPITCH + hh * 16;
        bf16x8 k0c = *(const LAS bf16x8*)kp0, k1c = *(const LAS bf16x8*)kp1;
#pragma unroll
        for (int ks = 0; ks < 12; ++ks) {
            bf16x8 k0n = k0c, k1n = k1c;
            if (ks < 11) { k0n = *(const LAS bf16x8*)(kp0 + (ks + 1) * 32); k1n = *(const LAS bf16x8*)(kp1 + (ks + 1) * 32); }
            __builtin_amdgcn_sched_barrier(0);
            s0 = __builtin_amdgcn_mfma_f32_32x32x16_bf16(k0c, qf[ks], s0, 0, 0, 0);
            s1 = __builtin_amdgcn_mfma_f32_32x32x16_bf16(k1c, qf[ks], s1, 0, 0, 0);
            __builtin_amdgcn_sched_barrier(0);
            k0c = k0n; k1c = k1n;
        }
        float mx = s0[0];
#pragma unroll
        for (int r = 0; r < 16; ++r) { mx = fmaxf(mx, s0[r]); mx = fmaxf(mx, s1[r]); }
        mx = fmaxf(mx, shx(mx, 32, lane));
        const bool grow = (mx - m_run) * SL > 8.0f;
        if (__builtin_amdgcn_ballot_w64(grow) != 0ull) {
            const float m_new = grow ? mx : m_run; const float alpha = exp2f((m_run - m_new) * SL); m_run = m_new;
            l_run *= alpha;
#pragma unroll
            for (int db = 0; db < 4; ++db)
#pragma unroll
                for (int r = 0; r < 16; ++r) oacc[db][r] *= alpha;
        }
    };
    auto pv = [&](int j) {
        { float ps = 0.f; const float mb = m_run * SL;
#pragma unroll
          for (int r = 0; r < 16; ++r) { s0[r] = exp2f(s0[r] * SL - mb); s1[r] = exp2f(s1[r] * SL - mb); ps += s0[r] + s1[r]; }
          l_run += ps; }
        const LAS unsigned char* vbase = lds + (j & 1) * BUFB + VOFF + ql * VPITCH + hh * 8;
        bf16x8 vc = read_perm(vbase);
#pragma unroll
        for (int it = 0; it < 16; ++it) {
            const int kb = it >> 3, sp = (it >> 2) & 1, db = it & 3;
            bf16x8 vn = vc;
            if (it < 15) { const int kb2 = (it + 1) >> 3, sp2 = ((it + 1) >> 2) & 1, db2 = (it + 1) & 3; vn = read_perm(vbase + db2 * 32 * VPITCH + (32 * kb2 + 16 * sp2) * 2); }
            const bf16x8 pf = pack8(kb == 0 ? s0 : s1, sp);
            __builtin_amdgcn_sched_barrier(0);
            if (db == 0) oacc[0] = __builtin_amdgcn_mfma_f32_32x32x16_bf16(vc, pf, oacc[0], 0, 0, 0);
            if (db == 1) oacc[1] = __builtin_amdgcn_mfma_f32_32x32x16_bf16(vc, pf, oacc[1], 0, 0, 0);
            if (db == 2) oacc[2] = __builtin_amdgcn_mfma_f32_32x32x16_bf16(vc, pf, oacc[2], 0, 0, 0);
            if (db == 3) oacc[3] = __builtin_amdgcn_mfma_f32_32x32x16_bf16(vc, pf, oacc[3], 0, 0, 0);
            __builtin_amdgcn_sched_barrier(0);
            vc = vn;
        }
    };
    issueK(0); issueV(0); commitK(0); commitV(0); wgbar();
    if (!grpB) {
        for (int m = 0; m < ntile; ++m) {
            if (m >= 1) commitV(m & 1);
            if (m + 1 < ntile) issueK(m + 1);
            scores(m);
            wgbar();
            if (m + 1 < ntile) { commitK((m + 1) & 1); issueV(m + 1); }
            pv(m);
            wgbar();
        }
        wgbar();
    } else {
        if (1 < ntile) issueK(1);
        wgbar();
        for (int m = 0; m < ntile; ++m) {
            if (m + 1 < ntile) { commitK((m + 1) & 1); issueV(m + 1); }
            scores(m);
            wgbar();
            if (m + 1 < ntile) commitV((m + 1) & 1);
            if (m + 2 < ntile) issueK(m + 2);
            pv(m);
            wgbar();
        }
    }
    const float linv = 4.0f / (l_run + shx(l_run, 32, lane));
    unsigned char* orow = Op + (size_t)(wid * 32 + ql) * 1024 + h * 128;
#pragma unroll
    for (int db = 0; db < 4; ++db)
#pragma unroll
        for (int g = 0; g < 4; ++g) *(unsigned*)(orow + db * 32 + g * 8 + hh * 4) = pk4_fp8(oacc[db][4 * g] * linv, oacc[db][4 * g + 1] * linv, oacc[db][4 * g + 2] * linv, oacc[db][4 * g + 3] * linv);
    __syncthreads();
}

DI void gla_item(LAS unsigned char* lds, const bf16_t* Zseq, int len, int h, int dir, const float* gw, const float* gb,
                 const float* Sin, float* Sout, bf16_t* Oseq) {
    constexpr int QP = 272, KDP = 144, VP = 144;
    LAS unsigned char* QE = lds; LAS unsigned char* KE = lds + 17408; LAS unsigned char* KDT = lds + 34816; LAS unsigned char* VT = lds + 53248;
    LAS float* LR = (LAS float*)(lds + 90112); LAS float* SEG = (LAS float*)(lds + 94208); LAS float* DEC = (LAS float*)(lds + 96256);
    int tid = threadIdx.x; asm volatile("" : "+v"(tid));
    const int wid = tid >> 6, lane = tid & 63, ql = lane & 31, hh = lane >> 5, d = tid & 127, part = tid >> 7;
    float gwr[16];
#pragma unroll
    for (int j = 0; j < 16; ++j) gwr[j] = gw[j * 512 + h * 128 + d];
    const float gbr = gb[h * 128 + d];
    f32x16 S[4];
#pragma unroll
    for (int db = 0; db < 4; ++db)
#pragma unroll
        for (int r = 0; r < 16; ++r) S[db][r] = Sin ? Sin[(size_t)(32 * db + (r & 3) + 8 * (r >> 2) + 4 * hh) * 256 + 32 * wid + ql] : 0.f;
    const int lrcol = dir ? ZC_LRB : ZC_LRF;
    for (int n0 = 0; n0 < len; n0 += 64) {
#pragma unroll
        for (int i = 0; i < 2; ++i) { const int e = tid + 512 * i, row = e >> 4, j = e & 15; const int t = dir ? len - 1 - (n0 + row) : n0 + row;
            LR[e] = bf2f(Zseq[(size_t)t * ZLD + lrcol + j]); }
#pragma unroll
        for (int i = 0; i < 4; ++i) { const int cidx = tid + 512 * i, row = cidx & 63, c8 = cidx >> 6; const int t = dir ? len - 1 - (n0 + row) : n0 + row;
            const u32x4 v = *(const u32x4*)(Zseq + (size_t)t * ZLD + ZC_V + h * 256 + c8 * 8);
            LAS bf16_t* vp = (LAS bf16_t*)(VT + (c8 * 8) * VP + row * 2);
            const unsigned v0 = v.x, v1 = v.y, v2 = v.z, v3 = v.w;
            vp[0 * (VP / 2)] = (bf16_t)v0; vp[1 * (VP / 2)] = (bf16_t)(v0 >> 16); vp[2 * (VP / 2)] = (bf16_t)v1; vp[3 * (VP / 2)] = (bf16_t)(v1 >> 16);
            vp[4 * (VP / 2)] = (bf16_t)v2; vp[5 * (VP / 2)] = (bf16_t)(v2 >> 16); vp[6 * (VP / 2)] = (bf16_t)v3; vp[7 * (VP / 2)] = (bf16_t)(v3 >> 16); }
        bf16_t qraw[16], kraw[16];
#pragma unroll
        for (int ii = 0; ii < 16; ++ii) { const int row = part * 16 + ii; const int t = dir ? len - 1 - (n0 + row) : n0 + row;
            qraw[ii] = Zseq[(size_t)t * ZLD + ZC_Q + h * 128 + d]; kraw[ii] = Zseq[(size_t)t * ZLD + ZC_K + h * 128 + d]; }
        __syncthreads();
        float bl[16]; float run = 0.f;
#pragma unroll
        for (int ii = 0; ii < 16; ++ii) { float z = gbr;
#pragma unroll
            for (int j = 0; j < 16; ++j) z += LR[(part * 16 + ii) * 16 + j] * gwr[j];
            run += (fminf(z, 0.f) - __logf(1.0f + __expf(-fabsf(z)))) * 0.0625f; bl[ii] = run; }
        SEG[part * 128 + d] = run;
        __syncthreads();
        float off = 0.f, blast = 0.f;
#pragma unroll
        for (int pp = 0; pp < 4; ++pp) { const float sg = SEG[pp * 128 + d]; off += (pp < part) ? sg : 0.f; blast += sg; }
        if (part == 0) DEC[d] = __expf(blast);
        unsigned kdp[8];
#pragma unroll
        for (int ii = 0; ii < 16; ++ii) { const int row = part * 16 + ii; const float b = off + bl[ii];
            const float qv = bf2f(qraw[ii]), kv = bf2f(kraw[ii]);
            *(LAS bf16_t*)(QE + row * QP + d * 2) = f2bf(qv * __expf(b));
            *(LAS bf16_t*)(KE + row * QP + d * 2) = f2bf(kv * __expf(-b));
            const unsigned kd = f2bf(kv * __expf(blast - b));
            if (ii & 1) kdp[ii >> 1] |= kd << 16; else kdp[ii >> 1] = kd; }
        { u32x4 a; a.x = kdp[0]; a.y = kdp[1]; a.z = kdp[2]; a.w = kdp[3]; u32x4 b; b.x = kdp[4]; b.y = kdp[5]; b.z = kdp[6]; b.w = kdp[7];
          *(LAS u32x4*)(KDT + d * KDP + part * 32) = a; *(LAS u32x4*)(KDT + d * KDP + part * 32 + 16) = b; }
        __syncthreads();
        f32x16 att00, att01, att11, o0, o1;
#pragma unroll
        for (int r = 0; r < 16; ++r) { att00[r] = 0.f; att01[r] = 0.f; att11[r] = 0.f; o0[r] = 0.f; o1[r] = 0.f; }
#pragma unroll
        for (int ks = 0; ks < 8; ++ks) {
            const int co = (ks * 16 + hh * 8) * 2;
            const bf16x8 kf0 = *(const LAS bf16x8*)(KE + ql * QP + co), kf1 = *(const LAS bf16x8*)(KE + (32 + ql) * QP + co);
            const bf16x8 qf0 = *(const LAS bf16x8*)(QE + ql * QP + co), qf1 = *(const LAS bf16x8*)(QE + (32 + ql) * QP + co);
            att00 = __builtin_amdgcn_mfma_f32_32x32x16_bf16(kf0, qf0, att00, 0, 0, 0);
            att01 = __builtin_amdgcn_mfma_f32_32x32x16_bf16(kf0, qf1, att01, 0, 0, 0);
            att11 = __builtin_amdgcn_mfma_f32_32x32x16_bf16(kf1, qf1, att11, 0, 0, 0);
            if (ks & 1) __builtin_amdgcn_sched_barrier(0);
        }
#pragma unroll
        for (int r = 0; r < 16; ++r) { const int srow = (r & 3) + 8 * (r >> 2) + 4 * hh; if (srow > ql) { att00[r] = 0.f; att11[r] = 0.f; } }
        const LAS unsigned char* vrow = VT + (32 * wid + ql) * VP + hh * 8;
#pragma unroll
        for (int sp = 0; sp < 2; ++sp) {
            const bf16x8 va = read_perm(vrow + (16 * sp) * 2), vb = read_perm(vrow + (32 + 16 * sp) * 2);
            o0 = __builtin_amdgcn_mfma_f32_32x32x16_bf16(va, pack8(att00, sp), o0, 0, 0, 0);
            o1 = __builtin_amdgcn_mfma_f32_32x32x16_bf16(va, pack8(att01, sp), o1, 0, 0, 0);
            o1 = __builtin_amdgcn_mfma_f32_32x32x16_bf16(vb, pack8(att11, sp), o1, 0, 0, 0);
        }
#pragma unroll
        for (int db = 0; db < 4; ++db)
#pragma unroll
            for (int sp = 0; sp < 2; ++sp) {
                const bf16x8 sa = pack8(S[db], sp);
                const int co = (32 * db + 16 * sp + 4 * hh) * 2;
                const bf16x8 qb0 = read_perm(QE + ql * QP + co), qb1 = read_perm(QE + (32 + ql) * QP + co);
                o0 = __builtin_amdgcn_mfma_f32_32x32x16_bf16(sa, qb0, o0, 0, 0, 0);
                o1 = __builtin_amdgcn_mfma_f32_32x32x16_bf16(sa, qb1, o1, 0, 0, 0);
                if (sp) __builtin_amdgcn_sched_barrier(0);
            }
#pragma unroll
        for (int db = 0; db < 4; ++db) {
#pragma unroll
            for (int g4 = 0; g4 < 4; ++g4) { const f32x4 dc = *(const LAS f32x4*)(DEC + 32 * db + 8 * g4 + 4 * hh);
#pragma unroll
                for (int i = 0; i < 4; ++i) S[db][4 * g4 + i] *= dc[i]; }
#pragma unroll
            for (int ks = 0; ks < 4; ++ks) {
                const bf16x8 af = *(const LAS bf16x8*)(KDT + (32 * db + ql) * KDP + (16 * ks + 8 * hh) * 2);
                const bf16x8 bv = *(const LAS bf16x8*)(VT + (32 * wid + ql) * VP + (16 * ks + 8 * hh) * 2);
                S[db] = __builtin_amdgcn_mfma_f32_32x32x16_bf16(af, bv, S[db], 0, 0, 0);
            }
            __builtin_amdgcn_sched_barrier(0);
        }
#pragma unroll
        for (int tb = 0; tb < 2; ++tb) { const int row = 32 * tb + ql; const int t = dir ? len - 1 - (n0 + row) : n0 + row;
            bf16_t* op = Oseq + (size_t)t * 1024 + h * 256 + 32 * wid + 4 * hh;
#pragma unroll
            for (int g4 = 0; g4 < 4; ++g4) { u32x2 w2;
                if (tb == 0) { w2.x = pk2(o0[4 * g4], o0[4 * g4 + 1]); w2.y = pk2(o0[4 * g4 + 2], o0[4 * g4 + 3]); }
                else { w2.x = pk2(o1[4 * g4], o1[4 * g4 + 1]); w2.y = pk2(o1[4 * g4 + 2], o1[4 * g4 + 3]); }
                *(u32x2*)(op + 8 * g4) = w2; } }
        __syncthreads();
    }
    if (Sout) {
#pragma unroll
        for (int db = 0; db < 4; ++db)
#pragma unroll
            for (int r = 0; r < 16; ++r) Sout[(size_t)(32 * db + (r & 3) + 8 * (r >> 2) + 4 * hh) * 256 + 32 * wid + ql] = S[db][r]; }
}

DI void phase_glafin(const bf16_t* OF, const bf16_t* OB, const bf16_t* Z, const float* gg, int rows, bf16_t* GF) {
    const int tid_ = ltid(); const int lane = tid_ & 63, wid = tid_ >> 6;
    const float4 g4 = *(const float4*)(gg + lane * 4);
    for (int r = lbid() * 8 + wid; r < rows; r += lgdim() * 8) {
#pragma unroll
        for (int h = 0; h < 4; ++h) {
            const int c = h * 256 + lane * 4;
            const u32x2 a = *(const u32x2*)(OF + (size_t)r * 1024 + c), b = *(const u32x2*)(OB + (size_t)r * 1024 + c), rr = *(const u32x2*)(Z + (size_t)r * ZLD + ZC_R + c);
            const float s0 = lo2f(a.x) + lo2f(b.x), s1 = hi2f(a.x) + hi2f(b.x), s2 = lo2f(a.y) + lo2f(b.y), s3 = hi2f(a.y) + hi2f(b.y);
            const float ss = wave_sum(s0 * s0 + s1 * s1 + s2 * s2 + s3 * s3, lane);
            const float rstd = rsqrtf(ss * (1.0f / 256.0f) + 1e-6f);
            const float r0 = lo2f(rr.x), r1 = hi2f(rr.x), r2 = lo2f(rr.y), r3 = hi2f(rr.y);
            *(unsigned*)((unsigned char*)GF + (size_t)r * 1024 + c) = pk4_fp8(s0 * rstd * g4.x * (r0 * sigmoidf_(r0)), s1 * rstd * g4.y * (r1 * sigmoidf_(r1)), s2 * rstd * g4.z * (r2 * sigmoidf_(r2)), s3 * rstd * g4.w * (r3 * sigmoidf_(r3)));
        }
    }
}

DI unsigned fkey(float f) { const unsigned u = __float_as_uint(f); return u ^ ((unsigned)((int)u >> 31) | 0x80000000u); }
DI float unfkey(unsigned k) { return __uint_as_float((k & 0x80000000u) ? (k ^ 0x80000000u) : ~k); }
DI void key_insert(unsigned (&t)[16], unsigned k) {
#pragma unroll
    for (int j = 0; j < 16; ++j) { const unsigned hi = t[j] > k ? t[j] : k; const unsigned lo = t[j] > k ? k : t[j]; t[j] = hi; k = lo; }
}
DI void phase_select(const _Float16* SC, int rows, uint2* ROUTE, unsigned short* EID, LAS unsigned char* lds) {
    const int tid_ = ltid(); const int lane = tid_ & 63, wid = tid_ >> 6;
    LAS float* T = (LAS float*)lds + wid * (64 * 65);
    for (int pbase = (lbid() * 8 + wid) * 64; pbase < rows * 8; pbase += lgdim() * 8 * 64) {
        const int p = pbase + lane;
        unsigned k1[16], k2[16];
#pragma unroll
        for (int j = 0; j < 16; ++j) { k1[j] = 0u; k2[j] = 0u; }
#pragma unroll
        for (int pass = 0; pass < 4; ++pass) {
#pragma unroll
            for (int k = 0; k < 8; ++k) { const int pp = 8 * k + (lane >> 3), c8 = lane & 7;
                const h16x8 v = *(const h16x8*)(SC + (size_t)(pbase + pp) * 256 + pass * 32 + (c8 & 3) * 8 + (c8 >> 2) * 128);
                LAS float* tp = T + (8 * c8) * 65 + pp;
#pragma unroll
                for (int c = 0; c < 8; ++c) tp[c * 65] = (float)v[c]; }
            for (int f = 0; f < 32; ++f) { const float va = T[f * 65 + lane], vb = T[(32 + f) * 65 + lane]; const unsigned ix = (unsigned)(127 - (pass * 32 + f));
                key_insert(k1, (fkey(va) & ~127u) | ix); key_insert(k2, (fkey(vb) & ~127u) | ix); }
        }
        float t1[16], t2[16]; unsigned i1p[4] = {0u, 0u, 0u, 0u}, i2p[4] = {0u, 0u, 0u, 0u};
#pragma unroll
        for (int j = 0; j < 16; ++j) { t1[j] = unfkey(k1[j] & ~127u); t2[j] = unfkey(k2[j] & ~127u);
            i1p[j >> 2] |= (127u - (k1[j] & 127u)) << (8 * (j & 3)); i2p[j >> 2] |= (127u - (k2[j] & 127u)) << (8 * (j & 3)); }
        unsigned kc[16];
#pragma unroll
        for (int j = 0; j < 16; ++j) kc[j] = 0u;
#pragma unroll
        for (int a = 0; a < 16; ++a)
#pragma unroll
            for (int b = 0; b < 16; ++b)
                if ((a + 1) * (b + 1) <= 16) key_insert(kc, (fkey(t1[a] + t2[b]) & ~255u) | (unsigned)(a * 16 + b));
        float e[16]; unsigned ei[16]; float mx = -3.0e38f;
#pragma unroll
        for (int j = 0; j < 16; ++j) { const unsigned a = (kc[j] >> 4) & 15u, b = kc[j] & 15u;
            const unsigned wa = (a >> 2) == 0u ? i1p[0] : (a >> 2) == 1u ? i1p[1] : (a >> 2) == 2u ? i1p[2] : i1p[3];
            const unsigned wb = (b >> 2) == 0u ? i2p[0] : (b >> 2) == 1u ? i2p[1] : (b >> 2) == 2u ? i2p[2] : i2p[3];
            ei[j] = (((wa >> (8 * (a & 3u))) & 127u) << 7) | ((wb >> (8 * (b & 3u))) & 127u);
            e[j] = unfkey(kc[j] & ~255u); mx = fmaxf(mx, e[j]); }
        float sum = 0.f;
#pragma unroll
        for (int j = 0; j < 16; ++j) { e[j] = __expf(e[j] - mx); sum += e[j]; }
        const float inv = 1.0f / sum;
        uint2* dst = ROUTE + (size_t)p * 16; unsigned short* de = EID + (size_t)p * 16;
#pragma unroll
        for (int j = 0; j < 16; ++j) { dst[j] = make_uint2(ei[j], __float_as_uint(e[j] * inv)); de[j] = (unsigned short)ei[j]; }
    }
}

DI float dot2u(unsigned a, unsigned b, float acc) { return __builtin_amdgcn_fdot2_f32_bf16(__builtin_bit_cast(bf16x2_t, a), __builtin_bit_cast(bf16x2_t, b), acc, false); }
DI float dot8(const u32x4& a, const u32x4& b, float acc) {
    const unsigned a0 = a.x, a1 = a.y, a2 = a.z, a3 = a.w, b0 = b.x, b1 = b.y, b2 = b.z, b3 = b.w;
    acc = dot2u(a0, b0, acc); acc = dot2u(a1, b1, acc); acc = dot2u(a2, b2, acc); acc = dot2u(a3, b3, acc);
    return acc;
}
template <int CTRL> DI float dppf(float v) { return __builtin_bit_cast(float, __builtin_amdgcn_update_dpp(0, __builtin_bit_cast(int, v), CTRL, 0xF, 0xF, true)); }
typedef float f32x2_t __attribute__((ext_vector_type(2)));
DI void phase_peer_u(const bf16_t* H2, const unsigned short* EID, const unsigned char* PU, int rows, float* PART) {
    const int tid_ = ltid(); const int lane = tid_ & 63, wid = tid_ >> 6, g = lane >> 3, pc = lane & 7;
    const int x = lbid() & 7, gw = (lbid() >> 3) * 8 + wid, nw = (lgdim() >> 3) * 8;
    const unsigned lbase = ((unsigned)x << 21) + (unsigned)(pc * 16);
    auto finish = [&](int r, const u32x4 (&uv)[16], const u32x4& h0, const u32x4& h1) {
        f32x2_t hp[8];
        { const unsigned a0 = h0.x, a1 = h0.y, a2 = h0.z, a3 = h0.w, b0 = h1.x, b1 = h1.y, b2 = h1.z, b3 = h1.w;
          hp[0] = (f32x2_t){lo2f(a0), hi2f(a0)}; hp[1] = (f32x2_t){lo2f(a1), hi2f(a1)}; hp[2] = (f32x2_t){lo2f(a2), hi2f(a2)}; hp[3] = (f32x2_t){lo2f(a3), hi2f(a3)};
          hp[4] = (f32x2_t){lo2f(b0), hi2f(b0)}; hp[5] = (f32x2_t){lo2f(b1), hi2f(b1)}; hp[6] = (f32x2_t){lo2f(b2), hi2f(b2)}; hp[7] = (f32x2_t){lo2f(b3), hi2f(b3)}; }
        float a[16];
#pragma unroll
        for (int j = 0; j < 16; ++j) {
            const unsigned w0 = uv[j].x, w1 = uv[j].y, w2 = uv[j].z, w3 = uv[j].w;
            f32x2_t s = __builtin_amdgcn_cvt_pk_f32_fp8((int)w0, false) * hp[0];
            s = __builtin_elementwise_fma(__builtin_amdgcn_cvt_pk_f32_fp8((int)w0, true), hp[1], s);
            s = __builtin_elementwise_fma(__builtin_amdgcn_cvt_pk_f32_fp8((int)w1, false), hp[2], s);
            s = __builtin_elementwise_fma(__builtin_amdgcn_cvt_pk_f32_fp8((int)w1, true), hp[3], s);
            s = __builtin_elementwise_fma(__builtin_amdgcn_cvt_pk_f32_fp8((int)w2, false), hp[4], s);
            s = __builtin_elementwise_fma(__builtin_amdgcn_cvt_pk_f32_fp8((int)w2, true), hp[5], s);
            s = __builtin_elementwise_fma(__builtin_amdgcn_cvt_pk_f32_fp8((int)w3, false), hp[6], s);
            s = __builtin_elementwise_fma(__builtin_amdgcn_cvt_pk_f32_fp8((int)w3, true), hp[7], s);
            a[j] = s[0] + s[1];
        }
        const bool u4 = (pc & 4) != 0, u2 = (pc & 2) != 0, u1 = (pc & 1) != 0;
        float k8[8], k4[4], k2[2];
#pragma unroll
        for (int i = 0; i < 8; ++i) { const float send = u4 ? a[i] : a[i + 8]; k8[i] = (u4 ? a[i + 8] : a[i]) + dppf<0x141>(send); }
#pragma unroll
        for (int i = 0; i < 4; ++i) { const float send = u2 ? k8[i] : k8[i + 4]; k4[i] = (u2 ? k8[i + 4] : k8[i]) + dppf<0x4E>(send); }
#pragma unroll
        for (int i = 0; i < 2; ++i) { const float send = u1 ? k4[i] : k4[i + 2]; k2[i] = (u1 ? k4[i + 2] : k4[i]) + dppf<0xB1>(send); }
        if (r < rows) *(float2*)(PART + (unsigned)((r * 8 + x) * 128 + g * 16 + 2 * pc)) = make_float2(k2[0] * 0.03125f, k2[1] * 0.03125f); };
    auto ids = [&](int r, unsigned (&e)[8]) { const int rr = r < rows ? r : rows - 1;
        const u32x4* ep = (const u32x4*)(EID + (unsigned)(rr * 128 + g * 16)); const u32x4 t0 = ep[0], t1 = ep[1];
        e[0] = t0.x; e[1] = t0.y; e[2] = t0.z; e[3] = t0.w; e[4] = t1.x; e[5] = t1.y; e[6] = t1.z; e[7] = t1.w; };
    auto issue = [&](int r, const unsigned (&e)[8], u32x4 (&uv)[16], u32x4& h0, u32x4& h1) {
#pragma unroll
        for (int j = 0; j < 16; ++j) uv[j] = *(const u32x4*)(PU + ((((j & 1) ? (e[j >> 1] >> 16) : (e[j >> 1] & 0xffffu)) << 7) + lbase));
        const int rr = r < rows ? r : rows - 1;
        const u32x4* hp = (const u32x4*)(H2 + (unsigned)(rr * 1024 + x * 128 + pc * 16)); h0 = hp[0]; h1 = hp[1]; };
    unsigned eA[8], eB[8]; u32x4 hA0, hA1, hB0, hB1; u32x4 uA[16], uB[16];
    ids(gw, eA); ids(gw + nw, eB);
    issue(gw, eA, uA, hA0, hA1); ids(gw + 2 * nw, eA);
    issue(gw + nw, eB, uB, hB0, hB1); ids(gw + 3 * nw, eB);
    for (int r = gw; r < rows; r += 2 * nw) {
        __builtin_amdgcn_sched_barrier(0);
        finish(r, uA, hA0, hA1);
        __builtin_amdgcn_sched_barrier(0);
        issue(r + 2 * nw, eA, uA, hA0, hA1); ids(r + 4 * nw, eA);
        __builtin_amdgcn_sched_barrier(0);
        finish(r + nw, uB, hB0, hB1);
        __builtin_amdgcn_sched_barrier(0);
        issue(r + 3 * nw, eB, uB, hB0, hB1); ids(r + 5 * nw, eB);
    }
}
DI void phase_peer_w(const float* PART, const uint2* ROUTE, int rows, bf16_t* WG) {
    const int tid_ = ltid(); const int lane = tid_ & 63, wid = tid_ >> 6;
    for (int r = lbid() * 8 + wid; r < rows; r += lgdim() * 8) {
        float a0 = 0.f, a1 = 0.f;
#pragma unroll
        for (int x = 0; x < 8; ++x) { const float* pp = PART + ((size_t)r * 8 + x) * 128; a0 += pp[lane]; a1 += pp[64 + lane]; }
        const float g0 = __uint_as_float(ROUTE[(size_t)r * 128 + lane].y), g1 = __uint_as_float(ROUTE[(size_t)r * 128 + 64 + lane].y);
        WG[(size_t)r * 128 + lane] = f2bf(g0 * 0.5f * a0 * (1.0f + erff(a0 * 0.70710678118654752f)));
        WG[(size_t)r * 128 + 64 + lane] = f2bf(g1 * 0.5f * a1 * (1.0f + erff(a1 * 0.70710678118654752f)));
    }
}
DI void phase_peer_v(const bf16_t* WG, const unsigned short* EID, const unsigned char* PV, const float* mod, int is_ctx, int b0, int rows, bf16_t* X, bool dry) {
    const int tid_ = ltid(); const int lane = tid_ & 63, wid = tid_ >> 6, g = lane >> 3, pc = lane & 7;
    const int x = lbid() & 7, gw = (lbid() >> 3) * 8 + wid, nw = (lgdim() >> 3) * 8;
    const unsigned lbase = ((unsigned)x << 21) + (unsigned)(pc * 16);
    const int mydim = x * 128 + pc * 16 + 8 * ((lane >> 5) & 1) + 4 * ((lane >> 4) & 1) + 2 * ((lane >> 3) & 1);
    auto meta = [&](int r, unsigned (&e)[8]) {
        const int rr = r < rows ? r : rows - 1;
        const u32x4* ep = (const u32x4*)(EID + (unsigned)(rr * 128 + g * 16)); const u32x4 t0 = ep[0], t1 = ep[1];
        e[0] = t0.x; e[1] = t0.y; e[2] = t0.z; e[3] = t0.w; e[4] = t1.x; e[5] = t1.y; e[6] = t1.z; e[7] = t1.w; };
    auto wload = [&](int r, unsigned (&w)[8]) {
        const int rr = r < rows ? r : rows - 1;
        const u32x4* wp = (const u32x4*)(WG + (unsigned)(rr * 128 + g * 16)); const u32x4 t0 = wp[0], t1 = wp[1];
        w[0] = t0.x; w[1] = t0.y; w[2] = t0.z; w[3] = t0.w; w[4] = t1.x; w[5] = t1.y; w[6] = t1.z; w[7] = t1.w; };
    auto xload = [&](int r, unsigned& xw, float2& m) {
        const int rr = r < rows ? r : rows - 1; const int bi = is_ctx ? 32 : b0 + (rr >> 11);
        m = *(const float2*)(mod + (unsigned)(bi * 6144 + 5 * 1024 + mydim)); xw = *(const unsigned*)(X + (unsigned)(rr * 1024 + mydim)); };
    auto finish = [&](int r, const u32x4 (&vv)[16], const unsigned (&w)[8], const unsigned xw, const float2 m) {
        f32x2_t q0 = {0.f, 0.f}, q1 = q0, q2 = q0, q3 = q0, q4 = q0, q5 = q0, q6 = q0, q7 = q0;
#pragma unroll
        for (int j = 0; j < 16; ++j) { const unsigned d0 = vv[j].x, d1 = vv[j].y, d2 = vv[j].z, d3 = vv[j].w; const float wj = (j & 1) ? hi2f(w[j >> 1]) : lo2f(w[j >> 1]);
            const f32x2_t wp = {wj, wj}; f32x2_t t0, t1, t2, t3;
            asm volatile("v_cvt_pk_f32_fp8_e32 %[t0], %[d0]\n\tv_cvt_pk_f32_fp8_sdwa %[t1], %[d0] src0_sel:WORD_1\n\tv_cvt_pk_f32_fp8_e32 %[t2], %[d1]\n\tv_cvt_pk_f32_fp8_sdwa %[t3], %[d1] src0_sel:WORD_1\n\t"
                         "v_pk_fma_f32 %[q0], %[t0], %[wp], %[q0]\n\tv_pk_fma_f32 %[q1], %[t1], %[wp], %[q1]\n\tv_pk_fma_f32 %[q2], %[t2], %[wp], %[q2]\n\tv_pk_fma_f32 %[q3], %[t3], %[wp], %[q3]\n\t"
                         "v_cvt_pk_f32_fp8_e32 %[t0], %[d2]\n\tv_cvt_pk_f32_fp8_sdwa %[t1], %[d2] src0_sel:WORD_1\n\tv_cvt_pk_f32_fp8_e32 %[t2], %[d3]\n\tv_cvt_pk_f32_fp8_sdwa %[t3], %[d3] src0_sel:WORD_1\n\t"
                         "v_pk_fma_f32 %[q4], %[t0], %[wp], %[q4]\n\tv_pk_fma_f32 %[q5], %[t1], %[wp], %[q5]\n\tv_pk_fma_f32 %[q6], %[t2], %[wp], %[q6]\n\tv_pk_fma_f32 %[q7], %[t3], %[wp], %[q7]"
                         : [q0] "+v"(q0), [q1] "+v"(q1), [q2] "+v"(q2), [q3] "+v"(q3), [q4] "+v"(q4), [q5] "+v"(q5), [q6] "+v"(q6), [q7] "+v"(q7),
                           [t0] "=&v"(t0), [t1] "=&v"(t1), [t2] "=&v"(t2), [t3] "=&v"(t3)
                         : [d0] "v"(d0), [d1] "v"(d1), [d2] "v"(d2), [d3] "v"(d3), [wp] "v"(wp) : "memory"); }
        const float o[16] = {q0[0], q0[1], q1[0], q1[1], q2[0], q2[1], q3[0], q3[1], q4[0], q4[1], q5[0], q5[1], q6[0], q6[1], q7[0], q7[1]};
        float k8[8], k4[4], k2[2];
#pragma unroll
        for (int i = 0; i < 8; ++i) { const bool up = (lane & 32) != 0; const float send = up ? o[i] : o[i + 8]; k8[i] = (up ? o[i + 8] : o[i]) + shx(send, 32, lane); }
#pragma unroll
        for (int i = 0; i < 4; ++i) { const bool up = (lane & 16) != 0; const float send = up ? k8[i] : k8[i + 4]; k4[i] = (up ? k8[i + 4] : k8[i]) + shx(send, 16, lane); }
#pragma unroll
        for (int i = 0; i < 2; ++i) { const bool up = (lane & 8) != 0; const float send = up ? k4[i] : k4[i + 2]; k2[i] = (up ? k4[i + 2] : k4[i]) + dppf<0x128>(send); }
        if (dry && k2[0] != 12345.678f) return;
        if (r < rows) { unsigned* xr = (unsigned*)(X + (unsigned)(r * 1024 + mydim)); *xr = pk2(lo2f(xw) + m.x * k2[0], hi2f(xw) + m.y * k2[1]); } };
    auto issue = [&](int r, const unsigned (&e)[8], u32x4 (&vv)[16], unsigned (&w)[8], unsigned& xw, float2& m) {
#pragma unroll
        for (int j = 0; j < 16; ++j) vv[j] = *(const u32x4*)(PV + ((((j & 1) ? (e[j >> 1] >> 16) : (e[j >> 1] & 0xffffu)) << 7) + lbase));
        wload(r, w); xload(r, xw, m); };
    unsigned e[8], wA[8], wB[8], xwA, xwB; float2 mA, mB; u32x4 vA[16], vB[16];
    meta(gw, e);
    issue(gw, e, vA, wA, xwA, mA); meta(gw + nw, e);
    issue(gw + nw, e, vB, wB, xwB, mB); meta(gw + 2 * nw, e);
    for (int r = gw; r < rows; r += 2 * nw) {
        finish(r, vA, wA, xwA, mA);
        issue(r + 2 * nw, e, vA, wA, xwA, mA); meta(r + 3 * nw, e);
        finish(r + nw, vB, wB, xwB, mB);
        issue(r + 3 * nw, e, vB, wB, xwB, mB); meta(r + 4 * nw, e);
    }
}

DI void phase_final(const bf16_t* xb, float* out, const float* gain, int rows) {
    const int tid_ = ltid(); const int lane = tid_ & 63, wid = tid_ >> 6;
    for (int r = lbid() * 8 + wid; r < rows; r += lgdim() * 8) {
        float4 v[4]; float ss = 0.f;
#pragma unroll
        for (int j = 0; j < 4; ++j) { const u32x2 w = ((const u32x2*)(xb + (size_t)r * 1024))[lane + 64 * j]; v[j] = make_float4(lo2f(w.x), hi2f(w.x), lo2f(w.y), hi2f(w.y));
            ss += v[j].x * v[j].x + v[j].y * v[j].y + v[j].z * v[j].z + v[j].w * v[j].w; }
        ss = wave_sum(ss, lane);
        const float rstd = rsqrtf(ss * (1.0f / 1024.0f) + 1e-6f);
        float4* orow = (float4*)(out + (size_t)r * 1024);
#pragma unroll
        for (int j = 0; j < 4; ++j) { const float4 g = *(const float4*)(gain + (lane + 64 * j) * 4);
            float4 o; o.x = v[j].x * rstd * g.x; o.y = v[j].y * rstd * g.y; o.z = v[j].z * rstd * g.z; o.w = v[j].w * rstd * g.w; orow[lane + 64 * j] = o; }
    }
}

enum { PH_NORM1 = 0, PH_INPROJ, PH_PREP, PH_UPPROJ, PH_MIX, PH_INPROJ2, PH_GLAFIN, PH_BRANCH, PH_WOUT, PH_NORM2, PH_WQ, PH_SELECT, PH_PEERU, PH_PEERW, PH_PEERV, PH_COUNT };

struct RunArgs { int mode;
                 int layer, chunk, phase; };

struct Bufs { bf16_t *H, *Z, *QB, *KN, *VT, *KR, *OF, *OB, *MLA, *PD, *PO, *GF, *MMB, *PQ; float *RS, *MMF, *CST, *PART; _Float16* SC; bf16_t* WG; unsigned short* EID; uint2* ROUTE; const bf16_t* W; const float* mod; unsigned* ctl; };
DI Bufs make_bufs(const Params& P, int is_ctx, int layer) {
    __attribute__((address_space(1))) unsigned char* gws = (__attribute__((address_space(1))) unsigned char*)P.ws; asm volatile("" : "+s"(gws));
    unsigned char* ws = (unsigned char*)gws; asm volatile("" : "+s"(layer));
    Bufs B;
    B.H = (bf16_t*)(ws + WS_H); B.Z = (bf16_t*)(ws + WS_Z); B.QB = (bf16_t*)(ws + WS_QB);
    B.KN = (bf16_t*)(ws + (is_ctx ? WS_CKN : WS_KN)); B.VT = (bf16_t*)(ws + (is_ctx ? WS_CVT : WS_VT)); B.KR = (bf16_t*)(ws + (is_ctx ? WS_CKR : WS_KR));
    B.RS = (float*)(ws + WS_RS); B.OF = (bf16_t*)(ws + WS_OF); B.OB = (bf16_t*)(ws + WS_OB); B.MLA = (bf16_t*)(ws + WS_MLA);
    B.PD = (bf16_t*)(ws + WS_PD); B.PO = (bf16_t*)(ws + WS_PO); B.GF = B.PO; B.MMF = (float*)(ws + WS_OF); B.MMB = (bf16_t*)(ws + WS_VT);
    B.PQ = B.QB; B.SC = (_Float16*)(ws + WS_Z); B.ROUTE = (uint2*)(ws + WS_ROUTE); B.PART = (float*)(ws + WS_Z + 128 * MiB); B.WG = (bf16_t*)(ws + WS_Z + 192 * MiB); B.EID = (unsigned short*)(ws + WS_Z + 200 * MiB); B.CST = (float*)(ws + WS_CST);
    B.W = (const bf16_t*)(ws + WS_W) + (size_t)layer * W_LAYER; B.mod = (const float*)(ws + WS_MOD) + (size_t)layer * 33 * 6144; B.ctl = (unsigned*)(ws + WS_CTL);
    return B;
}

DI Params kparams() {
    Params P;
#if defined(__HIP_DEVICE_COMPILE__)
    typedef const void* cvp; typedef const __attribute__((address_space(1))) void* gvp;
    const __attribute__((address_space(4))) gvp* q = (const __attribute__((address_space(4))) gvp*)__builtin_amdgcn_kernarg_segment_ptr();
    asm volatile("" : "+s"(q));
#pragma unroll
    for (int i = 0; i < (int)(sizeof(Params) / sizeof(void*)); ++i) ((cvp*)&P)[i] = (cvp)q[i];
#endif
    return P;
}

__global__ void __launch_bounds__(NTHR, 2) fwd_kernel(Params Pk, RunArgs R) {
    extern __shared__ __attribute__((aligned(16))) unsigned char smem[];
    LAS unsigned char* lds = (LAS unsigned char*)smem;
    LAS unsigned* ctlw = (LAS unsigned*)(lds + LDS_BYTES - 64);
    unsigned* ctl = (unsigned*)(Pk.ws + WS_CTL);
    if (threadIdx.x == 0) { ctlw[0] = 0u; ctlw[1] = 0u; ctlw[2] = 0u; ctlw[3] = 0u; }
    __syncthreads();
    XcdBarrier bar; bar.bar = ctl; bar.x = 0; bar.st = (volatile LAS unsigned*)ctlw;
    const bool single = (R.mode == 0);
    if (single) bar = xcd_barrier_post(ctl, (volatile LAS unsigned*)ctlw);
#define GRID_SYNC() do { if (single) xcd_barrier(bar); } while (0)

    if (R.mode == 0 || R.mode == 1) for (int rep_ = 0; rep_ < ((REP_PHASE) == 100 ? 2 : 1); ++rep_) { const Params P = kparams(); phase_convert(P, lds); phase_mod(P, lds); __syncthreads(); }
    GRID_SYNC();

    if (R.mode == 0 || R.mode == 2) {
    const int l_lo = single ? 0 : R.layer, l_hi = single ? NLAYER : R.layer + 1;
    const int c_lo = single ? 0 : R.chunk, c_hi = single ? 5 : R.chunk + 1;
    for (int layer = l_lo; layer < l_hi; ++layer)
    for (int ci = c_lo; ci < c_hi; ++ci) {
        const bool is_ctx = (ci == 0);
        const bool ctx_kv_only = is_ctx && layer == NLAYER - 1;
#define RUN(ph) (single || lnd(R.phase) == (ph))
#define REP(ph) for (int rep_ = 0; rep_ < (((REP_PHASE) == (ph) || (REP_PHASE) == 999) ? 2 : 1); ++rep_)
#define PHASE_LOCALS const Params P = kparams(); const Chunk ck = make_chunk(P, layer, ci); const Bufs B = make_bufs(P, ck.is_ctx, layer); const int rows = ck.rows, np = ck.np; (void)rows; (void)np;

        if ((REP_PHASE) == 200) { for (int xb = 0; xb < 10; ++xb) GRID_SYNC(); }
        if (RUN(PH_NORM1)) REP(PH_NORM1) { PHASE_LOCALS if (layer == 0) phase_norm<true, true>(ck.x32, rows, P.norm1_g + layer * 1024, B.mod, ck.is_ctx, ck.b0, 0, B.H); else phase_norm<false, true>(ck.xb, rows, P.norm1_g + layer * 1024, B.mod, ck.is_ctx, ck.b0, 0, B.H); }
        GRID_SYNC();
        if (RUN(PH_INPROJ)) REP(PH_INPROJ) { PHASE_LOCALS
            const bf16_t* H = B.H; const bf16_t* W = B.W; bf16_t* Z = B.Z;
            auto S = make_sched(np, 15, [=](Unit& u) { u.pn = (u.pn < 12) ? u.pn : u.pn + 16;
                u.A = (const char*)H + (size_t)u.pm * 256 * 1024; u.B = (const char*)(W + WO_IN) + (size_t)u.pn * 256 * 1024; });
            pg8::gemm_phase<1>(lds, 1024, 1024, 1024, S, [=](const f32x4 (&acc)[2][2][4][2], const Unit& u, int wr, int wc, int fr, int fq) {
                const bool is_gate = false;
                pg8::epi8(acc, wr, wc, fr, fq, [&](int row, int col, const f32x4& a, const f32x4& b) {
                    f32x4 a2 = a, b2 = b;
                    if (is_gate) {
#pragma unroll
                        for (int j = 0; j < 4; ++j) { a2[j] = sigmoidf_(a[j]); b2[j] = sigmoidf_(b[j]); } }
                    store8_bf16(Z + (size_t)(u.pm * 256 + row) * ZLD + u.pn * 256 + col, a2, b2); }); });
        }
        GRID_SYNC();
        if (RUN(PH_PREP)) REP(PH_PREP) { PHASE_LOCALS phase_prep(B.Z, rows, ck.is_ctx, B.RS, B.KR, B.PD, !ctx_kv_only, (const float2*)(P.ws + WS_ROPE)); }
        GRID_SYNC();
        if (RUN(PH_UPPROJ)) REP(PH_UPPROJ) {
            if (!ctx_kv_only) { PHASE_LOCALS
                const bf16_t* Z = B.Z; const bf16_t* W = B.W; bf16_t* QB = B.QB; const float* RS = B.RS;
                auto S = make_sched(np, 6, [=](Unit& u) { u.A = (const char*)(Z + (size_t)u.pm * 256 * ZLD + ZC_QDN); u.B = (const char*)(W + WO_UQ + (size_t)u.pn * 256 * 384); });
                pg8::gemm_phase<2>(lds, ZLD, 384, 384, S, [=](const f32x4 (&acc)[2][2][4][2], const Unit& u, int wr, int wc, int fr, int fq) {
                    pg8::epi8(acc, wr, wc, fr, fq, [&](int row, int col, const f32x4& a, const f32x4& b) { const int gr = u.pm * 256 + row; const float s = RS[gr];
                        store8_bf16(QB + (size_t)gr * 1536 + u.pn * 256 + col, a * s, b * s); }); });
            }
            { PHASE_LOCALS
                const bf16_t* Z = B.Z; const bf16_t* W = B.W; bf16_t* KN = B.KN; const float* RS = B.RS;
                auto S = make_sched(np, 4, [=](Unit& u) { u.A = (const char*)(Z + (size_t)u.pm * 256 * ZLD + ZC_KVDN); u.B = (const char*)(W + WO_KN + (size_t)u.pn * 256 * 256); });
                pg8::gemm_phase<2>(lds, ZLD, 256, 256, S, [=](const f32x4 (&acc)[2][2][4][2], const Unit& u, int wr, int wc, int fr, int fq) {
                    pg8::epi8(acc, wr, wc, fr, fq, [&](int row, int col, const f32x4& a, const f32x4& b) { const int gr = u.pm * 256 + row; const float s = RS[16384 + gr];
                        store8_bf16(KN + (size_t)gr * 1024 + u.pn * 256 + col, a * s, b * s); }); });
            }
            { PHASE_LOCALS
                const bf16_t* Z = B.Z; const bf16_t* W = B.W; bf16_t* VT = B.VT; const float* RS = B.RS;
                auto S = make_sched(4, np, [=](Unit& u) { u.A = (const char*)(W + WO_V + (size_t)u.pm * 256 * 256); u.B = (const char*)(Z + (size_t)u.pn * 256 * ZLD + ZC_KVDN); });
                pg8::gemm_phase<2>(lds, 256, ZLD, 256, S, [=](const f32x4 (&acc)[2][2][4][2], const Unit& u, int wr, int wc, int fr, int fq) {
                    pg8::epi8(acc, wr, wc, fr, fq, [&](int row, int col, const f32x4& a, const f32x4& b) { const int tk = u.pn * 256 + col;
                        const f32x4 r0 = *(const f32x4*)(RS + 16384 + tk), r1 = *(const f32x4*)(RS + 16384 + tk + 4);
                        store8_bf16(VT + (size_t)(u.pm * 256 + row) * rows + tk, a * r0, b * r1); }); });
            }
        }
        GRID_SYNC();
        if (RUN(PH_MIX)) for (int rep_ = 0; rep_ < (((REP_PHASE) == PH_MIX || (REP_PHASE) == 201 || (REP_PHASE) == 202 || (REP_PHASE) == 999) ? 2 : 1); ++rep_) { PHASE_LOCALS
            const int nbat = ck.is_ctx ? NB : 8;
            const int nG = (rep_ != 0 && (REP_PHASE) == 202) ? 0 : nbat * 8;
            const int nA = (rep_ != 0 && (REP_PHASE) == 201) ? 0 : (ck.is_ctx ? (layer == 0 ? NB * 8 : 0) : 8 * 8 * 8);
            unsigned* ctr = B.ctl + CTL_WORKQ + 64 * (layer * 5 + ci) + 64 * 16 * rep_;
            const int seqlen = ck.is_ctx ? TC : TL;
            for (;;) {
                if (ltid() == 0) ctlw[4] = xb_add(ctr, 1u);
                __syncthreads();
                const int item = (int)ctlw[4];
                __syncthreads();
                if (item >= nG + nA) break;
                if (item < nG) {
                    const int dir = item & 1, h = (item >> 1) & 3, bl = item >> 3;
                    const int b = ck.b0 + bl;
                    float* st = B.CST + (size_t)((b * 4 + h) * 2 + dir) * 128 * 256;
                    gla_item(lds, B.Z + (size_t)bl * seqlen * ZLD, seqlen, h, dir, P.gla_gate_w + ((size_t)layer * 2 + dir) * 16 * 512, P.gla_gate_b + ((size_t)layer * 2 + dir) * 512,
                             ck.is_ctx ? nullptr : st, ck.is_ctx ? st : nullptr, (dir ? B.OB : B.OF) + (size_t)bl * seqlen * 1024);
                } else {
                    const int a = item - nG;
                    int h, nt0, nt1, ldv0, tq0; bool rope; const bf16_t *Qp, *kn0, *kr0, *vt0, *kn1, *kr1, *vt1; unsigned char* Op;
                    if (ck.is_ctx) {
                        h = a & 7; const int bl = a >> 3; rope = false; tq0 = 0;
                        Qp = B.QB + (size_t)bl * TC * 1536; kn0 = B.KN + (size_t)bl * TC * 1024; kr0 = B.KR + (size_t)bl * TC * 64; vt0 = B.VT + (size_t)bl * TC; ldv0 = rows; nt0 = TC / 64;
                        kn1 = kn0; kr1 = kr0; vt1 = vt0; nt1 = 0; Op = (unsigned char*)B.MLA + (size_t)bl * TC * 1024;
                    } else {
                        const int qb = a & 7; h = (a >> 3) & 7; const int bl = a >> 6; const int b = ck.b0 + bl; rope = true; tq0 = qb * 256;
                        const bf16_t* CKN = (const bf16_t*)(P.ws + WS_CKN); const bf16_t* CKR = (const bf16_t*)(P.ws + WS_CKR); const bf16_t* CVT = (const bf16_t*)(P.ws + WS_CVT);
                        Qp = B.QB + (size_t)(bl * TL + qb * 256) * 1536; kn0 = CKN + (size_t)b * TC * 1024; kr0 = CKR + (size_t)b * TC * 64; vt0 = CVT + (size_t)b * TC; ldv0 = NB * TC; nt0 = TC / 64;
                        kn1 = B.KN + (size_t)bl * TL * 1024; kr1 = B.KR + (size_t)bl * TL * 64; vt1 = B.VT + (size_t)bl * TL; nt1 = TL / 64; Op = (unsigned char*)B.MLA + (size_t)(bl * TL + qb * 256) * 1024;
                    }
                    attn_item(lds, (const float2*)(P.ws + WS_ROPE), Qp, h, rope, tq0, kn0, kr0, vt0, ldv0, nt0, kn1, kr1, vt1, rows, nt1, Op);
                }
            }
        }
        GRID_SYNC();
        if (!ctx_kv_only) {
        if (RUN(PH_INPROJ2)) REP(PH_INPROJ2) { PHASE_LOCALS
            const bf16_t* H = B.H; const bf16_t* W = B.W; bf16_t* Z = B.Z;
            auto S = make_sched(np, 16, [=](Unit& u) { u.pn += 12; u.A = (const char*)H + (size_t)u.pm * 256 * 1024; u.B = (const char*)(W + WO_IN) + (size_t)u.pn * 256 * 1024; });
            pg8::gemm_phase<1>(lds, 1024, 1024, 1024, S, [=](const f32x4 (&acc)[2][2][4][2], const Unit& u, int wr, int wc, int fr, int fq) {
                const bool is_gate = (u.pn >= ZC_GZ / 256);
                pg8::epi8(acc, wr, wc, fr, fq, [&](int row, int col, const f32x4& a, const f32x4& b) {
                    f32x4 a2 = a, b2 = b;
                    if (is_gate) {
#pragma unroll
                        for (int j = 0; j < 4; ++j) { a2[j] = sigmoidf_(a[j]); b2[j] = sigmoidf_(b[j]); } }
                    store8_bf16(Z + (size_t)(u.pm * 256 + row) * ZLD + u.pn * 256 + col, a2, b2); }); });
        }
        GRID_SYNC();
        if (RUN(PH_GLAFIN)) REP(PH_GLAFIN) { PHASE_LOCALS phase_glafin(B.OF, B.OB, B.Z, P.gla_norm_g + layer * 256, rows, B.GF); }
        GRID_SYNC();
        if (RUN(PH_BRANCH)) REP(PH_BRANCH) { PHASE_LOCALS
            const bf16_t* PO = B.PD; const bf16_t* GF = B.GF; const bf16_t* MLA = B.MLA; const bf16_t* W = B.W; const bf16_t* Z = B.Z; bf16_t* MMS = (bf16_t*)B.MMF; bf16_t* MMB = B.MMB;
            auto fill = [=](Unit& u) { const bf16_t* a = (u.z == 0) ? PO : (u.z == 1) ? GF : MLA;   u.A = (const char*)a + (size_t)u.pm * 256 * 1024;
                                       u.B = (const char*)(W + WO_BR) + (size_t)u.z * 1048576 + (size_t)u.pn * 256 * 1024; u.sa = (u.z == 2) ? 0x7d7d7d7du : 0x7f7f7f7fu; };
            TripleSched<decltype(fill)> S{np, 4, lgdim(), lbid(), fill};
            pg8::gemm_phase<1>(lds, 1024, 1024, 1024, S, [=](const f32x4 (&acc)[2][2][4][2], const Unit& u, int wr, int wc, int fr, int fq) {
                pg8::epi8(acc, wr, wc, fr, fq, [&](int row, int col, const f32x4& a, const f32x4& b) {
                    const int gr = u.pm * 256 + row, c = u.pn * 256 + col;
                    const u32x4 gz = *(const u32x4*)(Z + (size_t)gr * ZLD + ZC_GZ + u.z * 1024 + c);
                    f32x4 va, vb;
                    va[0] = a[0] * lo2f(gz.x); va[1] = a[1] * hi2f(gz.x); va[2] = a[2] * lo2f(gz.y); va[3] = a[3] * hi2f(gz.y);
                    vb[0] = b[0] * lo2f(gz.z); vb[1] = b[1] * hi2f(gz.z); vb[2] = b[2] * lo2f(gz.w); vb[3] = b[3] * hi2f(gz.w);
                    bf16_t* mp = MMS + (size_t)gr * 1024 + c;
                    if (u.z != 0) { const u32x4 pm = *(const u32x4*)mp;
                        va[0] += lo2f(pm.x); va[1] += hi2f(pm.x); va[2] += lo2f(pm.y); va[3] += hi2f(pm.y); vb[0] += lo2f(pm.z); vb[1] += hi2f(pm.z); vb[2] += lo2f(pm.w); vb[3] += hi2f(pm.w); }
                    if (u.z == 2) { u32x2 w8; w8.x = pk4_fp8(va[0], va[1], va[2], va[3]); w8.y = pk4_fp8(vb[0], vb[1], vb[2], vb[3]); *(u32x2*)((unsigned char*)MMB + (size_t)gr * 1024 + c) = w8; }
                    else store8_bf16(mp, va, vb); }); });
        }
        GRID_SYNC();
        if (RUN(PH_WOUT)) for (int rep_ = 0; rep_ < (((REP_PHASE) == PH_WOUT || (REP_PHASE) == 999) && layer == 0 ? 2 : 1); ++rep_) { PHASE_LOCALS
            const bf16_t* MMB = B.MMB; const bf16_t* W = B.W; const float* mod = B.mod;
            auto S = make_sched(np, 4, [=](Unit& u) { u.A = (const char*)MMB + (size_t)u.pm * 256 * 1024; u.B = (const char*)(W + WO_OUT) + (size_t)u.pn * 256 * 1024; });
            const float* x32 = ck.x32; bf16_t* xb = ck.xb; const int isc = ck.is_ctx, b0 = ck.b0;
            pg8::gemm_phase<1>(lds, 1024, 1024, 1024, S, [=](const f32x4 (&acc)[2][2][4][2], const Unit& u, int wr, int wc, int fr, int fq) {
                const int bi = isc ? 32 : b0 + (u.pm >> 3);
                const float* g1 = mod + (size_t)bi * 6144 + 2 * 1024;
                pg8::epi8(acc, wr, wc, fr, fq, [&](int row, int col, const f32x4& a, const f32x4& b) {
                    const int c = u.pn * 256 + col; const size_t o = (size_t)(u.pm * 256 + row) * 1024 + c;
                    const f32x4 ga = *(const f32x4*)(g1 + c), gb = *(const f32x4*)(g1 + c + 4);
                    f32x4 xa, xv;
                    if (x32) { xa = *(const f32x4*)(x32 + o); xv = *(const f32x4*)(x32 + o + 4); }
                    else { const u32x4 w = *(const u32x4*)(xb + o); xa[0] = lo2f(w.x); xa[1] = hi2f(w.x); xa[2] = lo2f(w.y); xa[3] = hi2f(w.y); xv[0] = lo2f(w.z); xv[1] = hi2f(w.z); xv[2] = lo2f(w.w); xv[3] = hi2f(w.w); }
                    store8_bf16(xb + o, xa + ga * a, xv + gb * b); }); });
        }
        GRID_SYNC();
        if (RUN(PH_NORM2)) REP(PH_NORM2) { PHASE_LOCALS phase_norm<false, false>(ck.xb, rows, P.norm2_g + layer * 1024, B.mod, ck.is_ctx, ck.b0, 3, B.H); }
        GRID_SYNC();
        if (RUN(PH_WQ)) REP(PH_WQ) { PHASE_LOCALS
            const bf16_t* H = B.H; const bf16_t* W = B.W; _Float16* SC = B.SC;
            auto S = make_sched(np, 8, [=](Unit& u) { u.A = (const char*)(H + (size_t)u.pm * 256 * 1024); u.B = (const char*)(W + WO_Q + (size_t)u.pn * 256 * 1024); });
            pg8::gemm_phase<2>(lds, 1024, 1024, 1024, S, [=](const f32x4 (&acc)[2][2][4][2], const Unit& u, int wr, int wc, int fr, int fq) {
                pg8::epi8(acc, wr, wc, fr, fq, [&](int row, int col, const f32x4& a, const f32x4& b) {
                    h16x8 hv; hv[0] = (_Float16)a[0]; hv[1] = (_Float16)a[1]; hv[2] = (_Float16)a[2]; hv[3] = (_Float16)a[3]; hv[4] = (_Float16)b[0]; hv[5] = (_Float16)b[1]; hv[6] = (_Float16)b[2]; hv[7] = (_Float16)b[3];
                    *(h16x8*)(SC + (size_t)(u.pm * 256 + row) * 2048 + u.pn * 256 + col) = hv; }); });
        }
        GRID_SYNC();
        if (RUN(PH_SELECT)) REP(PH_SELECT) { PHASE_LOCALS phase_select(B.SC, rows, B.ROUTE, B.EID, lds); }
        GRID_SYNC();
        if (RUN(PH_PEERU)) REP(PH_PEERU) { PHASE_LOCALS phase_peer_u(B.H, B.EID, (const unsigned char*)(B.W + WO_PU), rows, B.PART); }
        GRID_SYNC();
        if (RUN(PH_PEERW)) REP(PH_PEERW) { PHASE_LOCALS phase_peer_w(B.PART, B.ROUTE, rows, B.WG); }
        GRID_SYNC();
        if (RUN(PH_PEERV)) REP(PH_PEERV) { PHASE_LOCALS phase_peer_v(B.WG, B.EID, (const unsigned char*)(B.W + WO_PV), B.mod, ck.is_ctx, ck.b0, rows, ck.xb, rep_ != 0); }
        GRID_SYNC();
        }
    }
    }
    if (R.mode == 0 || R.mode == 3) { const Params P = kparams(); phase_final((const bf16_t*)(P.ws + WS_XL), P.out, P.final_norm_g, NB * TL); }
#undef RUN
#undef GRID_SYNC
#undef PHASE_LOCALS
}

extern "C" void kernel_launch(void* const* d_in, const int* in_sizes, int n_in, void* d_out, int out_size, void* d_ws, size_t ws_size, hipStream_t stream) {
    static int grid = 0;
    if (grid == 0) {
        if (n_in != 25 || ws_size < WS_END) { fprintf(stderr, "kernel_launch: need 25 inputs and %zu bytes of workspace (got %d, %zu)\n", (size_t)WS_END, n_in, ws_size); grid = -1; return; }
        int dev = 0, cus = 0, per_cu = 0;
        if (hipGetDevice(&dev) != hipSuccess || hipDeviceGetAttribute(&cus, hipDeviceAttributeMultiprocessorCount, dev) != hipSuccess) { grid = -1; return; }
        if (hipFuncSetAttribute((const void*)fwd_kernel, hipFuncAttributeMaxDynamicSharedMemorySize, LDS_BYTES) != hipSuccess) { fprintf(stderr, "kernel_launch: hipFuncSetAttribute failed\n"); grid = -1; return; }
        if (hipOccupancyMaxActiveBlocksPerMultiprocessor(&per_cu, (const void*)fwd_kernel, NTHR, LDS_BYTES) != hipSuccess || per_cu < 1) { fprintf(stderr, "kernel_launch: occupancy query says %d\n", per_cu); grid = -1; return; }
        grid = cus;
    }
    if (grid <= 0) return;
    (void)hipMemsetAsync((char*)d_ws + WS_CTL, 0, CTL_BYTES, stream);
    Params P{};
    const float* const* in = (const float* const*)d_in;
    P.x = in[0]; P.c = in[1]; P.ctx = in[2]; P.c_ctx = in[3]; P.ada_w = in[4]; P.ada_b = in[5]; P.norm1_g = in[6]; P.norm2_g = in[7]; P.w_in = in[8]; P.pool_w = in[9];
    P.pool_scale = in[10]; P.gla_gate_w = in[11]; P.gla_gate_b = in[12]; P.gla_norm_g = in[13]; P.mla_q_norm_g = in[14]; P.mla_kv_norm_g = in[15]; P.mla_w_uq = in[16];
    P.mla_w_ukv = in[17]; P.branch_w = in[18]; P.w_out = in[19]; P.peer_wq = in[20]; P.peer_keys = in[21]; P.peer_u = in[22]; P.peer_v = in[23]; P.final_norm_g = in[24];
    P.out = (float*)d_out; P.ws = (unsigned char*)d_ws;
#if MK_SINGLE
    RunArgs R{0, 0, 0, 0};
    hipLaunchKernelGGL(fwd_kernel, dim3(grid), dim3(NTHR), LDS_BYTES, stream, P, R);
#else
    { RunArgs R{1, 0, 0, 0}; hipLaunchKernelGGL(fwd_kernel, dim3(grid), dim3(NTHR), LDS_BYTES, stream, P, R); }
    for (int layer = 0; layer < NLAYER; ++layer)
        for (int ci = 0; ci < 5; ++ci)
            for (int ph = 0; ph < PH_COUNT; ++ph) {
                if (ci == 0 && layer == NLAYER - 1 && ph >= PH_INPROJ2) continue;
                RunArgs R{2, layer, ci, ph}; hipLaunchKernelGGL(fwd_kernel, dim3(grid), dim3(NTHR), LDS_BYTES, stream, P, R); }
    { RunArgs R{3, 0, 0, 0}; hipLaunchKernelGGL(fwd_kernel, dim3(grid), dim3(NTHR), LDS_BYTES, stream, P, R); }
#endif
}
```
